# Optimizing an MI355X kernel written in HIP

```python
import jax, jax.numpy as jnp
from jax import lax
import numpy as np

D_MODEL = 1024
BATCH = 2
SEQ = 8192
DEPTH = 2

GRID_W = 64
CTX_LEN = 256
N_EVEN = (DEPTH + 1) // 2
N_ODD = DEPTH // 2

MLA_HEADS = 8
QK_NOPE_DIM = 64
QK_ROPE_DIM = 32
QK_HEAD_DIM = QK_NOPE_DIM + QK_ROPE_DIM
V_HEAD_DIM = 64
Q_LORA_RANK = 384
KV_LORA_RANK = 256
QK_SCALE = QK_HEAD_DIM ** -0.5
ROPE_BASE = 10000.0
BLOCK_Q = 128
CONV_GROUPS = 8
CONV_GROUP_DIM = 64
CONV_DIM = CONV_GROUPS * CONV_GROUP_DIM
CONV_WIDTH = 3
CONV_OFFSET = Q_LORA_RANK + KV_LORA_RANK + QK_ROPE_DIM
IN_PROJ_DIM = CONV_OFFSET + 3 * CONV_DIM
MIX_OUT_DIM = MLA_HEADS * V_HEAD_DIM + CONV_DIM
FOURIER_GROUPS = 4
FOURIER_GROUP_DIM = D_MODEL // FOURIER_GROUPS
D_FF = ((8 * D_MODEL + 3 * 256 - 1) // (3 * 256)) * 256
EPS = 1e-6

kernel_name = "hybrid_mla_shortconv_fnet_dit_block"


def rmsnorm(x, g):
    xf = x.astype(jnp.float32)
    y = xf * lax.rsqrt(jnp.mean(xf * xf, axis=-1, keepdims=True) + EPS)
    return (y * g.astype(jnp.float32)).astype(x.dtype)


def axial_angles(T):
    rows = T // GRID_W
    row = jnp.broadcast_to(jnp.arange(rows)[:, None], (rows, GRID_W)).reshape(-1).astype(jnp.float32)
    col = jnp.broadcast_to(jnp.arange(GRID_W)[None, :], (rows, GRID_W)).reshape(-1).astype(jnp.float32)
    half = QK_ROPE_DIM // 2
    inv = 1.0 / (ROPE_BASE ** (jnp.arange(0, half, 2, dtype=jnp.float32) / half))
    return row[:, None] * inv, col[:, None] * inv


def rotate(x, ang):
    cos = jnp.cos(ang)[:, None, :].astype(x.dtype)
    sin = jnp.sin(ang)[:, None, :].astype(x.dtype)
    x1, x2 = jnp.split(x, 2, axis=-1)
    return jnp.concatenate([x1 * cos - x2 * sin, x2 * cos + x1 * sin], axis=-1)


def axial_rope(x, ang_row, ang_col):
    half = QK_ROPE_DIM // 2
    return jnp.concatenate([rotate(x[..., :half], ang_row), rotate(x[..., half:], ang_col)], axis=-1)


def mla_qkv(proj, q_norm_g, kv_norm_g, w_uq, w_ukv, q_gain, k_gain, angles):
    B, T, _ = proj.shape
    cq = proj[..., :Q_LORA_RANK]
    ckv = proj[..., Q_LORA_RANK:Q_LORA_RANK + KV_LORA_RANK]
    k_pe = proj[..., Q_LORA_RANK + KV_LORA_RANK:CONV_OFFSET]
    q = (rmsnorm(cq, q_norm_g) @ w_uq).reshape(B, T, MLA_HEADS, QK_HEAD_DIM)
    kv = (rmsnorm(ckv, kv_norm_g) @ w_ukv).reshape(B, T, MLA_HEADS, QK_NOPE_DIM + V_HEAD_DIM)
    k_nope, v = kv[..., :QK_NOPE_DIM], kv[..., QK_NOPE_DIM:]
    k = jnp.concatenate([k_nope, jnp.broadcast_to(k_pe[:, :, None, :], (B, T, MLA_HEADS, QK_ROPE_DIM))], axis=-1)
    q = rmsnorm(q, q_gain)
    k = rmsnorm(k, k_gain)
    if angles is not None:
        ang_row, ang_col = angles
        q = jnp.concatenate([q[..., :QK_NOPE_DIM], axial_rope(q[..., QK_NOPE_DIM:], ang_row, ang_col)], axis=-1)
        k = jnp.concatenate([k[..., :QK_NOPE_DIM], axial_rope(k[..., QK_NOPE_DIM:], ang_row, ang_col)], axis=-1)
    return q, k, v


def attend(q, k, v):
    s = jnp.einsum('bqhd,bkhd->bhqk', q, k, preferred_element_type=jnp.float32) * QK_SCALE
    p = jax.nn.softmax(s, axis=-1)
    return jnp.einsum('bhqk,bkhd->bqhd', p.astype(v.dtype), v)


def attend_blocked(q, k, v):
    B, S, H, D = q.shape
    nb = S // BLOCK_Q
    qb = q.reshape(B, nb, BLOCK_Q, H, D).transpose(1, 0, 2, 3, 4)
    ob = lax.map(lambda qi: attend(qi, k, v), qb)
    return ob.transpose(1, 0, 2, 3, 4).reshape(B, S, H * V_HEAD_DIM)


def short_conv(p, conv_w):
    b_gate, c_gate, u = jnp.split(p, 3, axis=-1)
    z = c_gate * u
    T = z.shape[1]
    zp = jnp.pad(z, ((0, 0), (1, 1), (0, 0)))
    y = zp[:, 0:T] * conv_w[0] + zp[:, 1:T + 1] * conv_w[1] + zp[:, 2:T + 2] * conv_w[2]
    return b_gate * y


def even_mixer(h_lat, h_ctx, w_in, q_norm_g, kv_norm_g, w_uq, w_ukv, q_gain, k_gain, conv_w, w_o, with_ctx_out):
    B, S, _ = h_lat.shape
    L = h_ctx.shape[1]
    p_lat = h_lat @ w_in
    p_ctx = h_ctx @ w_in
    q_l, k_l, v_l = mla_qkv(p_lat, q_norm_g, kv_norm_g, w_uq, w_ukv, q_gain, k_gain, axial_angles(S))
    q_c, k_c, v_c = mla_qkv(p_ctx, q_norm_g, kv_norm_g, w_uq, w_ukv, q_gain, k_gain, None)
    k_all = jnp.concatenate([k_l, k_c], axis=1)
    v_all = jnp.concatenate([v_l, v_c], axis=1)
    a_l = attend_blocked(q_l, k_all, v_all)
    s_l = short_conv(p_lat[..., CONV_OFFSET:], conv_w)
    out_l = jnp.concatenate([a_l, s_l], axis=-1) @ w_o
    if not with_ctx_out:
        return out_l, None
    a_c = attend(q_c, k_c, v_c).reshape(B, L, MLA_HEADS * V_HEAD_DIM)
    s_c = short_conv(p_ctx[..., CONV_OFFSET:], conv_w)
    out_c = jnp.concatenate([a_c, s_c], axis=-1) @ w_o
    return out_l, out_c


def fourier_mixer(h, w_f):
    B, T, _ = h.shape
    hg = h.astype(jnp.float32).reshape(B, T, FOURIER_GROUPS, FOURIER_GROUP_DIM)
    f = jnp.fft.fft2(hg, axes=(1, 3), norm="ortho").real
    return f.reshape(B, T, D_MODEL).astype(h.dtype) @ w_f


def swiglu(h, w1, w3, w2):
    return (jax.nn.silu(h @ w1) * (h @ w3)) @ w2


def ada(cvec, w, b):
    return jnp.split(jax.nn.silu(cvec) @ w + b, 6, axis=-1)


def setup_inputs(seed: int = 0) -> dict:
    key = jax.random.key(seed)
    ks = jax.random.split(key, 24)
    nrm = jax.random.normal
    f32 = jnp.float32
    D = D_MODEL
    return {
        "x": nrm(ks[0], (BATCH, SEQ, D), f32),
        "c": nrm(ks[1], (BATCH, D), f32),
        "ctx": nrm(ks[2], (BATCH, CTX_LEN, D), f32),
        "c_ctx": nrm(ks[3], (D,), f32),
        "ada_w": nrm(ks[4], (DEPTH, D, 6 * D), f32) * D ** -0.5,
        "ada_b": nrm(ks[5], (DEPTH, 6 * D), f32) * 0.01,
        "norm1_g": 1.0 + 0.02 * nrm(ks[6], (DEPTH, D), f32),
        "norm2_g": 1.0 + 0.02 * nrm(ks[7], (DEPTH, D), f32),
        "w_in": nrm(ks[8], (N_EVEN, D, IN_PROJ_DIM), f32) * D ** -0.5,
        "q_norm_g": 1.0 + 0.02 * nrm(ks[9], (N_EVEN, Q_LORA_RANK), f32),
        "kv_norm_g": 1.0 + 0.02 * nrm(ks[10], (N_EVEN, KV_LORA_RANK), f32),
        "w_uq": nrm(ks[11], (N_EVEN, Q_LORA_RANK, MLA_HEADS * QK_HEAD_DIM), f32) * Q_LORA_RANK ** -0.5,
        "w_ukv": nrm(ks[12], (N_EVEN, KV_LORA_RANK, MLA_HEADS * (QK_NOPE_DIM + V_HEAD_DIM)), f32) * KV_LORA_RANK ** -0.5,
        "q_gain": 1.0 + 0.02 * nrm(ks[13], (N_EVEN, QK_HEAD_DIM), f32),
        "k_gain": 1.0 + 0.02 * nrm(ks[14], (N_EVEN, QK_HEAD_DIM), f32),
        "conv_w": nrm(ks[15], (N_EVEN, CONV_WIDTH, CONV_DIM), f32) * CONV_WIDTH ** -0.5,
        "w_o": nrm(ks[16], (N_EVEN, MIX_OUT_DIM, D), f32) * MIX_OUT_DIM ** -0.5,
        "w_fourier": nrm(ks[17], (N_ODD, D, D), f32) * D ** -0.5,
        "ffn_w1": nrm(ks[18], (DEPTH, D, D_FF), f32) * D ** -0.5,
        "ffn_w3": nrm(ks[19], (DEPTH, D, D_FF), f32) * D ** -0.5,
        "ffn_w2": nrm(ks[20], (DEPTH, D_FF, D), f32) * D_FF ** -0.5,
    }


def reference(x, c, ctx, c_ctx, ada_w, ada_b, norm1_g, norm2_g, w_in, q_norm_g, kv_norm_g, w_uq, w_ukv,
              q_gain, k_gain, conv_w, w_o, w_fourier, ffn_w1, ffn_w3, ffn_w2):
    for i in range(DEPTH):
        last = i == DEPTH - 1
        j = i // 2
        sh1, sc1, g1, sh2, sc2, g2 = [m[:, None, :] for m in ada(c, ada_w[i], ada_b[i])]
        csh1, csc1, cg1, csh2, csc2, cg2 = ada(c_ctx, ada_w[i], ada_b[i])
        h_l = rmsnorm(x, norm1_g[i]) * (1 + sc1) + sh1
        if i % 2 == 0:
            h_c = rmsnorm(ctx, norm1_g[i]) * (1 + csc1) + csh1
            out_l, out_c = even_mixer(h_l, h_c, w_in[j], q_norm_g[j], kv_norm_g[j], w_uq[j], w_ukv[j],
                                      q_gain[j], k_gain[j], conv_w[j], w_o[j], not last)
        else:
            out_l = fourier_mixer(h_l, w_fourier[j])
            out_c = None
            if not last:
                h_c = rmsnorm(ctx, norm1_g[i]) * (1 + csc1) + csh1
                out_c = fourier_mixer(h_c, w_fourier[j])
        x = x + g1 * out_l
        x = x + g2 * swiglu(rmsnorm(x, norm2_g[i]) * (1 + sc2) + sh2, ffn_w1[i], ffn_w3[i], ffn_w2[i])
        if not last:
            ctx = ctx + cg1 * out_c
            ctx = ctx + cg2 * swiglu(rmsnorm(ctx, norm2_g[i]) * (1 + csc2) + csh2, ffn_w1[i], ffn_w3[i], ffn_w2[i])
    return x
```

```cpp
#include <hip/hip_runtime.h>
#include <hip/hip_cooperative_groups.h>
#include <cstdio>
#include <cstdint>
namespace cg = cooperative_groups;

#define LAS __attribute__((address_space(3)))
typedef unsigned short bf16_t;
typedef short bf16x8 __attribute__((ext_vector_type(8)));
typedef short s16x4 __attribute__((ext_vector_type(4)));
typedef float f32x4 __attribute__((ext_vector_type(4)));
typedef float f32x16 __attribute__((ext_vector_type(16)));
typedef unsigned u32x4 __attribute__((ext_vector_type(4)));
typedef unsigned u32x2 __attribute__((ext_vector_type(2)));

constexpr int DM = 1024, SEQ = 8192, ML = 16384, MC = 512, MT = ML + MC;
constexpr int NINP = 2304, NIN = 2208, QR = 384, KVR = 256, NH = 8, DQK = 96, DFF = 2816, NKEY = 8448;
constexpr float EPS = 1e-6f;
constexpr float QSC = 0.10206207261596575f * 1.4426950408889634f;

constexpr size_t MiB = 1u << 20;
constexpr size_t WS_MOD = 1 * MiB;
constexpr size_t WS_WIN = 2 * MiB;
constexpr size_t WS_WUQ = WS_WIN + (size_t)NINP * 1024 * 2;
constexpr size_t WS_WUKV = WS_WUQ + (size_t)768 * 384 * 2;
constexpr size_t WS_WO = WS_WUKV + (size_t)1024 * 256 * 2;
constexpr size_t WS_WF = WS_WO + 2 * MiB;
constexpr size_t WS_WC = WS_WF + 2 * MiB;
constexpr size_t WS_D256 = WS_WC + 4 * MiB;
constexpr size_t WS_W1D = WS_D256 + 262144;
constexpr size_t WS_W2D = WS_W1D + 131072;
constexpr size_t WS_W13 = WS_W2D + 65536;
constexpr size_t W13_BYTES = (size_t)2 * DFF * 1024 * 2;
constexpr size_t WS_W2 = WS_W13 + 2 * W13_BYTES;
constexpr size_t W2_BYTES = (size_t)1024 * DFF * 2;
constexpr size_t WS_WEND = WS_W2 + 2 * W2_BYTES;
static_assert(WS_WEND <= 56 * MiB, "weights");
constexpr size_t WS_A = 56 * MiB;
constexpr size_t WS_B = 89 * MiB;
constexpr size_t WS_Q = WS_B;
constexpr size_t WS_KV = WS_B + 24 * MiB;
constexpr size_t WS_C = 164 * MiB;
constexpr size_t WS_CQN = WS_C;
constexpr size_t WS_CKVN = WS_C + 12 * MiB + 512 * 1024;
constexpr size_t WS_KF = WS_C;
constexpr size_t WS_VT = WS_C + 25 * MiB;
constexpr size_t WS_KPE = 206 * MiB;
constexpr size_t WS_H = WS_B;
constexpr size_t WS_Z1 = WS_B;
constexpr size_t WS_G2 = WS_B + 64 * MiB;
constexpr size_t WS_END = 256 * MiB;

__device__ __forceinline__ unsigned f2bf(float f) { unsigned u = __builtin_bit_cast(unsigned, f); return (u + 0x7fffu + ((u >> 16) & 1u)) >> 16; }
__device__ __forceinline__ unsigned pk2(float lo, float hi) { return f2bf(lo) | (f2bf(hi) << 16); }
__device__ __forceinline__ float bflo(unsigned w) { return __builtin_bit_cast(float, w << 16); }
__device__ __forceinline__ float bfhi(unsigned w) { return __builtin_bit_cast(float, w & 0xffff0000u); }
__device__ __forceinline__ float bf1(bf16_t h) { return __builtin_bit_cast(float, (unsigned)h << 16); }
__device__ __forceinline__ unsigned cvt_pk_bf16(float lo, float hi) { unsigned r; asm volatile("v_cvt_pk_bf16_f32 %0, %1, %2" : "=v"(r) : "v"(lo), "v"(hi)); return r; }
__device__ __forceinline__ float wave_sum(float v) {
#pragma unroll
    for (int o = 1; o < 64; o <<= 1) v += __shfl_xor(v, o);
    return v;
}
__device__ __forceinline__ float sin_rev(float r) { return __builtin_amdgcn_sinf(r); }
__device__ __forceinline__ float cos_rev(float r) { return __builtin_amdgcn_cosf(r); }
__device__ __forceinline__ float silu_f(float x) { return x * __builtin_amdgcn_rcpf(1.0f + __builtin_amdgcn_exp2f(-1.4426950408889634f * x)); }
#define LDS_WAIT() asm volatile("s_waitcnt lgkmcnt(0)" ::: "memory")

namespace pg8 {
constexpr int BM = 256, BK = 64, HALF = 128, HTB = HALF * BK * 2, STAGE_BYTES = 8 * HTB, NXCD = 8, WGM = 8;
__host__ __device__ __forceinline__ int lds_byte(int r, int c) { const int st = (r >> 4) * 2 + (c >> 5), rr = r & 15, cc = c & 31, ob = rr * 64 + cc * 2; return st * 1024 + (ob ^ (((ob >> 9) & 1) << 5)); }
__host__ __device__ __forceinline__ void stage_rc(int b, int& R, int& C) { const int st = b / 1024, sb = b % 1024, swz = sb ^ (((sb >> 9) & 1) << 5); R = (st >> 1) * 16 + swz / 64; C = (st & 1) * 32 + (swz % 64) / 2; }
__host__ __device__ __forceinline__ int perm32(int rho) { const int n = rho >> 4, i = rho & 15; return 8 * (i >> 2) + 4 * n + (i & 3); }

__device__ __forceinline__ void glds16s(const char* sbase, unsigned voff, unsigned lds_dst) { unsigned keep;
    asm volatile("s_mov_b32 %0, m0\n\ts_mov_b32 m0, %3\n\ts_nop 0\n\tglobal_load_lds_dwordx4 %1, %2\n\ts_mov_b32 m0, %0" : "=&s"(keep) : "v"(voff), "s"(sbase), "s"(lds_dst) : "memory"); }
struct Unit { int pm, pn; };
struct StaticOrder {
    int nM, nN, nwg, G, c;
    __device__ void init(int M, int N, int G_, int c_) { nM = M / BM; nN = N / BM; nwg = nM * nN; G = G_; c = c_; }
    __device__ bool next(int i, Unit& u) const {
        const long L = (long)i * G + c; if (L >= nwg) return false;
        int wgid = (int)L; { const int q = nwg / NXCD, r = nwg % NXCD, xcd = wgid % NXCD, off = wgid / NXCD; wgid = (xcd < r ? xcd * (q + 1) : r * (q + 1) + (xcd - r) * q) + off; }
        const int nig = WGM * nN, gid = wgid / nig, fm = gid * WGM, gsz = (nM - fm) < WGM ? (nM - fm) : WGM;
        u.pm = fm + ((wgid % nig) % gsz); u.pn = (wgid % nig) / gsz; return true;
    }
};
struct ProbStd {
    const char* A; const char* B; int K; unsigned rsA, rsB; size_t hsA, hsB, tsA, tsB;
    __device__ __forceinline__ const char* a_base(const Unit& u) const { return A + (size_t)u.pm * tsA; }
    __device__ __forceinline__ const char* b_base(const Unit& u) const { return B + (size_t)u.pn * tsB; }
};
__device__ __forceinline__ ProbStd make_std(const void* A, int lda, const void* B, int ldb, int K) {
    ProbStd p; p.A = (const char*)A; p.B = (const char*)B; p.K = K; p.rsA = lda * 2; p.rsB = ldb * 2;
    p.hsA = (size_t)128 * lda * 2; p.hsB = (size_t)128 * ldb * 2; p.tsA = 2 * p.hsA; p.tsB = 2 * p.hsB; return p;
}

template <class Epi, class Prob, bool ALIGN_EPI>
__device__ __forceinline__ void gemm_phase(LAS unsigned char* lds, const Prob& P, const StaticOrder& S, const Epi& E) {
    int tid = threadIdx.x; asm volatile("" : "+v"(tid));
    const int wid = __builtin_amdgcn_readfirstlane(tid >> 6), lane = tid & 63, wr = wid >> 2, wc = wid & 3, fr = lane & 15, fq = lane >> 4;
    const int nt = P.K / BK;
    unsigned voffA[2], voffB[2];
#pragma unroll
    for (int i = 0; i < 2; ++i) { int R, C; stage_rc(tid * 16 + i * 8192, R, C); const int Rb = (R & ~31) + perm32(R & 31);
        voffA[i] = (unsigned)R * P.rsA + (unsigned)C * 2u; voffB[i] = (unsigned)Rb * P.rsB + (unsigned)C * 2u; }
    const size_t kstep = (size_t)(BK * 2);
    const size_t hstepA = P.hsA, hstepB = P.hsB;
    const unsigned ldsw = (unsigned)wid * 1024u;
    const unsigned lds0 = (unsigned)(size_t)lds;
    const int aoff = lds_byte(wr * 64 + fr, fq * 8), boff = lds_byte(wc * 32 + fr, fq * 8);
#define PG8_SA(b, h) (((b) * 2 + (h)) * HTB)
#define PG8_SB(b, h) ((4 + (b) * 2 + (h)) * HTB)
#define PG8_STAGE(bufoff, gbase, voff) do { _Pragma("unroll") for (int _i = 0; _i < 2; ++_i) \
        glds16s((gbase), (voff)[_i], lds0 + (unsigned)(bufoff) + ldsw + _i * 8192u); } while (0)
#define PG8_LDA(dst, b, h) do { _Pragma("unroll") for (int m = 0; m < 4; ++m) _Pragma("unroll") for (int k = 0; k < 2; ++k) dst[m][k] = *(const LAS bf16x8*)(lds + PG8_SA(b, h) + aoff + m * 2048 + k * 1024); } while (0)
#define PG8_LDB(dst, b, h) do { _Pragma("unroll") for (int n = 0; n < 2; ++n) _Pragma("unroll") for (int k = 0; k < 2; ++k) dst[n][k] = *(const LAS bf16x8*)(lds + PG8_SB(b, h) + boff + n * 2048 + k * 1024); } while (0)
#define PG8_MMA(ai, bj, At, Bt) do { __builtin_amdgcn_s_setprio(1); _Pragma("unroll") for (int m = 0; m < 4; ++m) _Pragma("unroll") for (int n = 0; n < 2; ++n) _Pragma("unroll") for (int k = 0; k < 2; ++k) \
        acc[ai][bj][m][n] = __builtin_amdgcn_mfma_f32_16x16x32_bf16(Bt[n][k], At[m][k], acc[ai][bj][m][n], 0, 0, 0); __builtin_amdgcn_s_setprio(0); } while (0)
#define PG8_WAIT_V(n) asm volatile("s_waitcnt vmcnt(" #n ")" ::: "memory")
#define PG8_WAIT_L(n) asm volatile("s_waitcnt lgkmcnt(" #n ")" ::: "memory")
#define PG8_BAR __builtin_amdgcn_s_barrier()
#define PG8_SCHED __builtin_amdgcn_sched_barrier(0)
    Unit cur, nxt; int ui = 0;
    if (!S.next(0, cur)) return;
    f32x4 acc[2][2][4][2];
#pragma unroll
    for (int a = 0; a < 2; ++a)
#pragma unroll
        for (int b = 0; b < 2; ++b)
#pragma unroll
            for (int m = 0; m < 4; ++m)
#pragma unroll
                for (int n = 0; n < 2; ++n) acc[a][b][m][n] = (f32x4){0.f, 0.f, 0.f, 0.f};
    bf16x8 At[4][2], B0[2][2], B1[2][2];
    const char* cA = P.a_base(cur); const char* cB = P.b_base(cur);
    PG8_STAGE(PG8_SB(0, 0), cB, voffB); PG8_STAGE(PG8_SB(0, 1), cB + hstepB, voffB); PG8_STAGE(PG8_SA(0, 0), cA, voffA); PG8_STAGE(PG8_SA(0, 1), cA + hstepA, voffA);
    if (wr == 1) PG8_BAR;
    PG8_WAIT_V(2); PG8_BAR;
    PG8_STAGE(PG8_SB(1, 0), cB + kstep, voffB); PG8_STAGE(PG8_SA(1, 0), cA + kstep, voffA); PG8_STAGE(PG8_SB(1, 1), cB + hstepB + kstep, voffB);
    PG8_WAIT_V(6); PG8_BAR;
    for (;;) {
        const bool has_next = S.next(ui + 1, nxt);
        const char* nA = has_next ? P.a_base(nxt) : cA; const char* nB = has_next ? P.b_base(nxt) : cB;
        for (int t = 0; t < nt; t += 2) {
            const bool last = (t == nt - 2);
            const char* a1 = cA + (size_t)(t + 1) * kstep;
            const char* a2 = last ? nA : cA + (size_t)(t + 2) * kstep; const char* b2 = last ? nB : cB + (size_t)(t + 2) * kstep;
            const char* a3 = a2 + kstep; const char* b3 = b2 + kstep;
            PG8_LDB(B0, 0, 0); PG8_LDB(B1, 0, 1); PG8_SCHED; PG8_LDA(At, 0, 0); PG8_STAGE(PG8_SA(1, 1), a1 + hstepA, voffA);
            PG8_WAIT_V(8); PG8_WAIT_L(0); PG8_BAR; PG8_MMA(0, 0, At, B0); PG8_MMA(0, 1, At, B1); PG8_BAR; PG8_SCHED;
            PG8_LDA(At, 0, 1); PG8_STAGE(PG8_SB(0, 0), b2, voffB); PG8_STAGE(PG8_SB(0, 1), b2 + hstepB, voffB); PG8_STAGE(PG8_SA(0, 0), a2, voffA);
            PG8_WAIT_V(8); PG8_WAIT_L(0); PG8_BAR; PG8_MMA(1, 0, At, B0); PG8_MMA(1, 1, At, B1); PG8_BAR; PG8_SCHED;
            PG8_LDB(B0, 1, 0); PG8_LDB(B1, 1, 1); PG8_SCHED; PG8_LDA(At, 1, 0); PG8_STAGE(PG8_SA(0, 1), a2 + hstepA, voffA);
            PG8_WAIT_V(8); PG8_WAIT_L(0); PG8_BAR; PG8_MMA(0, 0, At, B0); PG8_MMA(0, 1, At, B1); PG8_BAR; PG8_SCHED;
            PG8_LDA(At, 1, 1); PG8_STAGE(PG8_SB(1, 0), b3, voffB); PG8_STAGE(PG8_SB(1, 1), b3 + hstepB, voffB); PG8_STAGE(PG8_SA(1, 0), a3, voffA);
            PG8_WAIT_V(8); PG8_WAIT_L(0); PG8_BAR; PG8_MMA(1, 0, At, B0); PG8_MMA(1, 1, At, B1); PG8_BAR; PG8_SCHED;
        }
        if constexpr (ALIGN_EPI) { if (wr == 0) PG8_BAR; }
        { int fr_ = fr, fq_ = fq; asm volatile("" : "+v"(fr_), "+v"(fq_)); E(acc, cur, wr, wc, fr_, fq_); }
        if (!has_next) break;
#pragma unroll
        for (int a = 0; a < 2; ++a)
#pragma unroll
            for (int b = 0; b < 2; ++b)
#pragma unroll
                for (int m = 0; m < 4; ++m)
#pragma unroll
                    for (int n = 0; n < 2; ++n) acc[a][b][m][n] = (f32x4){0.f, 0.f, 0.f, 0.f};
        cur = nxt; cA = nA; cB = nB; ++ui;
        if constexpr (ALIGN_EPI) { if (wr == 1) PG8_BAR; }
    }
    PG8_WAIT_V(0);
    if constexpr (!ALIGN_EPI) { if (wr == 0) PG8_BAR; }
    PG8_BAR;
#undef PG8_SA
#undef PG8_SB
#undef PG8_STAGE
#undef PG8_LDA
#undef PG8_LDB
#undef PG8_MMA
#undef PG8_WAIT_V
#undef PG8_WAIT_L
#undef PG8_BAR
#undef PG8_SCHED
}

typedef f32x4 Acc[2][2][4][2];
struct EpiBf16 {
    bf16_t* O; int ldc;
    __device__ __forceinline__ void operator()(const Acc& acc, const Unit& u, int wr, int wc, int fr, int fq) const {
        const int row0 = u.pm * BM + wr * 64 + fr, col0 = u.pn * BM + wc * 32 + 8 * fq;
#pragma unroll
        for (int ai = 0; ai < 2; ++ai)
#pragma unroll
            for (int m = 0; m < 4; ++m) { bf16_t* rowp = O + (size_t)(row0 + ai * HALF + m * 16) * ldc + col0;
#pragma unroll
                for (int bj = 0; bj < 2; ++bj) { const f32x4 v0 = acc[ai][bj][m][0], v1 = acc[ai][bj][m][1];
                    u32x4 w; w.x = cvt_pk_bf16(v0[0], v0[1]); w.y = cvt_pk_bf16(v0[2], v0[3]); w.z = cvt_pk_bf16(v1[0], v1[1]); w.w = cvt_pk_bf16(v1[2], v1[3]);
                    *(u32x4*)(rowp + bj * HALF) = w; } }
    }
};
struct EpiResid {
    const float* res; float* out; const float* gate0; int gstride;
    __device__ __forceinline__ void operator()(const Acc& acc, const Unit& u, int wr, int wc, int fr, int fq) const {
        const int row0 = u.pm * BM + wr * 64 + fr, col0 = u.pn * BM + wc * 32 + 8 * fq;
        const float* gp = gate0 + (size_t)(u.pm >> 5) * gstride + col0;
        f32x4 g[2][2];
#pragma unroll
        for (int bj = 0; bj < 2; ++bj)
#pragma unroll
            for (int n = 0; n < 2; ++n) g[bj][n] = *(const f32x4*)(gp + bj * HALF + 4 * n);
#pragma unroll
        for (int ai = 0; ai < 2; ++ai)
#pragma unroll
            for (int m = 0; m < 4; ++m) { const size_t off = (size_t)(row0 + ai * HALF + m * 16) * 1024 + col0;
#pragma unroll
                for (int bj = 0; bj < 2; ++bj)
#pragma unroll
                    for (int n = 0; n < 2; ++n) { const f32x4 r = *(const f32x4*)(res + off + bj * HALF + 4 * n);
                        *(f32x4*)(out + off + bj * HALF + 4 * n) = r + g[bj][n] * acc[ai][bj][m][n]; } }
    }
};
struct EpiSwiglu {
    bf16_t* H;
    __device__ __forceinline__ void operator()(const Acc& acc, const Unit& u, int wr, int wc, int fr, int fq) const {
        const int row0 = u.pm * BM + wr * 64 + fr, col0 = u.pn * HALF + wc * 32 + 8 * fq;
#pragma unroll
        for (int ai = 0; ai < 2; ++ai)
#pragma unroll
            for (int m = 0; m < 4; ++m) { bf16_t* rowp = H + (size_t)(row0 + ai * HALF + m * 16) * DFF + col0;
                f32x4 h0, h1;
#pragma unroll
                for (int j = 0; j < 4; ++j) { h0[j] = silu_f(acc[ai][0][m][0][j]) * acc[ai][1][m][0][j]; h1[j] = silu_f(acc[ai][0][m][1][j]) * acc[ai][1][m][1][j]; }
                u32x4 w; w.x = cvt_pk_bf16(h0[0], h0[1]); w.y = cvt_pk_bf16(h0[2], h0[3]); w.z = cvt_pk_bf16(h1[0], h1[1]); w.w = cvt_pk_bf16(h1[2], h1[3]);
                *(u32x4*)rowp = w; }
    }
};
struct EpiG1 {
    bf16_t* Z1;
    __device__ __forceinline__ void operator()(const Acc& acc, const Unit& u, int wr, int wc, int fr, int fq) const {
        const unsigned b = u.pn >> 5, q = u.pn & 31, ns0 = wc * 32 + 8 * fq;
        const unsigned j0 = u.pm * BM + wr * 64 + fr;
        const unsigned cs = j0 >> 10;
        bf16_t* base = Z1 + ((size_t)(b * 1024u) * 64u * 256u + (size_t)(2u * q) * 256u + cs * 128u + ns0);
#pragma unroll
        for (int ai = 0; ai < 2; ++ai)
#pragma unroll
            for (int m = 0; m < 4; ++m) { const unsigned ch = (j0 + ai * HALF + m * 16) & 1023u; bf16_t* rp = base + (size_t)ch * (64u * 256u);
#pragma unroll
                for (int bj = 0; bj < 2; ++bj) { const f32x4 v0 = acc[ai][bj][m][0], v1 = acc[ai][bj][m][1];
                    u32x4 w; w.x = cvt_pk_bf16(v0[0], v0[1]); w.y = cvt_pk_bf16(v0[2], v0[3]); w.z = cvt_pk_bf16(v1[0], v1[1]); w.w = cvt_pk_bf16(v1[2], v1[3]);
                    *(u32x4*)(rp + bj * 256) = w; }
                asm volatile("" ::: "memory"); }
    }
};
struct EpiG2 {
    bf16_t* G2;
    __device__ __forceinline__ void operator()(const Acc& acc, const Unit& u, int wr, int wc, int fr, int fq) const {
        const unsigned rho00 = u.pn * BM + wc * 32 + 8 * fq;
#pragma unroll
        for (int m = 0; m < 4; ++m) { const unsigned ka = wr * 64 + m * 16 + fr; const float kaf = (float)ka * (1.0f / 8192.0f);
#pragma unroll
            for (int bj = 0; bj < 2; ++bj) { const unsigned rho0 = rho00 + bj * HALF, bc = rho0 >> 6, nf0 = rho0 & 63u;
                bf16_t* dp = G2 + ((size_t)(bc * 128u + ka) * 128u + nf0);
#pragma unroll
                for (int n = 0; n < 2; ++n) { const f32x4 gr = acc[0][bj][m][n], gi = acc[1][bj][m][n]; f32x4 o_r, o_i;
#pragma unroll
                    for (int j = 0; j < 4; ++j) { const float rev = (float)(nf0 + 4 * n + j) * kaf; const float c = cos_rev(rev), s = sin_rev(rev);
                        o_r[j] = gr[j] * c + gi[j] * s; o_i[j] = gi[j] * c - gr[j] * s; }
                    u32x2 wre, wim; wre.x = cvt_pk_bf16(o_r[0], o_r[1]); wre.y = cvt_pk_bf16(o_r[2], o_r[3]); wim.x = cvt_pk_bf16(o_i[0], o_i[1]); wim.y = cvt_pk_bf16(o_i[2], o_i[3]);
                    *(u32x2*)(dp + 4 * n) = wre; *(u32x2*)(dp + 64 + 4 * n) = wim;
                    asm volatile("" ::: "memory"); } } }
    }
};
struct EpiG3 {
    float* out; const float* gate0; int gstride;
    __device__ __forceinline__ void operator()(const Acc& acc, const Unit& u, int wr, int wc, int fr, int fq) const {
        if (wr != 0) return;
        const int chblk = u.pn & 3, ka = (u.pn >> 2) & 127, b = u.pn >> 9, ch0 = chblk * 256 + wc * 32 + 8 * fq;
        const float* gp = gate0 + (size_t)b * gstride + ch0;
#pragma unroll
        for (int m = 0; m < 4; ++m) { const int kb = m * 16 + fr; const size_t off = ((size_t)b * 8192 + ka + 128 * kb) * 1024 + ch0;
#pragma unroll
            for (int bj = 0; bj < 2; ++bj)
#pragma unroll
                for (int n = 0; n < 2; ++n) { const f32x4 g = *(const f32x4*)(gp + bj * HALF + 4 * n); const f32x4 r = *(const f32x4*)(out + off + bj * HALF + 4 * n);
                    *(f32x4*)(out + off + bj * HALF + 4 * n) = r + g * acc[0][bj][m][n]; } }
    }
};
struct ProbWc {
    const char* WfT; const char* D; int K; unsigned rsA, rsB; size_t hsA, hsB;
    __device__ __forceinline__ const char* a_base(const Unit& u) const { return WfT + ((size_t)(u.pm & 3) * 256 * 1024 + (size_t)u.pn * 256) * 2; }
    __device__ __forceinline__ const char* b_base(const Unit& u) const { return D + (size_t)(u.pm >> 2) * 256 * 256 * 2; }
};
struct ProbG1 {
    const char* WcT; const char* XN; int K; unsigned rsA, rsB; size_t hsA, hsB;
    __device__ __forceinline__ const char* a_base(const Unit& u) const { return WcT + (size_t)u.pm * 256 * 1024 * 2; }
    __device__ __forceinline__ const char* b_base(const Unit& u) const { return XN + ((size_t)(u.pn >> 5) * 8192 + 2 * (u.pn & 31)) * 2048; }
};
struct ProbG3 {
    const char* W2d; const char* G2; int K; unsigned rsA, rsB; size_t hsA, hsB;
    __device__ __forceinline__ const char* a_base(const Unit&) const { return W2d; }
    __device__ __forceinline__ const char* b_base(const Unit& u) const { const int chblk = u.pn & 3, ka = (u.pn >> 2) & 127, b = u.pn >> 9;
        return G2 + (((size_t)(b * 1024 + chblk * 256) * 128 + ka) * 128) * 2; }
};
}

struct Args {
    const float* in[21]; float* out; unsigned char* ws;
};
constexpr int NWAVES = 8, NTHR = 512;
constexpr int LDS_BYTES = 147456;

__device__ __forceinline__ void ada_item(const Args& a, int item, LAS unsigned char* lds, int tid, int lane, int wave) {
    const int layer = item / 96, n0 = (item % 96) * 64;
    LAS float* sil = (LAS float*)lds; LAS float* red = sil + 3072;
    const float* c = a.in[1]; const float* cc = a.in[3];
    for (int i = tid; i < 3072; i += NTHR) { const int v = i >> 10, k = i & 1023; const float cv = (v < 2) ? c[v * 1024 + k] : cc[k]; sil[i] = cv / (1.0f + __expf(-cv)); }
    __syncthreads();
    const float* W = a.in[4] + (size_t)layer * 1024 * 6144 + n0 + lane;
    float a0 = 0.f, a1 = 0.f, a2 = 0.f; const int k0 = wave * 128;
#pragma unroll 8
    for (int kk = 0; kk < 128; ++kk) { const int k = k0 + kk; const float w = W[(size_t)k * 6144]; a0 += sil[k] * w; a1 += sil[1024 + k] * w; a2 += sil[2048 + k] * w; }
    red[(wave * 3 + 0) * 64 + lane] = a0; red[(wave * 3 + 1) * 64 + lane] = a1; red[(wave * 3 + 2) * 64 + lane] = a2;
    __syncthreads();
    if (tid < 192) { const int v = tid >> 6, l = tid & 63; float s = a.in[5][layer * 6144 + n0 + l];
#pragma unroll
        for (int w = 0; w < 8; ++w) s += red[(w * 3 + v) * 64 + l];
        ((float*)(a.ws + WS_MOD))[(layer * 3 + v) * 6144 + n0 + l] = s; }
    __syncthreads();
}
__device__ __forceinline__ void transpose_item(const float* W, int N, bf16_t* WT, int ldk, int k0, int n0, int drow0, LAS float* scr, int lane) {
#pragma unroll 8
    for (int i = 0; i < 32; ++i) { const int kk = 2 * i + (lane >> 5); scr[kk * 33 + (lane & 31)] = W[(size_t)(k0 + kk) * N + n0 + (lane & 31)]; }
    LDS_WAIT(); asm volatile("" ::: "memory");
    const int c = lane & 7;
#pragma unroll
    for (int j = 0; j < 4; ++j) { const int n = (lane >> 3) + 8 * j; const LAS float* s = scr + (8 * c) * 33 + n;
        u32x4 o; o.x = pk2(s[0 * 33], s[1 * 33]); o.y = pk2(s[2 * 33], s[3 * 33]); o.z = pk2(s[4 * 33], s[5 * 33]); o.w = pk2(s[6 * 33], s[7 * 33]);
        *(u32x4*)(WT + (size_t)(drow0 + n) * ldk + k0 + 8 * c) = o; }
    LDS_WAIT(); asm volatile("" ::: "memory");
}
__device__ __forceinline__ void p0_prologue(const Args& a, LAS unsigned char* lds, int tid, int lane, int wave) {
    asm volatile("" : "+v"(lane), "+v"(tid));
    unsigned char* ws = a.ws;
    if (blockIdx.x < 192) ada_item(a, blockIdx.x, lds, tid, lane, wave);
    LAS float* scr = (LAS float*)(lds + wave * 16384);
    const int gw = blockIdx.x * NWAVES + wave, NGW = gridDim.x * NWAVES;
    constexpr int I_IN = 16 * 69, I_UQ = 6 * 24, I_UKV = 4 * 32, I_O = 512, I_F = 512, I_13 = 16 * 88, I_2 = 44 * 32;
    constexpr int NITEMS = I_IN + I_UQ + I_UKV + I_O + I_F + 2 * (2 * I_13 + I_2);
    for (int it = gw; it < NITEMS; it += NGW) {
        int r = it;
        if (r < I_IN) { const int kb = r / 69, nb = r % 69; transpose_item(a.in[8], NIN, (bf16_t*)(ws + WS_WIN), 1024, 64 * kb, 32 * nb, 32 * nb, scr, lane); continue; } r -= I_IN;
        if (r < I_UQ) { const int kb = r / 24, nb = r % 24; transpose_item(a.in[11], 768, (bf16_t*)(ws + WS_WUQ), 384, 64 * kb, 32 * nb, 32 * nb, scr, lane); continue; } r -= I_UQ;
        if (r < I_UKV) { const int kb = r / 32, nb = r % 32; transpose_item(a.in[12], 1024, (bf16_t*)(ws + WS_WUKV), 256, 64 * kb, 32 * nb, 32 * nb, scr, lane); continue; } r -= I_UKV;
        if (r < I_O) { const int kb = r / 32, nb = r % 32; transpose_item(a.in[16], 1024, (bf16_t*)(ws + WS_WO), 1024, 64 * kb, 32 * nb, 32 * nb, scr, lane); continue; } r -= I_O;
        if (r < I_F) { const int kb = r / 32, nb = r % 32; transpose_item(a.in[17], 1024, (bf16_t*)(ws + WS_WF), 1024, 64 * kb, 32 * nb, 32 * nb, scr, lane); continue; } r -= I_F;
        const int layer = r / (2 * I_13 + I_2); r -= layer * (2 * I_13 + I_2);
        if (r < 2 * I_13) { const int s = r / I_13; r -= s * I_13; const int kb = r / 88, nb = r % 88, n0 = 32 * nb;
            transpose_item(a.in[s ? 19 : 18] + (size_t)layer * 1024 * DFF, DFF, (bf16_t*)(ws + WS_W13 + layer * W13_BYTES), 1024, 64 * kb, n0, 256 * (n0 >> 7) + 128 * s + (n0 & 127), scr, lane); continue; }
        r -= 2 * I_13;
        { const int kb = r / 32, nb = r % 32; transpose_item(a.in[20] + (size_t)layer * DFF * 1024, 1024, (bf16_t*)(ws + WS_W2 + layer * W2_BYTES), DFF, 64 * kb, 32 * nb, 32 * nb, scr, lane); }
    }
    const int gt = blockIdx.x * NTHR + tid, NGT = gridDim.x * NTHR;
    { unsigned* z = (unsigned*)(ws + WS_WIN + (size_t)NIN * 1024 * 2); for (int i = gt; i < 96 * 1024 / 2; i += NGT) z[i] = 0u; }
    { bf16_t* d = (bf16_t*)(ws + WS_D256);
      for (int i = gt; i < 131072; i += NGT) { const int cs = i >> 16, c = (i >> 8) & 255, cp = i & 255; const float rev = (float)((c * cp) & 255) * (1.0f / 256.0f);
          const float v = cs ? -sin_rev(rev) : cos_rev(rev); d[i] = (bf16_t)f2bf(v * 0.0625f); } }
    { bf16_t* d = (bf16_t*)(ws + WS_W1D);
      for (int i = gt; i < 65536; i += NGT) { const int row = i >> 8, col = i & 255, ro = row >> 7, ka = row & 127, ri = col >> 7, n = col & 127; const float rev = (float)((n * ka) & 127) * (1.0f / 128.0f);
          const float c = cos_rev(rev), s = sin_rev(rev); const float v = (ro == 0) ? (ri == 0 ? c : s) : (ri == 0 ? -s : c); d[i] = (bf16_t)f2bf(v * 0.08838834764831845f); } }
    { bf16_t* d = (bf16_t*)(ws + WS_W2D);
      for (int i = gt; i < 32768; i += NGT) { const int row = i >> 7, col = i & 127, ri = col >> 6, n2 = col & 63; float v = 0.f;
          if (row < 64) { const float rev = (float)((n2 * row) & 63) * (1.0f / 64.0f); v = (ri == 0 ? cos_rev(rev) : sin_rev(rev)) * 0.125f; }
          d[i] = (bf16_t)f2bf(v); } }
}

__device__ __forceinline__ void norm_row(const float* xrow, bf16_t* orow, const float* g, const float* sc, const float* sh, int lane) {
    const f32x4* xr = (const f32x4*)xrow + lane;
    f32x4 v[4]; float s = 0.f;
#pragma unroll
    for (int j = 0; j < 4; ++j) { v[j] = xr[64 * j]; s += (v[j].x * v[j].x + v[j].y * v[j].y) + (v[j].z * v[j].z + v[j].w * v[j].w); }
    const float rstd = rsqrtf(wave_sum(s) * (1.0f / 1024.0f) + EPS);
    u32x2* o8 = (u32x2*)orow + lane;
#pragma unroll
    for (int j = 0; j < 4; ++j) { const f32x4 gg = ((const f32x4*)g)[64 * j + lane], cc = ((const f32x4*)sc)[64 * j + lane], hh = ((const f32x4*)sh)[64 * j + lane];
        const f32x4 y = v[j] * rstd * gg * (cc + 1.0f) + hh; u32x2 w; w.x = pk2(y.x, y.y); w.y = pk2(y.z, y.w); o8[64 * j] = w; }
}
__device__ __forceinline__ void norm_pass(const float* src, int nrows, bf16_t* dst, const float* g, const float* mod, int sh_chunk, int vfixed, int lane, int wave) {
    asm volatile("" : "+v"(lane));
    const int gw = blockIdx.x * NWAVES + wave, NGW = gridDim.x * NWAVES;
    for (int r = gw; r < nrows; r += NGW) { const int v = vfixed >= 0 ? vfixed : (r >> 13); const float* mv = mod + v * 6144 + sh_chunk * 1024;
        norm_row(src + (size_t)r * 1024, dst + (size_t)r * 1024, g, mv + 1024, mv, lane); }
}

__device__ __forceinline__ float sumsq8(u32x4 c) { float s = 0.f;
#pragma unroll
    for (int i = 0; i < 4; ++i) { const float a = bflo(c[i]), b = bfhi(c[i]); s += a * a + b * b; } return s; }
__device__ __forceinline__ u32x4 scale8(u32x4 c, float r, const float* g) { const f32x4 g0 = *(const f32x4*)g, g1 = *(const f32x4*)(g + 4); u32x4 o;
    o.x = pk2(bflo(c.x) * r * g0.x, bfhi(c.x) * r * g0.y); o.y = pk2(bflo(c.y) * r * g0.z, bfhi(c.y) * r * g0.w);
    o.z = pk2(bflo(c.z) * r * g1.x, bfhi(c.z) * r * g1.y); o.w = pk2(bflo(c.w) * r * g1.z, bfhi(c.w) * r * g1.w); return o; }
__device__ __forceinline__ void prep1_pass(const Args& a, int lane, int wave) {
    asm volatile("" : "+v"(lane));
    unsigned char* ws = a.ws;
    const bf16_t* P = (const bf16_t*)(ws + WS_B); bf16_t* CQN = (bf16_t*)(ws + WS_CQN); bf16_t* CKVN = (bf16_t*)(ws + WS_CKVN); bf16_t* KPE = (bf16_t*)(ws + WS_KPE); bf16_t* MIX = (bf16_t*)(ws + WS_A);
    const float* qg = a.in[9]; const float* kvg = a.in[10]; const float* cw = a.in[15];
    f32x4 w0[2], w1[2], w2[2];
#pragma unroll
    for (int i = 0; i < 2; ++i) { w0[i] = *(const f32x4*)(cw + 8 * lane + 4 * i); w1[i] = *(const f32x4*)(cw + 512 + 8 * lane + 4 * i); w2[i] = *(const f32x4*)(cw + 1024 + 8 * lane + 4 * i); }
    const int gw = blockIdx.x * NWAVES + wave, NGW = gridDim.x * NWAVES;
    for (int r = gw; r < MT; r += NGW) {
        const bf16_t* pr = P + (size_t)r * NINP;
        const u32x4 c1 = *(const u32x4*)(pr + lane * 8);
        u32x4 c2 = (u32x4){0u, 0u, 0u, 0u}; if (lane < 20) c2 = *(const u32x4*)(pr + 512 + lane * 8);
        const float ss1 = sumsq8(c1), ss2 = sumsq8(c2);
        const float sq = wave_sum(lane < 48 ? ss1 : 0.f);
        const float skv = wave_sum((lane >= 48 ? ss1 : 0.f) + (lane < 16 ? ss2 : 0.f));
        const float rq = rsqrtf(sq * (1.0f / 384.0f) + EPS), rkv = rsqrtf(skv * (1.0f / 256.0f) + EPS);
        if (lane < 48) *(u32x4*)(CQN + (size_t)r * QR + 8 * lane) = scale8(c1, rq, qg + 8 * lane);
        else *(u32x4*)(CKVN + (size_t)r * KVR + 8 * (lane - 48)) = scale8(c1, rkv, kvg + 8 * (lane - 48));
        if (lane < 16) *(u32x4*)(CKVN + (size_t)r * KVR + 128 + 8 * lane) = scale8(c2, rkv, kvg + 128 + 8 * lane);
        else if (lane < 20) *(u32x4*)(KPE + (size_t)r * 32 + 8 * (lane - 16)) = c2;
        if (r < ML) {
            const int t = r & (SEQ - 1);
            const bf16_t* cb = pr + 672 + 8 * lane;
            const u32x4 bg = *(const u32x4*)cb, cg0 = *(const u32x4*)(cb + 512), u0 = *(const u32x4*)(cb + 1024);
            u32x4 cgm = (u32x4){0u, 0u, 0u, 0u}, um = cgm, cgp = cgm, up = cgm;
            if (t > 0) { cgm = *(const u32x4*)(cb - NINP + 512); um = *(const u32x4*)(cb - NINP + 1024); }
            if (t < SEQ - 1) { cgp = *(const u32x4*)(cb + NINP + 512); up = *(const u32x4*)(cb + NINP + 1024); }
            u32x4 o;
#pragma unroll
            for (int i = 0; i < 4; ++i) {
                const float zl_m = bflo(cgm[i]) * bflo(um[i]), zh_m = bfhi(cgm[i]) * bfhi(um[i]);
                const float zl_0 = bflo(cg0[i]) * bflo(u0[i]), zh_0 = bfhi(cg0[i]) * bfhi(u0[i]);
                const float zl_p = bflo(cgp[i]) * bflo(up[i]), zh_p = bfhi(cgp[i]) * bfhi(up[i]);
                const int e = 2 * i;
                const float yl = zl_m * w0[e >> 2][e & 3] + zl_0 * w1[e >> 2][e & 3] + zl_p * w2[e >> 2][e & 3];
                const float yh = zh_m * w0[(e + 1) >> 2][(e + 1) & 3] + zh_0 * w1[(e + 1) >> 2][(e + 1) & 3] + zh_p * w2[(e + 1) >> 2][(e + 1) & 3];
                o[i] = pk2(bflo(bg[i]) * yl, bfhi(bg[i]) * yh);
            }
            *(u32x4*)(MIX + (size_t)r * 1024 + 512 + 8 * lane) = o;
        }
    }
}

__device__ __forceinline__ void prep2_pass(const Args& a, LAS unsigned char* lds, int tid, int lane, int wave) {
    asm volatile("" : "+v"(lane), "+v"(tid));
    unsigned char* ws = a.ws;
    bf16_t* Q = (bf16_t*)(ws + WS_Q); const bf16_t* KV = (const bf16_t*)(ws + WS_KV); const bf16_t* KPE = (const bf16_t*)(ws + WS_KPE);
    bf16_t* Kf = (bf16_t*)(ws + WS_KF); bf16_t* Vt = (bf16_t*)(ws + WS_VT);
    const float* qgain = a.in[13]; const float* kgain = a.in[14];
    const int head = lane >> 3, sub = lane & 7;
    const float inv = __builtin_amdgcn_exp2f(-(float)sub * 1.6609640474436813f) * 0.15915494309189535f;
    float qgn[8], kgn[8], qgp[4], kgp[4];
#pragma unroll
    for (int e = 0; e < 8; ++e) { qgn[e] = qgain[8 * sub + e] * QSC; kgn[e] = kgain[8 * sub + e]; }
#pragma unroll
    for (int i = 0; i < 4; ++i) { qgp[i] = qgain[64 + sub + 8 * i] * QSC; kgp[i] = kgain[64 + sub + 8 * i]; }
    for (int blk = blockIdx.x; blk < MT / 64; blk += gridDim.x) {
        const int r0 = blk * 64; const bool latent = blk < 256;
        const int b = latent ? (blk >> 7) : ((blk - 256) >> 2);
        const int key0 = latent ? ((blk & 127) * 64) : (SEQ + ((blk - 256) & 3) * 64);
#pragma unroll
        for (int i = 0; i < 8; ++i) { const int id = tid + 512 * i, row = id >> 6, cc = id & 63, h = cc >> 3, part = cc & 7;
            const u32x4 v = *(const u32x4*)(KV + (size_t)(r0 + row) * 1024 + h * 128 + 64 + part * 8);
            *(LAS u32x4*)(lds + row * 1024 + cc * 16) = v; }
        for (int i = 0; i < 8; ++i) {
            const int r = r0 + 8 * wave + i, kl = 8 * wave + i;
            float cr = 1.f, sr = 0.f, ccol = 1.f, scol = 0.f;
            if (latent) { const int t = r & (SEQ - 1); const float ar = (float)(t >> 6) * inv, ac = (float)(t & 63) * inv;
                cr = cos_rev(ar - floorf(ar)); sr = sin_rev(ar - floorf(ar)); ccol = cos_rev(ac - floorf(ac)); scol = sin_rev(ac - floorf(ac)); }
            const bf16_t* kpe = KPE + (size_t)r * 32;
            if (latent) {
                bf16_t* qp = Q + (size_t)r * 768 + head * 96;
                const u32x4 nv = *(const u32x4*)(qp + 8 * sub);
                float pe[4];
#pragma unroll
                for (int j = 0; j < 4; ++j) pe[j] = bf1(qp[64 + sub + 8 * j]);
                float ss = sumsq8(nv) + (pe[0] * pe[0] + pe[1] * pe[1]) + (pe[2] * pe[2] + pe[3] * pe[3]);
                ss += __shfl_xor(ss, 1); ss += __shfl_xor(ss, 2); ss += __shfl_xor(ss, 4);
                const float rs = rsqrtf(ss * (1.0f / 96.0f) + EPS);
                u32x4 o; o.x = pk2(bflo(nv.x) * rs * qgn[0], bfhi(nv.x) * rs * qgn[1]); o.y = pk2(bflo(nv.y) * rs * qgn[2], bfhi(nv.y) * rs * qgn[3]);
                o.z = pk2(bflo(nv.z) * rs * qgn[4], bfhi(nv.z) * rs * qgn[5]); o.w = pk2(bflo(nv.w) * rs * qgn[6], bfhi(nv.w) * rs * qgn[7]);
                *(u32x4*)(qp + 8 * sub) = o;
                const float p0 = pe[0] * rs * qgp[0], p1 = pe[1] * rs * qgp[1], p2 = pe[2] * rs * qgp[2], p3 = pe[3] * rs * qgp[3];
                qp[64 + sub] = (bf16_t)f2bf(p0 * cr - p1 * sr); qp[72 + sub] = (bf16_t)f2bf(p1 * cr + p0 * sr);
                qp[80 + sub] = (bf16_t)f2bf(p2 * ccol - p3 * scol); qp[88 + sub] = (bf16_t)f2bf(p3 * ccol + p2 * scol);
            }
            {
                const u32x4 nv = *(const u32x4*)(KV + (size_t)r * 1024 + head * 128 + 8 * sub);
                float pe[4];
#pragma unroll
                for (int j = 0; j < 4; ++j) pe[j] = bf1(kpe[sub + 8 * j]);
                float ss = sumsq8(nv) + (pe[0] * pe[0] + pe[1] * pe[1]) + (pe[2] * pe[2] + pe[3] * pe[3]);
                ss += __shfl_xor(ss, 1); ss += __shfl_xor(ss, 2); ss += __shfl_xor(ss, 4);
                const float rs = rsqrtf(ss * (1.0f / 96.0f) + EPS);
                bf16_t* kp = Kf + ((size_t)(b * NH + head) * NKEY + key0 + kl) * DQK;
                u32x4 o; o.x = pk2(bflo(nv.x) * rs * kgn[0], bfhi(nv.x) * rs * kgn[1]); o.y = pk2(bflo(nv.y) * rs * kgn[2], bfhi(nv.y) * rs * kgn[3]);
                o.z = pk2(bflo(nv.z) * rs * kgn[4], bfhi(nv.z) * rs * kgn[5]); o.w = pk2(bflo(nv.w) * rs * kgn[6], bfhi(nv.w) * rs * kgn[7]);
                *(u32x4*)(kp + 8 * sub) = o;
                const float p0 = pe[0] * rs * kgp[0], p1 = pe[1] * rs * kgp[1], p2 = pe[2] * rs * kgp[2], p3 = pe[3] * rs * kgp[3];
                kp[64 + sub] = (bf16_t)f2bf(p0 * cr - p1 * sr); kp[72 + sub] = (bf16_t)f2bf(p1 * cr + p0 * sr);
                kp[80 + sub] = (bf16_t)f2bf(p2 * ccol - p3 * scol); kp[88 + sub] = (bf16_t)f2bf(p3 * ccol + p2 * scol);
            }
        }
        __syncthreads();
        { const int h = tid >> 6, d = tid & 63; bf16_t* vp = Vt + ((size_t)(b * NH + h) * 64 + d) * NKEY + key0;
#pragma unroll
          for (int i = 0; i < 8; ++i) { unsigned short e[8];
#pragma unroll
              for (int k = 0; k < 8; ++k) e[k] = *(const LAS unsigned short*)(lds + (8 * i + k) * 1024 + tid * 2);
              u32x4 o; o.x = e[0] | ((unsigned)e[1] << 16); o.y = e[2] | ((unsigned)e[3] << 16); o.z = e[4] | ((unsigned)e[5] << 16); o.w = e[6] | ((unsigned)e[7] << 16);
              *(u32x4*)(vp + 8 * i) = o; } }
        __syncthreads();
    }
}

__device__ __forceinline__ void attn_phase(const Args& a, LAS unsigned char* lds, int tid, int lane, int wid) {
    asm volatile("" : "+v"(lane), "+v"(tid));
    unsigned char* ws = a.ws;
    const bf16_t* Q = (const bf16_t*)(ws + WS_Q); const bf16_t* Kf = (const bf16_t*)(ws + WS_KF); const bf16_t* Vt = (const bf16_t*)(ws + WS_VT); bf16_t* MIX = (bf16_t*)(ws + WS_A);
    constexpr int BUF = 22528, VOFF = 13312, NT = NKEY / 64;
    const int q = lane & 31, hi = lane >> 5;
    const int xcd = blockIdx.x & 7, l = blockIdx.x >> 3;
    const int kkey0 = tid / 12, kpart0 = tid % 12, kkey1 = (512 + tid) / 12, kpart1 = (512 + tid) % 12;
    const int vd = tid >> 3, vpart = tid & 7;
    for (int it = 0; it < 2; ++it) {
        const int bh = 2 * xcd + it, b = bh >> 3, h = bh & 7, qb = l;
        const size_t qrow = (size_t)b * SEQ + qb * 256 + wid * 32 + q;
        bf16x8 qf[6];
#pragma unroll
        for (int d0 = 0; d0 < 6; ++d0) qf[d0] = *(const bf16x8*)(Q + qrow * 768 + h * 96 + d0 * 16 + hi * 8);
        const bf16_t* Kh = Kf + (size_t)bh * NKEY * DQK; const bf16_t* Vh = Vt + (size_t)bh * 64 * NKEY;
        u32x4 kr0, kr1 = (u32x4){0u, 0u, 0u, 0u}, vr;
        kr0 = *(const u32x4*)(Kh + tid * 8); if (tid < 256) kr1 = *(const u32x4*)(Kh + (512 + tid) * 8);
        vr = *(const u32x4*)(Vh + (size_t)vd * NKEY + vpart * 8);
        *(LAS u32x4*)(lds + kkey0 * 208 + kpart0 * 16) = kr0; if (tid < 256) *(LAS u32x4*)(lds + kkey1 * 208 + kpart1 * 16) = kr1;
        *(LAS u32x2*)(lds + VOFF + vd * 136 + vpart * 16) = (u32x2){vr.x, vr.y}; *(LAS u32x2*)(lds + VOFF + vd * 136 + vpart * 16 + 8) = (u32x2){vr.z, vr.w};
        __syncthreads();
        float m = -1e30f, lsum = 0.f; f32x16 o0 = {}, o1 = {};
        for (int t = 0; t < NT; ++t) {
            const bool more = (t + 1 < NT);
            if (more) { const bf16_t* kt = Kh + (size_t)(t + 1) * 64 * DQK; kr0 = *(const u32x4*)(kt + tid * 8); if (tid < 256) kr1 = *(const u32x4*)(kt + (512 + tid) * 8);
                vr = *(const u32x4*)(Vh + (size_t)vd * NKEY + (t + 1) * 64 + vpart * 8); }
            LAS unsigned char* kb = lds + (t & 1) * BUF;
            f32x16 p0 = {}, p1 = {};
#pragma unroll
            for (int d0 = 0; d0 < 6; ++d0) {
                const bf16x8 a0 = *(const LAS bf16x8*)(kb + q * 208 + d0 * 32 + hi * 16);
                const bf16x8 a1 = *(const LAS bf16x8*)(kb + (32 + q) * 208 + d0 * 32 + hi * 16);
                p0 = __builtin_amdgcn_mfma_f32_32x32x16_bf16(a0, qf[d0], p0, 0, 0, 0);
                p1 = __builtin_amdgcn_mfma_f32_32x32x16_bf16(a1, qf[d0], p1, 0, 0, 0);
            }
            float mx = fmaxf(p0[0], p1[0]);
#pragma unroll
            for (int r = 1; r < 16; ++r) mx = fmaxf(mx, fmaxf(p0[r], p1[r]));
            mx = fmaxf(mx, __shfl_xor(mx, 32));
            const float mn = fmaxf(m, mx), alpha = __builtin_amdgcn_exp2f(m - mn); m = mn;
            float rs = 0.f;
#pragma unroll
            for (int r = 0; r < 16; ++r) { p0[r] = __builtin_amdgcn_exp2f(p0[r] - mn); p1[r] = __builtin_amdgcn_exp2f(p1[r] - mn); rs += p0[r] + p1[r]; }
            lsum = lsum * alpha + rs;
#pragma unroll
            for (int r = 0; r < 16; ++r) { o0[r] *= alpha; o1[r] *= alpha; }
#pragma unroll
            for (int s = 0; s < 4; ++s) {
                u32x4 pw;
                if (s == 0) { pw.x = cvt_pk_bf16(p0[0], p0[1]); pw.y = cvt_pk_bf16(p0[2], p0[3]); pw.z = cvt_pk_bf16(p0[4], p0[5]); pw.w = cvt_pk_bf16(p0[6], p0[7]); }
                else if (s == 1) { pw.x = cvt_pk_bf16(p0[8], p0[9]); pw.y = cvt_pk_bf16(p0[10], p0[11]); pw.z = cvt_pk_bf16(p0[12], p0[13]); pw.w = cvt_pk_bf16(p0[14], p0[15]); }
                else if (s == 2) { pw.x = cvt_pk_bf16(p1[0], p1[1]); pw.y = cvt_pk_bf16(p1[2], p1[3]); pw.z = cvt_pk_bf16(p1[4], p1[5]); pw.w = cvt_pk_bf16(p1[6], p1[7]); }
                else { pw.x = cvt_pk_bf16(p1[8], p1[9]); pw.y = cvt_pk_bf16(p1[10], p1[11]); pw.z = cvt_pk_bf16(p1[12], p1[13]); pw.w = cvt_pk_bf16(p1[14], p1[15]); }
                const bf16x8 pb = __builtin_bit_cast(bf16x8, pw);
                const LAS unsigned char* vb = kb + VOFF + q * 136 + (16 * s + 4 * hi) * 2;
                const s16x4 l0 = *(const LAS s16x4*)(vb), h0 = *(const LAS s16x4*)(vb + 16);
                const s16x4 l1 = *(const LAS s16x4*)(vb + 32 * 136), h1 = *(const LAS s16x4*)(vb + 32 * 136 + 16);
                const bf16x8 va0 = (bf16x8){l0[0], l0[1], l0[2], l0[3], h0[0], h0[1], h0[2], h0[3]};
                const bf16x8 va1 = (bf16x8){l1[0], l1[1], l1[2], l1[3], h1[0], h1[1], h1[2], h1[3]};
                o0 = __builtin_amdgcn_mfma_f32_32x32x16_bf16(va0, pb, o0, 0, 0, 0);
                o1 = __builtin_amdgcn_mfma_f32_32x32x16_bf16(va1, pb, o1, 0, 0, 0);
            }
            if (more) { LAS unsigned char* nb = lds + ((t + 1) & 1) * BUF;
                *(LAS u32x4*)(nb + kkey0 * 208 + kpart0 * 16) = kr0; if (tid < 256) *(LAS u32x4*)(nb + kkey1 * 208 + kpart1 * 16) = kr1;
                *(LAS u32x2*)(nb + VOFF + vd * 136 + vpart * 16) = (u32x2){vr.x, vr.y}; *(LAS u32x2*)(nb + VOFF + vd * 136 + vpart * 16 + 8) = (u32x2){vr.z, vr.w}; }
            __syncthreads();
        }
        const float lt = lsum + __shfl_xor(lsum, 32); const float il = 1.0f / lt;
        bf16_t* op = MIX + qrow * 1024 + h * 64 + 4 * hi;
#pragma unroll
        for (int g = 0; g < 4; ++g) {
            u32x2 w0, w1; w0.x = cvt_pk_bf16(o0[4 * g] * il, o0[4 * g + 1] * il); w0.y = cvt_pk_bf16(o0[4 * g + 2] * il, o0[4 * g + 3] * il);
            w1.x = cvt_pk_bf16(o1[4 * g] * il, o1[4 * g + 1] * il); w1.y = cvt_pk_bf16(o1[4 * g + 2] * il, o1[4 * g + 3] * il);
            *(u32x2*)(op + 8 * g) = w0; *(u32x2*)(op + 32 + 8 * g) = w1;
        }
    }
}

__global__ void __launch_bounds__(NTHR, 2) fwd_kernel(Args a) {
    extern __shared__ __attribute__((aligned(16))) unsigned char lds_raw[];
    LAS unsigned char* lds = (LAS unsigned char*)lds_raw;
    cg::grid_group grid = cg::this_grid();
    const int tid = threadIdx.x, lane = tid & 63, wave = __builtin_amdgcn_readfirstlane(tid >> 6);
    const int G = gridDim.x, cu = blockIdx.x;
    unsigned char* ws = a.ws;
    const float* mod = (const float*)(ws + WS_MOD);
    bf16_t* XN = (bf16_t*)(ws + WS_A);

    p0_prologue(a, lds, tid, lane, wave);
    grid.sync();
    norm_pass(a.in[0], ML, XN, a.in[6], mod, 0, -1, lane, wave);
    norm_pass(a.in[2], MC, XN + (size_t)ML * 1024, a.in[6], mod, 0, 2, lane, wave);
    grid.sync();
    { pg8::ProbStd p = pg8::make_std(XN, 1024, ws + WS_WIN, 1024, 1024); pg8::StaticOrder S; S.init(MT, NINP, G, cu);
      pg8::EpiBf16 E{(bf16_t*)(ws + WS_B), NINP}; pg8::gemm_phase<pg8::EpiBf16, pg8::ProbStd, true>(lds, p, S, E); }
    { pg8::ProbWc p{(const char*)(ws + WS_WF), (const char*)(ws + WS_D256), 256, 1024 * 2, 256 * 2, (size_t)128 * 1024 * 2, (size_t)128 * 256 * 2};
      pg8::StaticOrder S; S.init(2048, 1024, G, (cu + 32) & 255);
      pg8::EpiBf16 E{(bf16_t*)(ws + WS_WC), 1024}; pg8::gemm_phase<pg8::EpiBf16, pg8::ProbWc, true>(lds, p, S, E); }
    grid.sync();
    prep1_pass(a, lane, wave);
    grid.sync();
    { pg8::ProbStd p = pg8::make_std(ws + WS_CQN, QR, ws + WS_WUQ, QR, QR); pg8::StaticOrder S; S.init(ML, 768, G, cu);
      pg8::EpiBf16 E{(bf16_t*)(ws + WS_Q), 768}; pg8::gemm_phase<pg8::EpiBf16, pg8::ProbStd, true>(lds, p, S, E); }
    { pg8::ProbStd p = pg8::make_std(ws + WS_CKVN, KVR, ws + WS_WUKV, KVR, KVR); pg8::StaticOrder S; S.init(MT, 1024, G, (cu + 64) & 255);
      pg8::EpiBf16 E{(bf16_t*)(ws + WS_KV), 1024}; pg8::gemm_phase<pg8::EpiBf16, pg8::ProbStd, true>(lds, p, S, E); }
    grid.sync();
    prep2_pass(a, lds, tid, lane, wave);
    grid.sync();
    attn_phase(a, lds, tid, lane, wave);
    grid.sync();
    { pg8::ProbStd p = pg8::make_std(ws + WS_A, 1024, ws + WS_WO, 1024, 1024); pg8::StaticOrder S; S.init(ML, 1024, G, cu);
      pg8::EpiResid E{a.in[0], a.out, mod + 2 * 1024, 6144}; pg8::gemm_phase<pg8::EpiResid, pg8::ProbStd, true>(lds, p, S, E); }
    grid.sync();
#pragma unroll
    for (int layer = 0; layer < 2; ++layer) {
        const float* modl = mod + layer * 3 * 6144;
        if (layer == 1) {
            norm_pass(a.out, ML, XN, a.in[6] + 1024, modl, 0, -1, lane, wave);
            grid.sync();
            { pg8::ProbG1 p{(const char*)(ws + WS_WC), (const char*)XN, 1024, 1024 * 2, 64 * 2048, (size_t)128 * 1024 * 2, (size_t)2048};
              pg8::StaticOrder S; S.init(2048, 16384, G, cu);
              pg8::EpiG1 E{(bf16_t*)(ws + WS_Z1)}; pg8::gemm_phase<pg8::EpiG1, pg8::ProbG1, true>(lds, p, S, E); }
            grid.sync();
            { pg8::ProbStd p = pg8::make_std(ws + WS_W1D, 256, ws + WS_Z1, 256, 256); pg8::StaticOrder S; S.init(256, 131072, G, cu);
              pg8::EpiG2 E{(bf16_t*)(ws + WS_G2)}; pg8::gemm_phase<pg8::EpiG2, pg8::ProbStd, true>(lds, p, S, E); }
            grid.sync();
            { pg8::ProbG3 p{(const char*)(ws + WS_W2D), (const char*)(ws + WS_G2), 128, 128 * 2, 128 * 128 * 2, (size_t)128 * 128 * 2, (size_t)128 * 128 * 128 * 2};
              pg8::StaticOrder S; S.init(256, 262144, G, cu);
              pg8::EpiG3 E{a.out, modl + 2 * 1024, 6144}; pg8::gemm_phase<pg8::EpiG3, pg8::ProbG3, true>(lds, p, S, E); }
            grid.sync();
        }
        norm_pass(a.out, ML, XN, a.in[7] + layer * 1024, modl, 3, -1, lane, wave);
        grid.sync();
        { pg8::ProbStd p = pg8::make_std(XN, 1024, ws + WS_W13 + layer * W13_BYTES, 1024, 1024); pg8::StaticOrder S; S.init(ML, 2 * DFF, G, cu);
          pg8::EpiSwiglu E{(bf16_t*)(ws + WS_H)}; pg8::gemm_phase<pg8::EpiSwiglu, pg8::ProbStd, true>(lds, p, S, E); }
        grid.sync();
        { pg8::ProbStd p = pg8::make_std(ws + WS_H, DFF, ws + WS_W2 + layer * W2_BYTES, DFF, DFF); pg8::StaticOrder S; S.init(ML, 1024, G, cu);
          pg8::EpiResid E{a.out, a.out, modl + 5 * 1024, 6144}; pg8::gemm_phase<pg8::EpiResid, pg8::ProbStd, true>(lds, p, S, E); }
        if (layer == 0) grid.sync();
    }
}

extern "C" void kernel_launch(void* const* d_in, const int* in_sizes, int n_in, void* d_out, int out_size, void* d_ws, size_t ws_size, hipStream_t stream) {
    static int grid = 0;
    if (grid == 0) {
        if (n_in != 21 || out_size != ML * DM || ws_size < WS_END) { fprintf(stderr, "kernel_launch: unexpected problem (n_in %d out %d ws %zu)\n", n_in, out_size, ws_size); grid = -1; return; }
        int dev = 0, cus = 0, per_cu = 0;
        (void)hipGetDevice(&dev);
        (void)hipDeviceGetAttribute(&cus, hipDeviceAttributeMultiprocessorCount, dev);
        (void)hipFuncSetAttribute((const void*)fwd_kernel, hipFuncAttributeMaxDynamicSharedMemorySize, LDS_BYTES);
        (void)hipOccupancyMaxActiveBlocksPerMultiprocessor(&per_cu, (const void*)fwd_kernel, NTHR, LDS_BYTES);
        (void)hipGetLastError();
        grid = 256;
        if (cus < 256 || per_cu < 1) fprintf(stderr, "kernel_launch: cus %d per_cu %d\n", cus, per_cu);
    }
    if (grid < 0) return;
    Args a{};
    for (int i = 0; i < 21; ++i) a.in[i] = (const float*)d_in[i];
    a.out = (float*)d_out; a.ws = (unsigned char*)d_ws;
    void* args[] = {&a};
    hipError_t e = hipLaunchCooperativeKernel((const void*)fwd_kernel, dim3(grid), dim3(NTHR), args, LDS_BYTES, stream);
    if (e != hipSuccess) fprintf(stderr, "cooperative launch failed: %s\n", hipGetErrorString(e));
}
```

```cpp
#include <hip/hip_runtime.h>
#include <hip/hip_cooperative_groups.h>
#include <cstdio>
#include <cstdint>
namespace cg = cooperative_groups;
#ifndef PROBE_SYNC
#define PROBE_SYNC 1
#endif
#ifndef PROBE_ATTN
#define PROBE_ATTN 1
#endif
#ifndef PROBE_FFNUP
#define PROBE_FFNUP 1
#endif

#define LAS __attribute__((address_space(3)))
typedef unsigned short bf16_t;
typedef short bf16x8 __attribute__((ext_vector_type(8)));
typedef short s16x4 __attribute__((ext_vector_type(4)));
typedef float f32x4 __attribute__((ext_vector_type(4)));
typedef float f32x16 __attribute__((ext_vector_type(16)));
typedef unsigned u32x4 __attribute__((ext_vector_type(4)));
typedef unsigned u32x2 __attribute__((ext_vector_type(2)));

constexpr int DM = 1024, SEQ = 8192, ML = 16384, MC = 512, MT = ML + MC;
constexpr int NINP = 2304, NIN = 2208, QR = 384, KVR = 256, NH = 8, DQK = 96, DFF = 2816, NKEY = 8448;
constexpr float EPS = 1e-6f;
constexpr float QSC = 0.10206207261596575f * 1.4426950408889634f;

constexpr size_t MiB = 1u << 20;
constexpr size_t WS_MOD = 1 * MiB;
constexpr size_t WS_WIN = 2 * MiB;
constexpr size_t WS_WUQ = WS_WIN + (size_t)NINP * 1024 * 2;
constexpr size_t WS_WUKV = WS_WUQ + (size_t)768 * 384 * 2;
constexpr size_t WS_WO = WS_WUKV + (size_t)1024 * 256 * 2;
constexpr size_t WS_WF = WS_WO + 2 * MiB;
constexpr size_t WS_WC = WS_WF + 2 * MiB;
constexpr size_t WS_D256 = WS_WC + 4 * MiB;
constexpr size_t WS_W1D = WS_D256 + 262144;
constexpr size_t WS_W2D = WS_W1D + 131072;
constexpr size_t WS_W13 = WS_W2D + 65536;
constexpr size_t W13_BYTES = (size_t)2 * DFF * 1024 * 2;
constexpr size_t WS_W2 = WS_W13 + 2 * W13_BYTES;
constexpr size_t W2_BYTES = (size_t)1024 * DFF * 2;
constexpr size_t WS_WEND = WS_W2 + 2 * W2_BYTES;
static_assert(WS_WEND <= 56 * MiB, "weights");
constexpr size_t WS_A = 56 * MiB;
constexpr size_t WS_B = 89 * MiB;
constexpr size_t WS_Q = WS_B;
constexpr size_t WS_KV = WS_B + 24 * MiB;
constexpr size_t WS_C = 164 * MiB;
constexpr size_t WS_CQN = WS_C;
constexpr size_t WS_CKVN = WS_C + 12 * MiB + 512 * 1024;
constexpr size_t WS_KF = WS_C;
constexpr size_t WS_VT = WS_C + 25 * MiB;
constexpr size_t WS_KPE = 206 * MiB;
constexpr size_t WS_H = WS_B;
constexpr size_t WS_Z1 = WS_B;
constexpr size_t WS_G2 = WS_B + 64 * MiB;
constexpr size_t WS_END = 256 * MiB;

__device__ __forceinline__ unsigned f2bf(float f) { unsigned u = __builtin_bit_cast(unsigned, f); return (u + 0x7fffu + ((u >> 16) & 1u)) >> 16; }
__device__ __forceinline__ unsigned pk2(float lo, float hi) { return f2bf(lo) | (f2bf(hi) << 16); }
__device__ __forceinline__ float bflo(unsigned w) { return __builtin_bit_cast(float, w << 16); }
__device__ __forceinline__ float bfhi(unsigned w) { return __builtin_bit_cast(float, w & 0xffff0000u); }
__device__ __forceinline__ float bf1(bf16_t h) { return __builtin_bit_cast(float, (unsigned)h << 16); }
__device__ __forceinline__ unsigned cvt_pk_bf16(float lo, float hi) { unsigned r; asm volatile("v_cvt_pk_bf16_f32 %0, %1, %2" : "=v"(r) : "v"(lo), "v"(hi)); return r; }
__device__ __forceinline__ float wave_sum(float v) {
#pragma unroll
    for (int o = 1; o < 64; o <<= 1) v += __shfl_xor(v, o);
    return v;
}
__device__ __forceinline__ float sin_rev(float r) { return __builtin_amdgcn_sinf(r); }
__device__ __forceinline__ float cos_rev(float r) { return __builtin_amdgcn_cosf(r); }
__device__ __forceinline__ float silu_f(float x) { return x * __builtin_amdgcn_rcpf(1.0f + __builtin_amdgcn_exp2f(-1.4426950408889634f * x)); }
#define LDS_WAIT() asm volatile("s_waitcnt lgkmcnt(0)" ::: "memory")

namespace pg8 {
constexpr int BM = 256, BK = 64, HALF = 128, HTB = HALF * BK * 2, STAGE_BYTES = 8 * HTB, NXCD = 8, WGM = 8;
__host__ __device__ __forceinline__ int lds_byte(int r, int c) { const int st = (r >> 4) * 2 + (c >> 5), rr = r & 15, cc = c & 31, ob = rr * 64 + cc * 2; return st * 1024 + (ob ^ (((ob >> 9) & 1) << 5)); }
__host__ __device__ __forceinline__ void stage_rc(int b, int& R, int& C) { const int st = b / 1024, sb = b % 1024, swz = sb ^ (((sb >> 9) & 1) << 5); R = (st >> 1) * 16 + swz / 64; C = (st & 1) * 32 + (swz % 64) / 2; }
__host__ __device__ __forceinline__ int perm32(int rho) { const int n = rho >> 4, i = rho & 15; return 8 * (i >> 2) + 4 * n + (i & 3); }

__device__ __forceinline__ void glds16s(const char* sbase, unsigned voff, unsigned lds_dst) { unsigned keep;
    asm volatile("s_mov_b32 %0, m0\n\ts_mov_b32 m0, %3\n\ts_nop 0\n\tglobal_load_lds_dwordx4 %1, %2\n\ts_mov_b32 m0, %0" : "=&s"(keep) : "v"(voff), "s"(sbase), "s"(lds_dst) : "memory"); }
struct Unit { int pm, pn; };
struct StaticOrder {
    int nM, nN, nwg, G, c;
    __device__ void init(int M, int N, int G_, int c_) { nM = M / BM; nN = N / BM; nwg = nM * nN; G = G_; c = c_; }
    __device__ bool next(int i, Unit& u) const {
        const long L = (long)i * G + c; if (L >= nwg) return false;
        int wgid = (int)L; { const int q = nwg / NXCD, r = nwg % NXCD, xcd = wgid % NXCD, off = wgid / NXCD; wgid = (xcd < r ? xcd * (q + 1) : r * (q + 1) + (xcd - r) * q) + off; }
        const int nig = WGM * nN, gid = wgid / nig, fm = gid * WGM, gsz = (nM - fm) < WGM ? (nM - fm) : WGM;
        u.pm = fm + ((wgid % nig) % gsz); u.pn = (wgid % nig) / gsz; return true;
    }
};
struct ProbStd {
    const char* A; const char* B; int K; unsigned rsA, rsB; size_t hsA, hsB, tsA, tsB;
    __device__ __forceinline__ const char* a_base(const Unit& u) const { return A + (size_t)u.pm * tsA; }
    __device__ __forceinline__ const char* b_base(const Unit& u) const { return B + (size_t)u.pn * tsB; }
};
__device__ __forceinline__ ProbStd make_std(const void* A, int lda, const void* B, int ldb, int K) {
    ProbStd p; p.A = (const char*)A; p.B = (const char*)B; p.K = K; p.rsA = lda * 2; p.rsB = ldb * 2;
    p.hsA = (size_t)128 * lda * 2; p.hsB = (size_t)128 * ldb * 2; p.tsA = 2 * p.hsA; p.tsB = 2 * p.hsB; return p;
}

template <class Epi, class Prob, bool ALIGN_EPI>
__device__ __forceinline__ void gemm_phase(LAS unsigned char* lds, const Prob& P, const StaticOrder& S, const Epi& E) {
    int tid = threadIdx.x; asm volatile("" : "+v"(tid));
    const int wid = __builtin_amdgcn_readfirstlane(tid >> 6), lane = tid & 63, wr = wid >> 2, wc = wid & 3, fr = lane & 15, fq = lane >> 4;
    const int nt = P.K / BK;
    unsigned voffA[2], voffB[2];
#pragma unroll
    for (int i = 0; i < 2; ++i) { int R, C; stage_rc(tid * 16 + i * 8192, R, C); const int Rb = (R & ~31) + perm32(R & 31);
        voffA[i] = (unsigned)R * P.rsA + (unsigned)C * 2u; voffB[i] = (unsigned)Rb * P.rsB + (unsigned)C * 2u; }
    const size_t kstep = (size_t)(BK * 2);
    const size_t hstepA = P.hsA, hstepB = P.hsB;
    const unsigned ldsw = (unsigned)wid * 1024u;
    const unsigned lds0 = (unsigned)(size_t)lds;
    const int aoff = lds_byte(wr * 64 + fr, fq * 8), boff = lds_byte(wc * 32 + fr, fq * 8);
#define PG8_SA(b, h) (((b) * 2 + (h)) * HTB)
#define PG8_SB(b, h) ((4 + (b) * 2 + (h)) * HTB)
#define PG8_STAGE(bufoff, gbase, voff) do { _Pragma("unroll") for (int _i = 0; _i < 2; ++_i) \
        glds16s((gbase), (voff)[_i], lds0 + (unsigned)(bufoff) + ldsw + _i * 8192u); } while (0)
#define PG8_LDA(dst, b, h) do { _Pragma("unroll") for (int m = 0; m < 4; ++m) _Pragma("unroll") for (int k = 0; k < 2; ++k) dst[m][k] = *(const LAS bf16x8*)(lds + PG8_SA(b, h) + aoff + m * 2048 + k * 1024); } while (0)
#define PG8_LDB(dst, b, h) do { _Pragma("unroll") for (int n = 0; n < 2; ++n) _Pragma("unroll") for (int k = 0; k < 2; ++k) dst[n][k] = *(const LAS bf16x8*)(lds + PG8_SB(b, h) + boff + n * 2048 + k * 1024); } while (0)
#define PG8_MMA(ai, bj, At, Bt) do { __builtin_amdgcn_s_setprio(1); _Pragma("unroll") for (int m = 0; m < 4; ++m) _Pragma("unroll") for (int n = 0; n < 2; ++n) _Pragma("unroll") for (int k = 0; k < 2; ++k) \
        acc[ai][bj][m][n] = __builtin_amdgcn_mfma_f32_16x16x32_bf16(Bt[n][k], At[m][k], acc[ai][bj][m][n], 0, 0, 0); __builtin_amdgcn_s_setprio(0); } while (0)
#define PG8_WAIT_V(n) asm volatile("s_waitcnt vmcnt(" #n ")" ::: "memory")
#define PG8_WAIT_L(n) asm volatile("s_waitcnt lgkmcnt(" #n ")" ::: "memory")
#define PG8_BAR __builtin_amdgcn_s_barrier()
#define PG8_SCHED __builtin_amdgcn_sched_barrier(0)
    Unit cur, nxt; int ui = 0;
    if (!S.next(0, cur)) return;
    f32x4 acc[2][2][4][2];
#pragma unroll
    for (int a = 0; a < 2; ++a)
#pragma unroll
        for (int b = 0; b < 2; ++b)
#pragma unroll
            for (int m = 0; m < 4; ++m)
#pragma unroll
                for (int n = 0; n < 2; ++n) acc[a][b][m][n] = (f32x4){0.f, 0.f, 0.f, 0.f};
    bf16x8 At[4][2], B0[2][2], B1[2][2];
    const char* cA = P.a_base(cur); const char* cB = P.b_base(cur);
    PG8_STAGE(PG8_SB(0, 0), cB, voffB); PG8_STAGE(PG8_SB(0, 1), cB + hstepB, voffB); PG8_STAGE(PG8_SA(0, 0), cA, voffA); PG8_STAGE(PG8_SA(0, 1), cA + hstepA, voffA);
    if (wr == 1) PG8_BAR;
    PG8_WAIT_V(2); PG8_BAR;
    PG8_STAGE(PG8_SB(1, 0), cB + kstep, voffB); PG8_STAGE(PG8_SA(1, 0), cA + kstep, voffA); PG8_STAGE(PG8_SB(1, 1), cB + hstepB + kstep, voffB);
    PG8_WAIT_V(6); PG8_BAR;
    for (;;) {
        const bool has_next = S.next(ui + 1, nxt);
        const char* nA = has_next ? P.a_base(nxt) : cA; const char* nB = has_next ? P.b_base(nxt) : cB;
        for (int t = 0; t < nt; t += 2) {
            const bool last = (t == nt - 2);
            const char* a1 = cA + (size_t)(t + 1) * kstep;
            const char* a2 = last ? nA : cA + (size_t)(t + 2) * kstep; const char* b2 = last ? nB : cB + (size_t)(t + 2) * kstep;
            const char* a3 = a2 + kstep; const char* b3 = b2 + kstep;
            PG8_LDB(B0, 0, 0); PG8_LDB(B1, 0, 1); PG8_SCHED; PG8_LDA(At, 0, 0); PG8_STAGE(PG8_SA(1, 1), a1 + hstepA, voffA);
            PG8_WAIT_V(8); PG8_WAIT_L(0); PG8_BAR; PG8_MMA(0, 0, At, B0); PG8_MMA(0, 1, At, B1); PG8_BAR; PG8_SCHED;
            PG8_LDA(At, 0, 1); PG8_STAGE(PG8_SB(0, 0), b2, voffB); PG8_STAGE(PG8_SB(0, 1), b2 + hstepB, voffB); PG8_STAGE(PG8_SA(0, 0), a2, voffA);
            PG8_WAIT_V(8); PG8_WAIT_L(0); PG8_BAR; PG8_MMA(1, 0, At, B0); PG8_MMA(1, 1, At, B1); PG8_BAR; PG8_SCHED;
            PG8_LDB(B0, 1, 0); PG8_LDB(B1, 1, 1); PG8_SCHED; PG8_LDA(At, 1, 0); PG8_STAGE(PG8_SA(0, 1), a2 + hstepA, voffA);
            PG8_WAIT_V(8); PG8_WAIT_L(0); PG8_BAR; PG8_MMA(0, 0, At, B0); PG8_MMA(0, 1, At, B1); PG8_BAR; PG8_SCHED;
            PG8_LDA(At, 1, 1); PG8_STAGE(PG8_SB(1, 0), b3, voffB); PG8_STAGE(PG8_SB(1, 1), b3 + hstepB, voffB); PG8_STAGE(PG8_SA(1, 0), a3, voffA);
            PG8_WAIT_V(8); PG8_WAIT_L(0); PG8_BAR; PG8_MMA(1, 0, At, B0); PG8_MMA(1, 1, At, B1); PG8_BAR; PG8_SCHED;
        }
        if constexpr (ALIGN_EPI) { if (wr == 0) PG8_BAR; }
        { int fr_ = fr, fq_ = fq; asm volatile("" : "+v"(fr_), "+v"(fq_)); E(acc, cur, wr, wc, fr_, fq_); }
        if (!has_next) break;
#pragma unroll
        for (int a = 0; a < 2; ++a)
#pragma unroll
            for (int b = 0; b < 2; ++b)
#pragma unroll
                for (int m = 0; m < 4; ++m)
#pragma unroll
                    for (int n = 0; n < 2; ++n) acc[a][b][m][n] = (f32x4){0.f, 0.f, 0.f, 0.f};
        cur = nxt; cA = nA; cB = nB; ++ui;
        if constexpr (ALIGN_EPI) { if (wr == 1) PG8_BAR; }
    }
    PG8_WAIT_V(0);
    if constexpr (!ALIGN_EPI) { if (wr == 0) PG8_BAR; }
    PG8_BAR;
#undef PG8_SA
#undef PG8_SB
#undef PG8_STAGE
#undef PG8_LDA
#undef PG8_LDB
#undef PG8_MMA
#undef PG8_WAIT_V
#undef PG8_WAIT_L
#undef PG8_BAR
#undef PG8_SCHED
}

typedef f32x4 Acc[2][2][4][2];
struct EpiBf16 {
    bf16_t* O; int ldc;
    __device__ __forceinline__ void operator()(const Acc& acc, const Unit& u, int wr, int wc, int fr, int fq) const {
        const int row0 = u.pm * BM + wr * 64 + fr, col0 = u.pn * BM + wc * 32 + 8 * fq;
#pragma unroll
        for (int ai = 0; ai < 2; ++ai)
#pragma unroll
            for (int m = 0; m < 4; ++m) { bf16_t* rowp = O + (size_t)(row0 + ai * HALF + m * 16) * ldc + col0;
#pragma unroll
                for (int bj = 0; bj < 2; ++bj) { const f32x4 v0 = acc[ai][bj][m][0], v1 = acc[ai][bj][m][1];
                    u32x4 w; w.x = cvt_pk_bf16(v0[0], v0[1]); w.y = cvt_pk_bf16(v0[2], v0[3]); w.z = cvt_pk_bf16(v1[0], v1[1]); w.w = cvt_pk_bf16(v1[2], v1[3]);
                    *(u32x4*)(rowp + bj * HALF) = w; } }
    }
};
struct EpiResid {
    const float* res; float* out; const float* gate0; int gstride;
    __device__ __forceinline__ void operator()(const Acc& acc, const Unit& u, int wr, int wc, int fr, int fq) const {
        const int row0 = u.pm * BM + wr * 64 + fr, col0 = u.pn * BM + wc * 32 + 8 * fq;
        const float* gp = gate0 + (size_t)(u.pm >> 5) * gstride + col0;
        f32x4 g[2][2];
#pragma unroll
        for (int bj = 0; bj < 2; ++bj)
#pragma unroll
            for (int n = 0; n < 2; ++n) g[bj][n] = *(const f32x4*)(gp + bj * HALF + 4 * n);
#pragma unroll
        for (int ai = 0; ai < 2; ++ai)
#pragma unroll
            for (int m = 0; m < 4; ++m) { const size_t off = (size_t)(row0 + ai * HALF + m * 16) * 1024 + col0;
#pragma unroll
                for (int bj = 0; bj < 2; ++bj)
#pragma unroll
                    for (int n = 0; n < 2; ++n) { const f32x4 r = *(const f32x4*)(res + off + bj * HALF + 4 * n);
                        *(f32x4*)(out + off + bj * HALF + 4 * n) = r + g[bj][n] * acc[ai][bj][m][n]; } }
    }
};
struct EpiSwiglu {
    bf16_t* H;
    __device__ __forceinline__ void operator()(const Acc& acc, const Unit& u, int wr, int wc, int fr, int fq) const {
        const int row0 = u.pm * BM + wr * 64 + fr, col0 = u.pn * HALF + wc * 32 + 8 * fq;
#pragma unroll
        for (int ai = 0; ai < 2; ++ai)
#pragma unroll
            for (int m = 0; m < 4; ++m) { bf16_t* rowp = H + (size_t)(row0 + ai * HALF + m * 16) * DFF + col0;
                f32x4 h0, h1;
#pragma unroll
                for (int j = 0; j < 4; ++j) { h0[j] = silu_f(acc[ai][0][m][0][j]) * acc[ai][1][m][0][j]; h1[j] = silu_f(acc[ai][0][m][1][j]) * acc[ai][1][m][1][j]; }
                u32x4 w; w.x = cvt_pk_bf16(h0[0], h0[1]); w.y = cvt_pk_bf16(h0[2], h0[3]); w.z = cvt_pk_bf16(h1[0], h1[1]); w.w = cvt_pk_bf16(h1[2], h1[3]);
                *(u32x4*)rowp = w; }
    }
};
struct EpiG1 {
    bf16_t* Z1;
    __device__ __forceinline__ void operator()(const Acc& acc, const Unit& u, int wr, int wc, int fr, int fq) const {
        const unsigned b = u.pn >> 5, q = u.pn & 31, ns0 = wc * 32 + 8 * fq;
        const unsigned j0 = u.pm * BM + wr * 64 + fr;
        const unsigned cs = j0 >> 10;
        bf16_t* base = Z1 + ((size_t)(b * 1024u) * 64u * 256u + (size_t)(2u * q) * 256u + cs * 128u + ns0);
#pragma unroll
        for (int ai = 0; ai < 2; ++ai)
#pragma unroll
            for (int m = 0; m < 4; ++m) { const unsigned ch = (j0 + ai * HALF + m * 16) & 1023u; bf16_t* rp = base + (size_t)ch * (64u * 256u);
#pragma unroll
                for (int bj = 0; bj < 2; ++bj) { const f32x4 v0 = acc[ai][bj][m][0], v1 = acc[ai][bj][m][1];
                    u32x4 w; w.x = cvt_pk_bf16(v0[0], v0[1]); w.y = cvt_pk_bf16(v0[2], v0[3]); w.z = cvt_pk_bf16(v1[0], v1[1]); w.w = cvt_pk_bf16(v1[2], v1[3]);
                    *(u32x4*)(rp + bj * 256) = w; }
                asm volatile("" ::: "memory"); }
    }
};
struct EpiG2 {
    bf16_t* G2;
    __device__ __forceinline__ void operator()(const Acc& acc, const Unit& u, int wr, int wc, int fr, int fq) const {
        const unsigned rho00 = u.pn * BM + wc * 32 + 8 * fq;
#pragma unroll
        for (int m = 0; m < 4; ++m) { const unsigned ka = wr * 64 + m * 16 + fr; const float kaf = (float)ka * (1.0f / 8192.0f);
#pragma unroll
            for (int bj = 0; bj < 2; ++bj) { const unsigned rho0 = rho00 + bj * HALF, bc = rho0 >> 6, nf0 = rho0 & 63u;
                bf16_t* dp = G2 + ((size_t)(bc * 128u + ka) * 128u + nf0);
#pragma unroll
                for (int n = 0; n < 2; ++n) { const f32x4 gr = acc[0][bj][m][n], gi = acc[1][bj][m][n]; f32x4 o_r, o_i;
#pragma unroll
                    for (int j = 0; j < 4; ++j) { const float rev = (float)(nf0 + 4 * n + j) * kaf; const float c = cos_rev(rev), s = sin_rev(rev);
                        o_r[j] = gr[j] * c + gi[j] * s; o_i[j] = gi[j] * c - gr[j] * s; }
                    u32x2 wre, wim; wre.x = cvt_pk_bf16(o_r[0], o_r[1]); wre.y = cvt_pk_bf16(o_r[2], o_r[3]); wim.x = cvt_pk_bf16(o_i[0], o_i[1]); wim.y = cvt_pk_bf16(o_i[2], o_i[3]);
                    *(u32x2*)(dp + 4 * n) = wre; *(u32x2*)(dp + 64 + 4 * n) = wim;
                    asm volatile("" ::: "memory"); } } }
    }
};
struct EpiG3 {
    float* out; const float* gate0; int gstride;
    __device__ __forceinline__ void operator()(const Acc& acc, const Unit& u, int wr, int wc, int fr, int fq) const {
        if (wr != 0) return;
        const int chblk = u.pn & 3, ka = (u.pn >> 2) & 127, b = u.pn >> 9, ch0 = chblk * 256 + wc * 32 + 8 * fq;
        const float* gp = gate0 + (size_t)b * gstride + ch0;
#pragma unroll
        for (int m = 0; m < 4; ++m) { const int kb = m * 16 + fr; const size_t off = ((size_t)b * 8192 + ka + 128 * kb) * 1024 + ch0;
#pragma unroll
            for (int bj = 0; bj < 2; ++bj)
#pragma unroll
                for (int n = 0; n < 2; ++n) { const f32x4 g = *(const f32x4*)(gp + bj * HALF + 4 * n); const f32x4 r = *(const f32x4*)(out + off + bj * HALF + 4 * n);
                    *(f32x4*)(out + off + bj * HALF + 4 * n) = r + g * acc[0][bj][m][n]; } }
    }
};
struct ProbWc {
    const char* WfT; const char* D; int K; unsigned rsA, rsB; size_t hsA, hsB;
    __device__ __forceinline__ const char* a_base(const Unit& u) const { return WfT + ((size_t)(u.pm & 3) * 256 * 1024 + (size_t)u.pn * 256) * 2; }
    __device__ __forceinline__ const char* b_base(const Unit& u) const { return D + (size_t)(u.pm >> 2) * 256 * 256 * 2; }
};
struct ProbG1 {
    const char* WcT; const char* XN; int K; unsigned rsA, rsB; size_t hsA, hsB;
    __device__ __forceinline__ const char* a_base(const Unit& u) const { return WcT + (size_t)u.pm * 256 * 1024 * 2; }
    __device__ __forceinline__ const char* b_base(const Unit& u) const { return XN + ((size_t)(u.pn >> 5) * 8192 + 2 * (u.pn & 31)) * 2048; }
};
struct ProbG3 {
    const char* W2d; const char* G2; int K; unsigned rsA, rsB; size_t hsA, hsB;
    __device__ __forceinline__ const char* a_base(const Unit&) const { return W2d; }
    __device__ __forceinline__ const char* b_base(const Unit& u) const { const int chblk = u.pn & 3, ka = (u.pn >> 2) & 127, b = u.pn >> 9;
        return G2 + (((size_t)(b * 1024 + chblk * 256) * 128 + ka) * 128) * 2; }
};
}

#define RLX_AGENT __ATOMIC_RELAXED, __HIP_MEMORY_SCOPE_AGENT
#define XB_TMO      128
#define XB_XCNT(j)  (256  + 64 * (j))
#define XB_XSUB(j)  (1280 + 64 * (j))
#define XB_XGEN(j)  (2304 + 64 * (j))
#define XB_TOP      3328
#define XB_TOPGEN   3392
#define XCD_BAR_WORDS 3456
#define XB_SPIN_CAP (1u << 18)

__device__ __forceinline__ unsigned xb_ld(unsigned* p)              { return __hip_atomic_load(p, __ATOMIC_RELAXED, __HIP_MEMORY_SCOPE_AGENT); }
__device__ __forceinline__ unsigned xb_add(unsigned* p, unsigned v) { return __hip_atomic_fetch_add(p, v, __ATOMIC_RELAXED, __HIP_MEMORY_SCOPE_AGENT); }
__device__ __forceinline__ unsigned xb_xcc_id() { return (unsigned)__builtin_amdgcn_s_getreg((3 << 11) | 20) & 0xFu; }
#define XB_SPIN(cond, bar) do { unsigned _sp = 0; while (cond) { __builtin_amdgcn_s_sleep(1); \
    if ((++_sp & 255u) == 0u) { if (xb_ld(&(bar)[XB_TMO])) break; if (_sp > XB_SPIN_CAP) { atomicAdd(&(bar)[XB_TMO], 1u); break; } } } } while (0)

struct XcdBarrier {
    unsigned* bar; unsigned x;
    volatile LAS unsigned* st;
};

__device__ __forceinline__ XcdBarrier xcd_barrier_post(unsigned* bar, volatile LAS unsigned* st) {
    XcdBarrier b; b.bar = bar; b.x = xb_xcc_id(); b.st = st;
    if (threadIdx.x == 0) (void)xb_add(&bar[XB_XCNT(b.x)], 1u);
    return b;
}
__device__ __forceinline__ void xcd_barrier_complete(unsigned* bar, unsigned x, unsigned& nloc, unsigned& nx) {
    const unsigned G = gridDim.x * gridDim.y * gridDim.z;
    unsigned sum, cnt, mine, sp = 0u;
    for (;;) {
        sum = 0u; cnt = 0u; mine = 0u;
#pragma unroll
        for (unsigned j = 0; j < 16; ++j) { const unsigned c = xb_ld(&bar[XB_XCNT(j)]); sum += c; cnt += (c > 0u) ? 1u : 0u; mine = (j == x) ? c : mine; }
        if (sum == G) break;
        __builtin_amdgcn_s_sleep(1);
        if ((++sp & 255u) == 0u) { if (xb_ld(&bar[XB_TMO])) break; if (sp > XB_SPIN_CAP) { atomicAdd(&bar[XB_TMO], 1u); break; } }
    }
    nloc = mine > 0u ? mine : 1u; nx = cnt > 0u ? cnt : 1u;
}

__device__ __forceinline__ void xcd_barrier(const XcdBarrier& b) {
    asm volatile("s_waitcnt vmcnt(0)" ::: "memory");
    __syncthreads();
    if (threadIdx.x == 0) {
        unsigned* bar = b.bar;
        __builtin_amdgcn_s_waitcnt(0);
        unsigned nloc = b.st[0], nx = b.st[1];
        if (nloc == 0u) { xcd_barrier_complete(bar, b.x, nloc, nx); b.st[0] = nloc; b.st[1] = nx; }
        const unsigned old = xb_add(&bar[XB_XSUB(b.x)], 1u);
        const unsigned gen = old / nloc;
        if (old + 1u == (gen + 1u) * nloc) {
            __builtin_amdgcn_fence(__ATOMIC_RELEASE, "agent");
            asm volatile("s_waitcnt vmcnt(0)" ::: "memory");
            const unsigned og = xb_add(&bar[XB_TOP], 1u);
            const unsigned tg = og / nx;
            if (og + 1u == (tg + 1u) * nx) xb_add(&bar[XB_TOPGEN], 1u);
            else XB_SPIN(xb_ld(&bar[XB_TOPGEN]) == tg, bar);
            __builtin_amdgcn_fence(__ATOMIC_ACQUIRE, "agent");
            xb_add(&bar[XB_XGEN(b.x)], 1u);
            asm volatile("s_waitcnt vmcnt(0)" ::: "memory");
        } else {
            XB_SPIN(xb_ld(&bar[XB_XGEN(b.x)]) == gen, bar);
            __builtin_amdgcn_fence(__ATOMIC_ACQUIRE, "agent");
            asm volatile("s_waitcnt vmcnt(0)" ::: "memory");
        }
    }
    __syncthreads();
}
struct Args {
    const float* in[21]; float* out; unsigned char* ws;
};
constexpr int NWAVES = 8, NTHR = 512;
constexpr int LDS_BYTES = 147456;

__device__ __forceinline__ void ada_item(const Args& a, int item, LAS unsigned char* lds, int tid, int lane, int wave) {
    const int layer = item / 96, n0 = (item % 96) * 64;
    LAS float* sil = (LAS float*)lds; LAS float* red = sil + 3072;
    const float* c = a.in[1]; const float* cc = a.in[3];
    for (int i = tid; i < 3072; i += NTHR) { const int v = i >> 10, k = i & 1023; const float cv = (v < 2) ? c[v * 1024 + k] : cc[k]; sil[i] = cv / (1.0f + __expf(-cv)); }
    __syncthreads();
    const float* W = a.in[4] + (size_t)layer * 1024 * 6144 + n0 + lane;
    float a0 = 0.f, a1 = 0.f, a2 = 0.f; const int k0 = wave * 128;
#pragma unroll 8
    for (int kk = 0; kk < 128; ++kk) { const int k = k0 + kk; const float w = W[(size_t)k * 6144]; a0 += sil[k] * w; a1 += sil[1024 + k] * w; a2 += sil[2048 + k] * w; }
    red[(wave * 3 + 0) * 64 + lane] = a0; red[(wave * 3 + 1) * 64 + lane] = a1; red[(wave * 3 + 2) * 64 + lane] = a2;
    __syncthreads();
    if (tid < 192) { const int v = tid >> 6, l = tid & 63; float s = a.in[5][layer * 6144 + n0 + l];
#pragma unroll
        for (int w = 0; w < 8; ++w) s += red[(w * 3 + v) * 64 + l];
        ((float*)(a.ws + WS_MOD))[(layer * 3 + v) * 6144 + n0 + l] = s; }
    __syncthreads();
}
__device__ __forceinline__ void transpose_item(const float* W, int N, bf16_t* WT, int ldk, int k0, int n0, int drow0, LAS float* scr, int lane) {
#pragma unroll 8
    for (int i = 0; i < 32; ++i) { const int kk = 2 * i + (lane >> 5); scr[kk * 33 + (lane & 31)] = W[(size_t)(k0 + kk) * N + n0 + (lane & 31)]; }
    LDS_WAIT(); asm volatile("" ::: "memory");
    const int c = lane & 7;
#pragma unroll
    for (int j = 0; j < 4; ++j) { const int n = (lane >> 3) + 8 * j; const LAS float* s = scr + (8 * c) * 33 + n;
        u32x4 o; o.x = pk2(s[0 * 33], s[1 * 33]); o.y = pk2(s[2 * 33], s[3 * 33]); o.z = pk2(s[4 * 33], s[5 * 33]); o.w = pk2(s[6 * 33], s[7 * 33]);
        *(u32x4*)(WT + (size_t)(drow0 + n) * ldk + k0 + 8 * c) = o; }
    LDS_WAIT(); asm volatile("" ::: "memory");
}
__device__ __forceinline__ void p0_prologue(const Args& a, LAS unsigned char* lds, int tid, int lane, int wave) {
    asm volatile("" : "+v"(lane), "+v"(tid));
    unsigned char* ws = a.ws;
    if (blockIdx.x < 192) ada_item(a, blockIdx.x, lds, tid, lane, wave);
    LAS float* scr = (LAS float*)(lds + wave * 16384);
    const int gw = blockIdx.x * NWAVES + wave, NGW = gridDim.x * NWAVES;
    constexpr int I_IN = 16 * 69, I_UQ = 6 * 24, I_UKV = 4 * 32, I_O = 512, I_F = 512, I_13 = 16 * 88, I_2 = 44 * 32;
    constexpr int NITEMS = I_IN + I_UQ + I_UKV + I_O + I_F + 2 * (2 * I_13 + I_2);
    for (int it = gw; it < NITEMS; it += NGW) {
        int r = it;
        if (r < I_IN) { const int kb = r / 69, nb = r % 69; transpose_item(a.in[8], NIN, (bf16_t*)(ws + WS_WIN), 1024, 64 * kb, 32 * nb, 32 * nb, scr, lane); continue; } r -= I_IN;
        if (r < I_UQ) { const int kb = r / 24, nb = r % 24; transpose_item(a.in[11], 768, (bf16_t*)(ws + WS_WUQ), 384, 64 * kb, 32 * nb, 32 * nb, scr, lane); continue; } r -= I_UQ;
        if (r < I_UKV) { const int kb = r / 32, nb = r % 32; transpose_item(a.in[12], 1024, (bf16_t*)(ws + WS_WUKV), 256, 64 * kb, 32 * nb, 32 * nb, scr, lane); continue; } r -= I_UKV;
        if (r < I_O) { const int kb = r / 32, nb = r % 32; transpose_item(a.in[16], 1024, (bf16_t*)(ws + WS_WO), 1024, 64 * kb, 32 * nb, 32 * nb, scr, lane); continue; } r -= I_O;
        if (r < I_F) { const int kb = r / 32, nb = r % 32; transpose_item(a.in[17], 1024, (bf16_t*)(ws + WS_WF), 1024, 64 * kb, 32 * nb, 32 * nb, scr, lane); continue; } r -= I_F;
        const int layer = r / (2 * I_13 + I_2); r -= layer * (2 * I_13 + I_2);
        if (r < 2 * I_13) { const int s = r / I_13; r -= s * I_13; const int kb = r / 88, nb = r % 88, n0 = 32 * nb;
            transpose_item(a.in[s ? 19 : 18] + (size_t)layer * 1024 * DFF, DFF, (bf16_t*)(ws + WS_W13 + layer * W13_BYTES), 1024, 64 * kb, n0, 256 * (n0 >> 7) + 128 * s + (n0 & 127), scr, lane); continue; }
        r -= 2 * I_13;
        { const int kb = r / 32, nb = r % 32; transpose_item(a.in[20] + (size_t)layer * DFF * 1024, 1024, (bf16_t*)(ws + WS_W2 + layer * W2_BYTES), DFF, 64 * kb, 32 * nb, 32 * nb, scr, lane); }
    }
    const int gt = blockIdx.x * NTHR + tid, NGT = gridDim.x * NTHR;
    { unsigned* z = (unsigned*)(ws + WS_WIN + (size_t)NIN * 1024 * 2); for (int i = gt; i < 96 * 1024 / 2; i += NGT) z[i] = 0u; }
    { bf16_t* d = (bf16_t*)(ws + WS_D256);
      for (int i = gt; i < 131072; i += NGT) { const int cs = i >> 16, c = (i >> 8) & 255, cp = i & 255; const float rev = (float)((c * cp) & 255) * (1.0f / 256.0f);
          const float v = cs ? -sin_rev(rev) : cos_rev(rev); d[i] = (bf16_t)f2bf(v * 0.0625f); } }
    { bf16_t* d = (bf16_t*)(ws + WS_W1D);
      for (int i = gt; i < 65536; i += NGT) { const int row = i >> 8, col = i & 255, ro = row >> 7, ka = row & 127, ri = col >> 7, n = col & 127; const float rev = (float)((n * ka) & 127) * (1.0f / 128.0f);
          const float c = cos_rev(rev), s = sin_rev(rev); const float v = (ro == 0) ? (ri == 0 ? c : s) : (ri == 0 ? -s : c); d[i] = (bf16_t)f2bf(v * 0.08838834764831845f); } }
    { bf16_t* d = (bf16_t*)(ws + WS_W2D);
      for (int i = gt; i < 32768; i += NGT) { const int row = i >> 7, col = i & 127, ri = col >> 6, n2 = col & 63; float v = 0.f;
          if (row < 64) { const float rev = (float)((n2 * row) & 63) * (1.0f / 64.0f); v = (ri == 0 ? cos_rev(rev) : sin_rev(rev)) * 0.125f; }
          d[i] = (bf16_t)f2bf(v); } }
}

__device__ __forceinline__ void norm_row(const float* xrow, bf16_t* orow, const float* g, const float* sc, const float* sh, int lane) {
    const f32x4* xr = (const f32x4*)xrow + lane;
    f32x4 v[4]; float s = 0.f;
#pragma unroll
    for (int j = 0; j < 4; ++j) { v[j] = xr[64 * j]; s += (v[j].x * v[j].x + v[j].y * v[j].y) + (v[j].z * v[j].z + v[j].w * v[j].w); }
    const float rstd = rsqrtf(wave_sum(s) * (1.0f / 1024.0f) + EPS);
    u32x2* o8 = (u32x2*)orow + lane;
#pragma unroll
    for (int j = 0; j < 4; ++j) { const f32x4 gg = ((const f32x4*)g)[64 * j + lane], cc = ((const f32x4*)sc)[64 * j + lane], hh = ((const f32x4*)sh)[64 * j + lane];
        const f32x4 y = v[j] * rstd * gg * (cc + 1.0f) + hh; u32x2 w; w.x = pk2(y.x, y.y); w.y = pk2(y.z, y.w); o8[64 * j] = w; }
}
__device__ __forceinline__ void norm_pass(const float* src, int nrows, bf16_t* dst, const float* g, const float* mod, int sh_chunk, int vfixed, int lane, int wave) {
    asm volatile("" : "+v"(lane));
    const int gw = blockIdx.x * NWAVES + wave, NGW = gridDim.x * NWAVES;
    for (int r = gw; r < nrows; r += NGW) { const int v = vfixed >= 0 ? vfixed : (r >> 13); const float* mv = mod + v * 6144 + sh_chunk * 1024;
        norm_row(src + (size_t)r * 1024, dst + (size_t)r * 1024, g, mv + 1024, mv, lane); }
}

__device__ __forceinline__ float sumsq8(u32x4 c) { float s = 0.f;
#pragma unroll
    for (int i = 0; i < 4; ++i) { const float a = bflo(c[i]), b = bfhi(c[i]); s += a * a + b * b; } return s; }
__device__ __forceinline__ u32x4 scale8(u32x4 c, float r, const float* g) { const f32x4 g0 = *(const f32x4*)g, g1 = *(const f32x4*)(g + 4); u32x4 o;
    o.x = pk2(bflo(c.x) * r * g0.x, bfhi(c.x) * r * g0.y); o.y = pk2(bflo(c.y) * r * g0.z, bfhi(c.y) * r * g0.w);
    o.z = pk2(bflo(c.z) * r * g1.x, bfhi(c.z) * r * g1.y); o.w = pk2(bflo(c.w) * r * g1.z, bfhi(c.w) * r * g1.w); return o; }
__device__ __forceinline__ void prep1_pass(const Args& a, int lane, int wave) {
    asm volatile("" : "+v"(lane));
    unsigned char* ws = a.ws;
    const bf16_t* P = (const bf16_t*)(ws + WS_B); bf16_t* CQN = (bf16_t*)(ws + WS_CQN); bf16_t* CKVN = (bf16_t*)(ws + WS_CKVN); bf16_t* KPE = (bf16_t*)(ws + WS_KPE); bf16_t* MIX = (bf16_t*)(ws + WS_A);
    const float* qg = a.in[9]; const float* kvg = a.in[10]; const float* cw = a.in[15];
    f32x4 w0[2], w1[2], w2[2];
#pragma unroll
    for (int i = 0; i < 2; ++i) { w0[i] = *(const f32x4*)(cw + 8 * lane + 4 * i); w1[i] = *(const f32x4*)(cw + 512 + 8 * lane + 4 * i); w2[i] = *(const f32x4*)(cw + 1024 + 8 * lane + 4 * i); }
    const int gw = blockIdx.x * NWAVES + wave, NGW = gridDim.x * NWAVES;
    for (int r = gw; r < MT; r += NGW) {
        const bf16_t* pr = P + (size_t)r * NINP;
        const u32x4 c1 = *(const u32x4*)(pr + lane * 8);
        u32x4 c2 = (u32x4){0u, 0u, 0u, 0u}; if (lane < 20) c2 = *(const u32x4*)(pr + 512 + lane * 8);
        const float ss1 = sumsq8(c1), ss2 = sumsq8(c2);
        const float sq = wave_sum(lane < 48 ? ss1 : 0.f);
        const float skv = wave_sum((lane >= 48 ? ss1 : 0.f) + (lane < 16 ? ss2 : 0.f));
        const float rq = rsqrtf(sq * (1.0f / 384.0f) + EPS), rkv = rsqrtf(skv * (1.0f / 256.0f) + EPS);
        if (lane < 48) *(u32x4*)(CQN + (size_t)r * QR + 8 * lane) = scale8(c1, rq, qg + 8 * lane);
        else *(u32x4*)(CKVN + (size_t)r * KVR + 8 * (lane - 48)) = scale8(c1, rkv, kvg + 8 * (lane - 48));
        if (lane < 16) *(u32x4*)(CKVN + (size_t)r * KVR + 128 + 8 * lane) = scale8(c2, rkv, kvg + 128 + 8 * lane);
        else if (lane < 20) *(u32x4*)(KPE + (size_t)r * 32 + 8 * (lane - 16)) = c2;
        if (r < ML) {
            const int t = r & (SEQ - 1);
            const bf16_t* cb = pr + 672 + 8 * lane;
            const u32x4 bg = *(const u32x4*)cb, cg0 = *(const u32x4*)(cb + 512), u0 = *(const u32x4*)(cb + 1024);
            u32x4 cgm = (u32x4){0u, 0u, 0u, 0u}, um = cgm, cgp = cgm, up = cgm;
            if (t > 0) { cgm = *(const u32x4*)(cb - NINP + 512); um = *(const u32x4*)(cb - NINP + 1024); }
            if (t < SEQ - 1) { cgp = *(const u32x4*)(cb + NINP + 512); up = *(const u32x4*)(cb + NINP + 1024); }
            u32x4 o;
#pragma unroll
            for (int i = 0; i < 4; ++i) {
                const float zl_m = bflo(cgm[i]) * bflo(um[i]), zh_m = bfhi(cgm[i]) * bfhi(um[i]);
                const float zl_0 = bflo(cg0[i]) * bflo(u0[i]), zh_0 = bfhi(cg0[i]) * bfhi(u0[i]);
                const float zl_p = bflo(cgp[i]) * bflo(up[i]), zh_p = bfhi(cgp[i]) * bfhi(up[i]);
                const int e = 2 * i;
                const float yl = zl_m * w0[e >> 2][e & 3] + zl_0 * w1[e >> 2][e & 3] + zl_p * w2[e >> 2][e & 3];
                const float yh = zh_m * w0[(e + 1) >> 2][(e + 1) & 3] + zh_0 * w1[(e + 1) >> 2][(e + 1) & 3] + zh_p * w2[(e + 1) >> 2][(e + 1) & 3];
                o[i] = pk2(bflo(bg[i]) * yl, bfhi(bg[i]) * yh);
            }
            *(u32x4*)(MIX + (size_t)r * 1024 + 512 + 8 * lane) = o;
        }
    }
}

__device__ __forceinline__ void prep2_pass(const Args& a, LAS unsigned char* lds, int tid, int lane, int wave) {
    asm volatile("" : "+v"(lane), "+v"(tid));
    unsigned char* ws = a.ws;
    bf16_t* Q = (bf16_t*)(ws + WS_Q); const bf16_t* KV = (const bf16_t*)(ws + WS_KV); const bf16_t* KPE = (const bf16_t*)(ws + WS_KPE);
    bf16_t* Kf = (bf16_t*)(ws + WS_KF); bf16_t* Vt = (bf16_t*)(ws + WS_VT);
    const float* qgain = a.in[13]; const float* kgain = a.in[14];
    const int head = lane >> 3, sub = lane & 7;
    const float inv = __builtin_amdgcn_exp2f(-(float)sub * 1.6609640474436813f) * 0.15915494309189535f;
    float qgn[8], kgn[8], qgp[4], kgp[4];
#pragma unroll
    for (int e = 0; e < 8; ++e) { qgn[e] = qgain[8 * sub + e] * QSC; kgn[e] = kgain[8 * sub + e]; }
#pragma unroll
    for (int i = 0; i < 4; ++i) { qgp[i] = qgain[64 + sub + 8 * i] * QSC; kgp[i] = kgain[64 + sub + 8 * i]; }
    for (int blk = blockIdx.x; blk < MT / 64; blk += gridDim.x) {
        const int r0 = blk * 64; const bool latent = blk < 256;
        const int b = latent ? (blk >> 7) : ((blk - 256) >> 2);
        const int key0 = latent ? ((blk & 127) * 64) : (SEQ + ((blk - 256) & 3) * 64);
#pragma unroll
        for (int i = 0; i < 8; ++i) { const int id = tid + 512 * i, row = id >> 6, cc = id & 63, h = cc >> 3, part = cc & 7;
            const u32x4 v = *(const u32x4*)(KV + (size_t)(r0 + row) * 1024 + h * 128 + 64 + part * 8);
            *(LAS u32x4*)(lds + row * 1024 + cc * 16) = v; }
        for (int i = 0; i < 8; ++i) {
            const int r = r0 + 8 * wave + i, kl = 8 * wave + i;
            float cr = 1.f, sr = 0.f, ccol = 1.f, scol = 0.f;
            if (latent) { const int t = r & (SEQ - 1); const float ar = (float)(t >> 6) * inv, ac = (float)(t & 63) * inv;
                cr = cos_rev(ar - floorf(ar)); sr = sin_rev(ar - floorf(ar)); ccol = cos_rev(ac - floorf(ac)); scol = sin_rev(ac - floorf(ac)); }
            const bf16_t* kpe = KPE + (size_t)r * 32;
            if (latent) {
                bf16_t* qp = Q + (size_t)r * 768 + head * 96;
                const u32x4 nv = *(const u32x4*)(qp + 8 * sub);
                float pe[4];
#pragma unroll
                for (int j = 0; j < 4; ++j) pe[j] = bf1(qp[64 + sub + 8 * j]);
                float ss = sumsq8(nv) + (pe[0] * pe[0] + pe[1] * pe[1]) + (pe[2] * pe[2] + pe[3] * pe[3]);
                ss += __shfl_xor(ss, 1); ss += __shfl_xor(ss, 2); ss += __shfl_xor(ss, 4);
                const float rs = rsqrtf(ss * (1.0f / 96.0f) + EPS);
                u32x4 o; o.x = pk2(bflo(nv.x) * rs * qgn[0], bfhi(nv.x) * rs * qgn[1]); o.y = pk2(bflo(nv.y) * rs * qgn[2], bfhi(nv.y) * rs * qgn[3]);
                o.z = pk2(bflo(nv.z) * rs * qgn[4], bfhi(nv.z) * rs * qgn[5]); o.w = pk2(bflo(nv.w) * rs * qgn[6], bfhi(nv.w) * rs * qgn[7]);
                *(u32x4*)(qp + 8 * sub) = o;
                const float p0 = pe[0] * rs * qgp[0], p1 = pe[1] * rs * qgp[1], p2 = pe[2] * rs * qgp[2], p3 = pe[3] * rs * qgp[3];
                qp[64 + sub] = (bf16_t)f2bf(p0 * cr - p1 * sr); qp[72 + sub] = (bf16_t)f2bf(p1 * cr + p0 * sr);
                qp[80 + sub] = (bf16_t)f2bf(p2 * ccol - p3 * scol); qp[88 + sub] = (bf16_t)f2bf(p3 * ccol + p2 * scol);
            }
            {
                const u32x4 nv = *(const u32x4*)(KV + (size_t)r * 1024 + head * 128 + 8 * sub);
                float pe[4];
#pragma unroll
                for (int j = 0; j < 4; ++j) pe[j] = bf1(kpe[sub + 8 * j]);
                float ss = sumsq8(nv) + (pe[0] * pe[0] + pe[1] * pe[1]) + (pe[2] * pe[2] + pe[3] * pe[3]);
                ss += __shfl_xor(ss, 1); ss += __shfl_xor(ss, 2); ss += __shfl_xor(ss, 4);
                const float rs = rsqrtf(ss * (1.0f / 96.0f) + EPS);
                bf16_t* kp = Kf + ((size_t)(b * NH + head) * NKEY + key0 + kl) * DQK;
                u32x4 o; o.x = pk2(bflo(nv.x) * rs * kgn[0], bfhi(nv.x) * rs * kgn[1]); o.y = pk2(bflo(nv.y) * rs * kgn[2], bfhi(nv.y) * rs * kgn[3]);
                o.z = pk2(bflo(nv.z) * rs * kgn[4], bfhi(nv.z) * rs * kgn[5]); o.w = pk2(bflo(nv.w) * rs * kgn[6], bfhi(nv.w) * rs * kgn[7]);
                *(u32x4*)(kp + 8 * sub) = o;
                const float p0 = pe[0] * rs * kgp[0], p1 = pe[1] * rs * kgp[1], p2 = pe[2] * rs * kgp[2], p3 = pe[3] * rs * kgp[3];
                kp[64 + sub] = (bf16_t)f2bf(p0 * cr - p1 * sr); kp[72 + sub] = (bf16_t)f2bf(p1 * cr + p0 * sr);
                kp[80 + sub] = (bf16_t)f2bf(p2 * ccol - p3 * scol); kp[88 + sub] = (bf16_t)f2bf(p3 * ccol + p2 * scol);
            }
        }
        __syncthreads();
        { const int h = tid >> 6, d = tid & 63; bf16_t* vp = Vt + ((size_t)(b * NH + h) * 64 + d) * NKEY + key0;
#pragma unroll
          for (int i = 0; i < 8; ++i) { unsigned short e[8];
#pragma unroll
              for (int k = 0; k < 8; ++k) e[k] = *(const LAS unsigned short*)(lds + (8 * i + k) * 1024 + tid * 2);
              u32x4 o; o.x = e[0] | ((unsigned)e[1] << 16); o.y = e[2] | ((unsigned)e[3] << 16); o.z = e[4] | ((unsigned)e[5] << 16); o.w = e[6] | ((unsigned)e[7] << 16);
              *(u32x4*)(vp + 8 * i) = o; } }
        __syncthreads();
    }
}

__device__ __forceinline__ void attn_phase(const Args& a, LAS unsigned char* lds, int tid, int lane, int wid) {
    asm volatile("" : "+v"(lane), "+v"(tid));
    unsigned char* ws = a.ws;
    const bf16_t* Q = (const bf16_t*)(ws + WS_Q); const bf16_t* Kf = (const bf16_t*)(ws + WS_KF); const bf16_t* Vt = (const bf16_t*)(ws + WS_VT); bf16_t* MIX = (bf16_t*)(ws + WS_A);
    constexpr int BUF = 22528, VOFF = 13312, NT = NKEY / 64;
    const int q = lane & 31, hi = lane >> 5;
    const int xcd = blockIdx.x & 7, l = blockIdx.x >> 3;
    const int kkey0 = tid / 12, kpart0 = tid % 12, kkey1 = (512 + tid) / 12, kpart1 = (512 + tid) % 12;
    const int vd = tid >> 3, vpart = tid & 7;
    for (int it = 0; it < 2; ++it) {
        const int bh = 2 * xcd + it, b = bh >> 3, h = bh & 7, qb = l;
        const size_t qrow = (size_t)b * SEQ + qb * 256 + wid * 32 + q;
        bf16x8 qf[6];
#pragma unroll
        for (int d0 = 0; d0 < 6; ++d0) qf[d0] = *(const bf16x8*)(Q + qrow * 768 + h * 96 + d0 * 16 + hi * 8);
        const bf16_t* Kh = Kf + (size_t)bh * NKEY * DQK; const bf16_t* Vh = Vt + (size_t)bh * 64 * NKEY;
        u32x4 kr0, kr1 = (u32x4){0u, 0u, 0u, 0u}, vr;
        kr0 = *(const u32x4*)(Kh + tid * 8); if (tid < 256) kr1 = *(const u32x4*)(Kh + (512 + tid) * 8);
        vr = *(const u32x4*)(Vh + (size_t)vd * NKEY + vpart * 8);
        *(LAS u32x4*)(lds + kkey0 * 208 + kpart0 * 16) = kr0; if (tid < 256) *(LAS u32x4*)(lds + kkey1 * 208 + kpart1 * 16) = kr1;
        *(LAS u32x2*)(lds + VOFF + vd * 136 + vpart * 16) = (u32x2){vr.x, vr.y}; *(LAS u32x2*)(lds + VOFF + vd * 136 + vpart * 16 + 8) = (u32x2){vr.z, vr.w};
        __syncthreads();
        float m = -1e30f, lsum = 0.f; f32x16 o0 = {}, o1 = {};
        for (int t = 0; t < NT; ++t) {
            const bool more = (t + 1 < NT);
            if (more) { const bf16_t* kt = Kh + (size_t)(t + 1) * 64 * DQK; kr0 = *(const u32x4*)(kt + tid * 8); if (tid < 256) kr1 = *(const u32x4*)(kt + (512 + tid) * 8);
                vr = *(const u32x4*)(Vh + (size_t)vd * NKEY + (t + 1) * 64 + vpart * 8); }
            LAS unsigned char* kb = lds + (t & 1) * BUF;
            f32x16 p0 = {}, p1 = {};
#pragma unroll
            for (int d0 = 0; d0 < 6; ++d0) {
                const bf16x8 a0 = *(const LAS bf16x8*)(kb + q * 208 + d0 * 32 + hi * 16);
                const bf16x8 a1 = *(const LAS bf16x8*)(kb + (32 + q) * 208 + d0 * 32 + hi * 16);
                p0 = __builtin_amdgcn_mfma_f32_32x32x16_bf16(a0, qf[d0], p0, 0, 0, 0);
                p1 = __builtin_amdgcn_mfma_f32_32x32x16_bf16(a1, qf[d0], p1, 0, 0, 0);
            }
            float mx = fmaxf(p0[0], p1[0]);
#pragma unroll
            for (int r = 1; r < 16; ++r) mx = fmaxf(mx, fmaxf(p0[r], p1[r]));
            mx = fmaxf(mx, __shfl_xor(mx, 32));
            const float mn = fmaxf(m, mx), alpha = __builtin_amdgcn_exp2f(m - mn); m = mn;
            float rs = 0.f;
#pragma unroll
            for (int r = 0; r < 16; ++r) { p0[r] = __builtin_amdgcn_exp2f(p0[r] - mn); p1[r] = __builtin_amdgcn_exp2f(p1[r] - mn); rs += p0[r] + p1[r]; }
            lsum = lsum * alpha + rs;
#pragma unroll
            for (int r = 0; r < 16; ++r) { o0[r] *= alpha; o1[r] *= alpha; }
#pragma unroll
            for (int s = 0; s < 4; ++s) {
                u32x4 pw;
                if (s == 0) { pw.x = cvt_pk_bf16(p0[0], p0[1]); pw.y = cvt_pk_bf16(p0[2], p0[3]); pw.z = cvt_pk_bf16(p0[4], p0[5]); pw.w = cvt_pk_bf16(p0[6], p0[7]); }
                else if (s == 1) { pw.x = cvt_pk_bf16(p0[8], p0[9]); pw.y = cvt_pk_bf16(p0[10], p0[11]); pw.z = cvt_pk_bf16(p0[12], p0[13]); pw.w = cvt_pk_bf16(p0[14], p0[15]); }
                else if (s == 2) { pw.x = cvt_pk_bf16(p1[0], p1[1]); pw.y = cvt_pk_bf16(p1[2], p1[3]); pw.z = cvt_pk_bf16(p1[4], p1[5]); pw.w = cvt_pk_bf16(p1[6], p1[7]); }
                else { pw.x = cvt_pk_bf16(p1[8], p1[9]); pw.y = cvt_pk_bf16(p1[10], p1[11]); pw.z = cvt_pk_bf16(p1[12], p1[13]); pw.w = cvt_pk_bf16(p1[14], p1[15]); }
                const bf16x8 pb = __builtin_bit_cast(bf16x8, pw);
                const LAS unsigned char* vb = kb + VOFF + q * 136 + (16 * s + 4 * hi) * 2;
                const s16x4 l0 = *(const LAS s16x4*)(vb), h0 = *(const LAS s16x4*)(vb + 16);
                const s16x4 l1 = *(const LAS s16x4*)(vb + 32 * 136), h1 = *(const LAS s16x4*)(vb + 32 * 136 + 16);
                const bf16x8 va0 = (bf16x8){l0[0], l0[1], l0[2], l0[3], h0[0], h0[1], h0[2], h0[3]};
                const bf16x8 va1 = (bf16x8){l1[0], l1[1], l1[2], l1[3], h1[0], h1[1], h1[2], h1[3]};
                o0 = __builtin_amdgcn_mfma_f32_32x32x16_bf16(va0, pb, o0, 0, 0, 0);
                o1 = __builtin_amdgcn_mfma_f32_32x32x16_bf16(va1, pb, o1, 0, 0, 0);
            }
            if (more) { LAS unsigned char* nb = lds + ((t + 1) & 1) * BUF;
                *(LAS u32x4*)(nb + kkey0 * 208 + kpart0 * 16) = kr0; if (tid < 256) *(LAS u32x4*)(nb + kkey1 * 208 + kpart1 * 16) = kr1;
                *(LAS u32x2*)(nb + VOFF + vd * 136 + vpart * 16) = (u32x2){vr.x, vr.y}; *(LAS u32x2*)(nb + VOFF + vd * 136 + vpart * 16 + 8) = (u32x2){vr.z, vr.w}; }
            __syncthreads();
        }
        const float lt = lsum + __shfl_xor(lsum, 32); const float il = 1.0f / lt;
        bf16_t* op = MIX + qrow * 1024 + h * 64 + 4 * hi;
#pragma unroll
        for (int g = 0; g < 4; ++g) {
            u32x2 w0, w1; w0.x = cvt_pk_bf16(o0[4 * g] * il, o0[4 * g + 1] * il); w0.y = cvt_pk_bf16(o0[4 * g + 2] * il, o0[4 * g + 3] * il);
            w1.x = cvt_pk_bf16(o1[4 * g] * il, o1[4 * g + 1] * il); w1.y = cvt_pk_bf16(o1[4 * g + 2] * il, o1[4 * g + 3] * il);
            *(u32x2*)(op + 8 * g) = w0; *(u32x2*)(op + 32 + 8 * g) = w1;
        }
    }
}

__global__ void __launch_bounds__(NTHR, 2) fwd_kernel(Args a) {
    extern __shared__ __attribute__((aligned(16))) unsigned char lds_raw[];
    LAS unsigned char* lds = (LAS unsigned char*)lds_raw;
    cg::grid_group grid = cg::this_grid();
    unsigned* barw = (unsigned*)a.ws;
    volatile LAS unsigned* bst = (volatile LAS unsigned*)(lds_raw + 131072 + 64);
    if (threadIdx.x < 2) bst[threadIdx.x] = 0u;
    if (blockIdx.x == 0) for (int i = threadIdx.x; i < XCD_BAR_WORDS; i += NTHR) barw[i] = 0u;
    __syncthreads();
    XcdBarrier xbar; xbar.bar = barw; xbar.x = 0; xbar.st = bst;
#define GSYNC() do { for (int s_ = 0; s_ < PROBE_SYNC; ++s_) xcd_barrier(xbar); } while (0)
    const int tid = threadIdx.x, lane = tid & 63, wave = __builtin_amdgcn_readfirstlane(tid >> 6);
    const int G = gridDim.x, cu = blockIdx.x;
    unsigned char* ws = a.ws;
    const float* mod = (const float*)(ws + WS_MOD);
    bf16_t* XN = (bf16_t*)(ws + WS_A);

    p0_prologue(a, lds, tid, lane, wave);
    grid.sync();
    xbar = xcd_barrier_post(barw, bst);
    norm_pass(a.in[0], ML, XN, a.in[6], mod, 0, -1, lane, wave);
    norm_pass(a.in[2], MC, XN + (size_t)ML * 1024, a.in[6], mod, 0, 2, lane, wave);
    GSYNC();
    { pg8::ProbStd p = pg8::make_std(XN, 1024, ws + WS_WIN, 1024, 1024); pg8::StaticOrder S; S.init(MT, NINP, G, cu);
      pg8::EpiBf16 E{(bf16_t*)(ws + WS_B), NINP}; pg8::gemm_phase<pg8::EpiBf16, pg8::ProbStd, true>(lds, p, S, E); }
    { pg8::ProbWc p{(const char*)(ws + WS_WF), (const char*)(ws + WS_D256), 256, 1024 * 2, 256 * 2, (size_t)128 * 1024 * 2, (size_t)128 * 256 * 2};
      pg8::StaticOrder S; S.init(2048, 1024, G, (cu + 32) & 255);
      pg8::EpiBf16 E{(bf16_t*)(ws + WS_WC), 1024}; pg8::gemm_phase<pg8::EpiBf16, pg8::ProbWc, true>(lds, p, S, E); }
    GSYNC();
    prep1_pass(a, lane, wave);
    GSYNC();
    { pg8::ProbStd p = pg8::make_std(ws + WS_CQN, QR, ws + WS_WUQ, QR, QR); pg8::StaticOrder S; S.init(ML, 768, G, cu);
      pg8::EpiBf16 E{(bf16_t*)(ws + WS_Q), 768}; pg8::gemm_phase<pg8::EpiBf16, pg8::ProbStd, true>(lds, p, S, E); }
    { pg8::ProbStd p = pg8::make_std(ws + WS_CKVN, KVR, ws + WS_WUKV, KVR, KVR); pg8::StaticOrder S; S.init(MT, 1024, G, (cu + 64) & 255);
      pg8::EpiBf16 E{(bf16_t*)(ws + WS_KV), 1024}; pg8::gemm_phase<pg8::EpiBf16, pg8::ProbStd, true>(lds, p, S, E); }
    GSYNC();
    prep2_pass(a, lds, tid, lane, wave);
    GSYNC();
    for (int p_ = 0; p_ < PROBE_ATTN; ++p_) attn_phase(a, lds, tid, lane, wave);
    GSYNC();
    { pg8::ProbStd p = pg8::make_std(ws + WS_A, 1024, ws + WS_WO, 1024, 1024); pg8::StaticOrder S; S.init(ML, 1024, G, cu);
      pg8::EpiResid E{a.in[0], a.out, mod + 2 * 1024, 6144}; pg8::gemm_phase<pg8::EpiResid, pg8::ProbStd, true>(lds, p, S, E); }
    GSYNC();
#pragma unroll
    for (int layer = 0; layer < 2; ++layer) {
        const float* modl = mod + layer * 3 * 6144;
        if (layer == 1) {
            norm_pass(a.out, ML, XN, a.in[6] + 1024, modl, 0, -1, lane, wave);
            GSYNC();
            { pg8::ProbG1 p{(const char*)(ws + WS_WC), (const char*)XN, 1024, 1024 * 2, 64 * 2048, (size_t)128 * 1024 * 2, (size_t)2048};
              pg8::StaticOrder S; S.init(2048, 16384, G, cu);
              pg8::EpiG1 E{(bf16_t*)(ws + WS_Z1)}; pg8::gemm_phase<pg8::EpiG1, pg8::ProbG1, true>(lds, p, S, E); }
            GSYNC();
            { pg8::ProbStd p = pg8::make_std(ws + WS_W1D, 256, ws + WS_Z1, 256, 256); pg8::StaticOrder S; S.init(256, 131072, G, cu);
              pg8::EpiG2 E{(bf16_t*)(ws + WS_G2)}; pg8::gemm_phase<pg8::EpiG2, pg8::ProbStd, true>(lds, p, S, E); }
            GSYNC();
            { pg8::ProbG3 p{(const char*)(ws + WS_W2D), (const char*)(ws + WS_G2), 128, 128 * 2, 128 * 128 * 2, (size_t)128 * 128 * 2, (size_t)128 * 128 * 128 * 2};
              pg8::StaticOrder S; S.init(256, 262144, G, cu);
              pg8::EpiG3 E{a.out, modl + 2 * 1024, 6144}; pg8::gemm_phase<pg8::EpiG3, pg8::ProbG3, true>(lds, p, S, E); }
            GSYNC();
        }
        norm_pass(a.out, ML, XN, a.in[7] + layer * 1024, modl, 3, -1, lane, wave);
        GSYNC();
        { pg8::ProbStd p = pg8::make_std(XN, 1024, ws + WS_W13 + layer * W13_BYTES, 1024, 1024); pg8::StaticOrder S; S.init(ML, 2 * DFF, G, cu);
          pg8::EpiSwiglu E{(bf16_t*)(ws + WS_H)}; for (int p_ = 0; p_ < PROBE_FFNUP; ++p_) pg8::gemm_phase<pg8::EpiSwiglu, pg8::ProbStd, true>(lds, p, S, E); }
        GSYNC();
        { pg8::ProbStd p = pg8::make_std(ws + WS_H, DFF, ws + WS_W2 + layer * W2_BYTES, DFF, DFF); pg8::StaticOrder S; S.init(ML, 1024, G, cu);
          pg8::EpiResid E{a.out, a.out, modl + 5 * 1024, 6144}; pg8::gemm_phase<pg8::EpiResid, pg8::ProbStd, true>(lds, p, S, E); }
        if (layer == 0) GSYNC();
    }
}

extern "C" void kernel_launch(void* const* d_in, const int* in_sizes, int n_in, void* d_out, int out_size, void* d_ws, size_t ws_size, hipStream_t stream) {
    static int grid = 0;
    if (grid == 0) {
        if (n_in != 21 || out_size != ML * DM || ws_size < WS_END) { fprintf(stderr, "kernel_launch: unexpected problem (n_in %d out %d ws %zu)\n", n_in, out_size, ws_size); grid = -1; return; }
        int dev = 0, cus = 0, per_cu = 0;
        (void)hipGetDevice(&dev);
        (void)hipDeviceGetAttribute(&cus, hipDeviceAttributeMultiprocessorCount, dev);
        (void)hipFuncSetAttribute((const void*)fwd_kernel, hipFuncAttributeMaxDynamicSharedMemorySize, LDS_BYTES);
        (void)hipOccupancyMaxActiveBlocksPerMultiprocessor(&per_cu, (const void*)fwd_kernel, NTHR, LDS_BYTES);
        (void)hipGetLastError();
        grid = 256;
        if (cus < 256 || per_cu < 1) fprintf(stderr, "kernel_launch: cus %d per_cu %d\n", cus, per_cu);
    }
    if (grid < 0) return;
    Args a{};
    for (int i = 0; i < 21; ++i) a.in[i] = (const float*)d_in[i];
    a.out = (float*)d_out; a.ws = (unsigned char*)d_ws;
    void* args[] = {&a};
    hipError_t e = hipLaunchCooperativeKernel((const void*)fwd_kernel, dim3(grid), dim3(NTHR), args, LDS_BYTES, stream);
    if (e != hipSuccess) fprintf(stderr, "cooperative launch failed: %s\n", hipGetErrorString(e));
}
```

```cpp
#include <hip/hip_runtime.h>
#include <hip/hip_cooperative_groups.h>
#include <cstdio>
#include <cstdint>
namespace cg = cooperative_groups;
#ifndef PROBE_SYNC
#define PROBE_SYNC 1
#endif
#ifndef PROBE_ATTN
#define PROBE_ATTN 1
#endif
#ifndef PROBE_FFNUP
#define PROBE_FFNUP 1
#endif

#define LAS __attribute__((address_space(3)))
typedef unsigned short bf16_t;
typedef short bf16x8 __attribute__((ext_vector_type(8)));
typedef short s16x4 __attribute__((ext_vector_type(4)));
typedef float f32x4 __attribute__((ext_vector_type(4)));
typedef float f32x16 __attribute__((ext_vector_type(16)));
typedef unsigned u32x4 __attribute__((ext_vector_type(4)));
typedef unsigned u32x2 __attribute__((ext_vector_type(2)));
typedef float f32x2 __attribute__((ext_vector_type(2)));

constexpr int DM = 1024, SEQ = 8192, ML = 16384, MC = 512, MT = ML + MC;
constexpr int NINP = 2304, NIN = 2208, QR = 384, KVR = 256, NH = 8, DQK = 96, DFF = 2816, NKEY = 8448;
constexpr float EPS = 1e-6f;
constexpr float QSC = 0.10206207261596575f * 1.4426950408889634f;

constexpr size_t MiB = 1u << 20;
constexpr size_t WS_MOD = 1 * MiB;
constexpr size_t WS_WIN = 2 * MiB;
constexpr size_t WS_WUQ = WS_WIN + (size_t)NINP * 1024 * 2;
constexpr size_t WS_WUKV = WS_WUQ + (size_t)768 * 384 * 2;
constexpr size_t WS_WO = WS_WUKV + (size_t)1024 * 256 * 2;
constexpr size_t WS_WF = WS_WO + 2 * MiB;
constexpr size_t WS_WC = WS_WF + 2 * MiB;
constexpr size_t WS_D256 = WS_WC + 4 * MiB;
constexpr size_t WS_W1D = WS_D256 + 262144;
constexpr size_t WS_W2D = WS_W1D + 131072;
constexpr size_t WS_W13 = WS_W2D + 65536;
constexpr size_t W13_BYTES = (size_t)2 * DFF * 1024 * 2;
constexpr size_t WS_W2 = WS_W13 + 2 * W13_BYTES;
constexpr size_t W2_BYTES = (size_t)1024 * DFF * 2;
constexpr size_t WS_WEND = WS_W2 + 2 * W2_BYTES;
static_assert(WS_WEND <= 56 * MiB, "weights");
constexpr size_t WS_A = 56 * MiB;
constexpr size_t WS_B = 89 * MiB;
constexpr size_t WS_Q = WS_B;
constexpr size_t WS_KV = WS_B + 24 * MiB;
constexpr size_t WS_C = 164 * MiB;
constexpr size_t WS_CQN = WS_C;
constexpr size_t WS_CKVN = WS_C + 12 * MiB + 512 * 1024;
constexpr size_t WS_KF = WS_C;
constexpr size_t WS_VT = WS_C + 25 * MiB;
constexpr size_t WS_KPE = 206 * MiB;
constexpr size_t WS_H = WS_B;
constexpr size_t WS_Z1 = WS_B;
constexpr size_t WS_G2 = WS_B + 64 * MiB;
constexpr size_t WS_XB = 218 * MiB;
constexpr size_t WS_END = 256 * MiB;

__device__ __forceinline__ unsigned f2bf(float f) { unsigned u = __builtin_bit_cast(unsigned, f); return (u + 0x7fffu + ((u >> 16) & 1u)) >> 16; }
__device__ __forceinline__ unsigned pk2(float lo, float hi) { return f2bf(lo) | (f2bf(hi) << 16); }
__device__ __forceinline__ float bflo(unsigned w) { return __builtin_bit_cast(float, w << 16); }
__device__ __forceinline__ float bfhi(unsigned w) { return __builtin_bit_cast(float, w & 0xffff0000u); }
__device__ __forceinline__ float bf1(bf16_t h) { return __builtin_bit_cast(float, (unsigned)h << 16); }
__device__ __forceinline__ unsigned cvt_pk_bf16(float lo, float hi) { unsigned r; asm volatile("v_cvt_pk_bf16_f32 %0, %1, %2" : "=v"(r) : "v"(lo), "v"(hi)); return r; }
__device__ __forceinline__ float wave_sum(float v) {
#pragma unroll
    for (int o = 1; o < 64; o <<= 1) v += __shfl_xor(v, o);
    return v;
}
__device__ __forceinline__ float sin_rev(float r) { return __builtin_amdgcn_sinf(r); }
__device__ __forceinline__ float cos_rev(float r) { return __builtin_amdgcn_cosf(r); }
__device__ __forceinline__ float silu_f(float x) { return x * __builtin_amdgcn_rcpf(1.0f + __builtin_amdgcn_exp2f(-1.4426950408889634f * x)); }
#define LDS_WAIT() asm volatile("s_waitcnt lgkmcnt(0)" ::: "memory")

namespace pg8 {
constexpr int BM = 256, BK = 64, HALF = 128, HTB = HALF * BK * 2, STAGE_BYTES = 8 * HTB, NXCD = 8, WGM = 8;
__host__ __device__ __forceinline__ int lds_byte(int r, int c) { const int st = (r >> 4) * 2 + (c >> 5), rr = r & 15, cc = c & 31, ob = rr * 64 + cc * 2; return st * 1024 + (ob ^ (((ob >> 9) & 1) << 5)); }
__host__ __device__ __forceinline__ void stage_rc(int b, int& R, int& C) { const int st = b / 1024, sb = b % 1024, swz = sb ^ (((sb >> 9) & 1) << 5); R = (st >> 1) * 16 + swz / 64; C = (st & 1) * 32 + (swz % 64) / 2; }
__host__ __device__ __forceinline__ int perm32(int rho) { const int n = rho >> 4, i = rho & 15; return 8 * (i >> 2) + 4 * n + (i & 3); }

__device__ __forceinline__ void glds16s(const char* sbase, unsigned voff, unsigned lds_dst) { unsigned keep;
    asm volatile("s_mov_b32 %0, m0\n\ts_mov_b32 m0, %3\n\ts_nop 0\n\tglobal_load_lds_dwordx4 %1, %2\n\ts_mov_b32 m0, %0" : "=&s"(keep) : "v"(voff), "s"(sbase), "s"(lds_dst) : "memory"); }
struct Unit { int pm, pn; };
struct StaticOrder {
    int nM, nN, nwg, G, c;
    __device__ void init(int M, int N, int G_, int c_) { nM = M / BM; nN = N / BM; nwg = nM * nN; G = G_; c = c_; }
    __device__ bool next(int i, Unit& u) const {
        const long L = (long)i * G + c; if (L >= nwg) return false;
        int wgid = (int)L; { const int q = nwg / NXCD, r = nwg % NXCD, xcd = wgid % NXCD, off = wgid / NXCD; wgid = (xcd < r ? xcd * (q + 1) : r * (q + 1) + (xcd - r) * q) + off; }
        const int nig = WGM * nN, gid = wgid / nig, fm = gid * WGM, gsz = (nM - fm) < WGM ? (nM - fm) : WGM;
        u.pm = fm + ((wgid % nig) % gsz); u.pn = (wgid % nig) / gsz; return true;
    }
};
struct ProbStd {
    const char* A; const char* B; int K; unsigned rsA, rsB; size_t hsA, hsB, tsA, tsB;
    __device__ __forceinline__ const char* a_base(const Unit& u) const { return A + (size_t)u.pm * tsA; }
    __device__ __forceinline__ const char* b_base(const Unit& u) const { return B + (size_t)u.pn * tsB; }
};
__device__ __forceinline__ ProbStd make_std(const void* A, int lda, const void* B, int ldb, int K) {
    ProbStd p; p.A = (const char*)A; p.B = (const char*)B; p.K = K; p.rsA = lda * 2; p.rsB = ldb * 2;
    p.hsA = (size_t)128 * lda * 2; p.hsB = (size_t)128 * ldb * 2; p.tsA = 2 * p.hsA; p.tsB = 2 * p.hsB; return p;
}

template <class Epi, class Prob, bool ALIGN_EPI>
__device__ __forceinline__ void gemm_phase(LAS unsigned char* lds, const Prob& P, const StaticOrder& S, const Epi& E) {
    int tid = threadIdx.x; asm volatile("" : "+v"(tid));
    const int wid = __builtin_amdgcn_readfirstlane(tid >> 6), lane = tid & 63, wr = wid >> 2, wc = wid & 3, fr = lane & 15, fq = lane >> 4;
    const int nt = P.K / BK;
    unsigned voffA[2], voffB[2];
#pragma unroll
    for (int i = 0; i < 2; ++i) { int R, C; stage_rc(tid * 16 + i * 8192, R, C); const int Rb = (R & ~31) + perm32(R & 31);
        voffA[i] = (unsigned)R * P.rsA + (unsigned)C * 2u; voffB[i] = (unsigned)Rb * P.rsB + (unsigned)C * 2u; }
    const size_t kstep = (size_t)(BK * 2);
    const size_t hstepA = P.hsA, hstepB = P.hsB;
    const unsigned ldsw = (unsigned)wid * 1024u;
    const unsigned lds0 = (unsigned)(size_t)lds;
    const int aoff = lds_byte(wr * 64 + fr, fq * 8), boff = lds_byte(wc * 32 + fr, fq * 8);
#define PG8_SA(b, h) (((b) * 2 + (h)) * HTB)
#define PG8_SB(b, h) ((4 + (b) * 2 + (h)) * HTB)
#define PG8_STAGE(bufoff, gbase, voff) do { _Pragma("unroll") for (int _i = 0; _i < 2; ++_i) \
        glds16s((gbase), (voff)[_i], lds0 + (unsigned)(bufoff) + ldsw + _i * 8192u); } while (0)
#define PG8_LDA(dst, b, h) do { _Pragma("unroll") for (int m = 0; m < 4; ++m) _Pragma("unroll") for (int k = 0; k < 2; ++k) dst[m][k] = *(const LAS bf16x8*)(lds + PG8_SA(b, h) + aoff + m * 2048 + k * 1024); } while (0)
#define PG8_LDB(dst, b, h) do { _Pragma("unroll") for (int n = 0; n < 2; ++n) _Pragma("unroll") for (int k = 0; k < 2; ++k) dst[n][k] = *(const LAS bf16x8*)(lds + PG8_SB(b, h) + boff + n * 2048 + k * 1024); } while (0)
#define PG8_MMA(ai, bj, At, Bt) do { __builtin_amdgcn_s_setprio(1); _Pragma("unroll") for (int m = 0; m < 4; ++m) _Pragma("unroll") for (int n = 0; n < 2; ++n) _Pragma("unroll") for (int k = 0; k < 2; ++k) \
        acc[ai][bj][m][n] = __builtin_amdgcn_mfma_f32_16x16x32_bf16(Bt[n][k], At[m][k], acc[ai][bj][m][n], 0, 0, 0); __builtin_amdgcn_s_setprio(0); } while (0)
#define PG8_WAIT_V(n) asm volatile("s_waitcnt vmcnt(" #n ")" ::: "memory")
#define PG8_WAIT_L(n) asm volatile("s_waitcnt lgkmcnt(" #n ")" ::: "memory")
#define PG8_BAR __builtin_amdgcn_s_barrier()
#define PG8_SCHED __builtin_amdgcn_sched_barrier(0)
    Unit cur, nxt; int ui = 0;
    if (!S.next(0, cur)) return;
    f32x4 acc[2][2][4][2];
#pragma unroll
    for (int a = 0; a < 2; ++a)
#pragma unroll
        for (int b = 0; b < 2; ++b)
#pragma unroll
            for (int m = 0; m < 4; ++m)
#pragma unroll
                for (int n = 0; n < 2; ++n) acc[a][b][m][n] = (f32x4){0.f, 0.f, 0.f, 0.f};
    bf16x8 At[4][2], B0[2][2], B1[2][2];
    const char* cA = P.a_base(cur); const char* cB = P.b_base(cur);
    PG8_STAGE(PG8_SB(0, 0), cB, voffB); PG8_STAGE(PG8_SB(0, 1), cB + hstepB, voffB); PG8_STAGE(PG8_SA(0, 0), cA, voffA); PG8_STAGE(PG8_SA(0, 1), cA + hstepA, voffA);
    if (wr == 1) PG8_BAR;
    PG8_WAIT_V(2); PG8_BAR;
    PG8_STAGE(PG8_SB(1, 0), cB + kstep, voffB); PG8_STAGE(PG8_SA(1, 0), cA + kstep, voffA); PG8_STAGE(PG8_SB(1, 1), cB + hstepB + kstep, voffB);
    PG8_WAIT_V(6); PG8_BAR;
    for (;;) {
        const bool has_next = S.next(ui + 1, nxt);
        const char* nA = has_next ? P.a_base(nxt) : cA; const char* nB = has_next ? P.b_base(nxt) : cB;
        for (int t = 0; t < nt; t += 2) {
            const bool last = (t == nt - 2);
            const char* a1 = cA + (size_t)(t + 1) * kstep;
            const char* a2 = last ? nA : cA + (size_t)(t + 2) * kstep; const char* b2 = last ? nB : cB + (size_t)(t + 2) * kstep;
            const char* a3 = a2 + kstep; const char* b3 = b2 + kstep;
            PG8_LDB(B0, 0, 0); PG8_LDB(B1, 0, 1); PG8_SCHED; PG8_LDA(At, 0, 0); PG8_STAGE(PG8_SA(1, 1), a1 + hstepA, voffA);
            PG8_WAIT_V(8); PG8_WAIT_L(0); PG8_BAR; PG8_MMA(0, 0, At, B0); PG8_MMA(0, 1, At, B1); PG8_BAR; PG8_SCHED;
            PG8_LDA(At, 0, 1); PG8_STAGE(PG8_SB(0, 0), b2, voffB); PG8_STAGE(PG8_SB(0, 1), b2 + hstepB, voffB); PG8_STAGE(PG8_SA(0, 0), a2, voffA);
            PG8_WAIT_V(8); PG8_WAIT_L(0); PG8_BAR; PG8_MMA(1, 0, At, B0); PG8_MMA(1, 1, At, B1); PG8_BAR; PG8_SCHED;
            PG8_LDB(B0, 1, 0); PG8_LDB(B1, 1, 1); PG8_SCHED; PG8_LDA(At, 1, 0); PG8_STAGE(PG8_SA(0, 1), a2 + hstepA, voffA);
            PG8_WAIT_V(8); PG8_WAIT_L(0); PG8_BAR; PG8_MMA(0, 0, At, B0); PG8_MMA(0, 1, At, B1); PG8_BAR; PG8_SCHED;
            PG8_LDA(At, 1, 1); PG8_STAGE(PG8_SB(1, 0), b3, voffB); PG8_STAGE(PG8_SB(1, 1), b3 + hstepB, voffB); PG8_STAGE(PG8_SA(1, 0), a3, voffA);
            PG8_WAIT_V(8); PG8_WAIT_L(0); PG8_BAR; PG8_MMA(1, 0, At, B0); PG8_MMA(1, 1, At, B1); PG8_BAR; PG8_SCHED;
        }
        if constexpr (ALIGN_EPI) { if (wr == 0) PG8_BAR; }
        { int fr_ = fr, fq_ = fq; asm volatile("" : "+v"(fr_), "+v"(fq_)); E(acc, cur, wr, wc, fr_, fq_); }
        if (!has_next) break;
#pragma unroll
        for (int a = 0; a < 2; ++a)
#pragma unroll
            for (int b = 0; b < 2; ++b)
#pragma unroll
                for (int m = 0; m < 4; ++m)
#pragma unroll
                    for (int n = 0; n < 2; ++n) acc[a][b][m][n] = (f32x4){0.f, 0.f, 0.f, 0.f};
        cur = nxt; cA = nA; cB = nB; ++ui;
        if constexpr (ALIGN_EPI) { if (wr == 1) PG8_BAR; }
    }
    PG8_WAIT_V(0);
    if constexpr (!ALIGN_EPI) { if (wr == 0) PG8_BAR; }
    PG8_BAR;
#undef PG8_SA
#undef PG8_SB
#undef PG8_STAGE
#undef PG8_LDA
#undef PG8_LDB
#undef PG8_MMA
#undef PG8_WAIT_V
#undef PG8_WAIT_L
#undef PG8_BAR
#undef PG8_SCHED
}

typedef f32x4 Acc[2][2][4][2];
struct EpiBf16 {
    bf16_t* O; int ldc;
    __device__ __forceinline__ void operator()(const Acc& acc, const Unit& u, int wr, int wc, int fr, int fq) const {
        const int row0 = u.pm * BM + wr * 64 + fr, col0 = u.pn * BM + wc * 32 + 8 * fq;
#pragma unroll
        for (int ai = 0; ai < 2; ++ai)
#pragma unroll
            for (int m = 0; m < 4; ++m) { bf16_t* rowp = O + (size_t)(row0 + ai * HALF + m * 16) * ldc + col0;
#pragma unroll
                for (int bj = 0; bj < 2; ++bj) { const f32x4 v0 = acc[ai][bj][m][0], v1 = acc[ai][bj][m][1];
                    u32x4 w; w.x = cvt_pk_bf16(v0[0], v0[1]); w.y = cvt_pk_bf16(v0[2], v0[3]); w.z = cvt_pk_bf16(v1[0], v1[1]); w.w = cvt_pk_bf16(v1[2], v1[3]);
                    *(u32x4*)(rowp + bj * HALF) = w; } }
    }
};
__device__ __forceinline__ void ld8(const float* p, f32x4& a, f32x4& b) { a = *(const f32x4*)p; b = *(const f32x4*)(p + 4); }
__device__ __forceinline__ void ld8(const bf16_t* p, f32x4& a, f32x4& b) { const u32x4 w = *(const u32x4*)p; a = (f32x4){bflo(w.x), bfhi(w.x), bflo(w.y), bfhi(w.y)}; b = (f32x4){bflo(w.z), bfhi(w.z), bflo(w.w), bfhi(w.w)}; }
__device__ __forceinline__ void st8(float* p, const f32x4& a, const f32x4& b) { *(f32x4*)p = a; *(f32x4*)(p + 4) = b; }
__device__ __forceinline__ void st8(bf16_t* p, const f32x4& a, const f32x4& b) { u32x4 w; w.x = cvt_pk_bf16(a[0], a[1]); w.y = cvt_pk_bf16(a[2], a[3]); w.z = cvt_pk_bf16(b[0], b[1]); w.w = cvt_pk_bf16(b[2], b[3]); *(u32x4*)p = w; }
template <class TR, class TO> struct EpiResid {
    const TR* res; TO* out; const float* gate0; int gstride;
    __device__ __forceinline__ void operator()(const Acc& acc, const Unit& u, int wr, int wc, int fr, int fq) const {
        const int row0 = u.pm * BM + wr * 64 + fr, col0 = u.pn * BM + wc * 32 + 8 * fq;
        const float* gp = gate0 + (size_t)(u.pm >> 5) * gstride + col0;
        f32x4 g[2][2];
#pragma unroll
        for (int bj = 0; bj < 2; ++bj)
#pragma unroll
            for (int n = 0; n < 2; ++n) g[bj][n] = *(const f32x4*)(gp + bj * HALF + 4 * n);
#pragma unroll
        for (int ai = 0; ai < 2; ++ai)
#pragma unroll
            for (int m = 0; m < 4; ++m) { const size_t off = (size_t)(row0 + ai * HALF + m * 16) * 1024 + col0;
#pragma unroll
                for (int bj = 0; bj < 2; ++bj) { f32x4 r0, r1; ld8(res + off + bj * HALF, r0, r1);
                    st8(out + off + bj * HALF, r0 + g[bj][0] * acc[ai][bj][m][0], r1 + g[bj][1] * acc[ai][bj][m][1]); } }
    }
};
struct EpiSwiglu {
    bf16_t* H;
    __device__ __forceinline__ void operator()(const Acc& acc, const Unit& u, int wr, int wc, int fr, int fq) const {
        const int row0 = u.pm * BM + wr * 64 + fr, col0 = u.pn * HALF + wc * 32 + 8 * fq;
#pragma unroll
        for (int ai = 0; ai < 2; ++ai)
#pragma unroll
            for (int m = 0; m < 4; ++m) { bf16_t* rowp = H + (size_t)(row0 + ai * HALF + m * 16) * DFF + col0;
                f32x4 h0, h1;
#pragma unroll
                for (int j = 0; j < 4; ++j) { h0[j] = silu_f(acc[ai][0][m][0][j]) * acc[ai][1][m][0][j]; h1[j] = silu_f(acc[ai][0][m][1][j]) * acc[ai][1][m][1][j]; }
                u32x4 w; w.x = cvt_pk_bf16(h0[0], h0[1]); w.y = cvt_pk_bf16(h0[2], h0[3]); w.z = cvt_pk_bf16(h1[0], h1[1]); w.w = cvt_pk_bf16(h1[2], h1[3]);
                *(u32x4*)rowp = w; }
    }
};
struct EpiG1 {
    bf16_t* Z1;
    __device__ __forceinline__ void operator()(const Acc& acc, const Unit& u, int wr, int wc, int fr, int fq) const {
        const unsigned b = u.pn >> 5, q = u.pn & 31, ns0 = wc * 32 + 8 * fq;
        const unsigned j0 = u.pm * BM + wr * 64 + fr;
        const unsigned cs = j0 >> 10;
        bf16_t* base = Z1 + ((size_t)(b * 1024u) * 64u * 256u + (size_t)(2u * q) * 256u + cs * 128u + ns0);
#pragma unroll
        for (int ai = 0; ai < 2; ++ai)
#pragma unroll
            for (int m = 0; m < 4; ++m) { const unsigned ch = (j0 + ai * HALF + m * 16) & 1023u; bf16_t* rp = base + (size_t)ch * (64u * 256u);
#pragma unroll
                for (int bj = 0; bj < 2; ++bj) { const f32x4 v0 = acc[ai][bj][m][0], v1 = acc[ai][bj][m][1];
                    u32x4 w; w.x = cvt_pk_bf16(v0[0], v0[1]); w.y = cvt_pk_bf16(v0[2], v0[3]); w.z = cvt_pk_bf16(v1[0], v1[1]); w.w = cvt_pk_bf16(v1[2], v1[3]);
                    *(u32x4*)(rp + bj * 256) = w; }
                asm volatile("" ::: "memory"); }
    }
};
struct EpiG2 {
    bf16_t* G2;
    __device__ __forceinline__ void operator()(const Acc& acc, const Unit& u, int wr, int wc, int fr, int fq) const {
        const unsigned rho00 = u.pn * BM + wc * 32 + 8 * fq;
#pragma unroll
        for (int m = 0; m < 4; ++m) { const unsigned ka = wr * 64 + m * 16 + fr; const float kaf = (float)ka * (1.0f / 8192.0f);
#pragma unroll
            for (int bj = 0; bj < 2; ++bj) { const unsigned rho0 = rho00 + bj * HALF, bc = rho0 >> 6, nf0 = rho0 & 63u;
                bf16_t* dp = G2 + ((size_t)(bc * 128u + ka) * 128u + nf0);
#pragma unroll
                for (int n = 0; n < 2; ++n) { const f32x4 gr = acc[0][bj][m][n], gi = acc[1][bj][m][n]; f32x4 o_r, o_i;
#pragma unroll
                    for (int j = 0; j < 4; ++j) { const float rev = (float)(nf0 + 4 * n + j) * kaf; const float c = cos_rev(rev), s = sin_rev(rev);
                        o_r[j] = gr[j] * c + gi[j] * s; o_i[j] = gi[j] * c - gr[j] * s; }
                    u32x2 wre, wim; wre.x = cvt_pk_bf16(o_r[0], o_r[1]); wre.y = cvt_pk_bf16(o_r[2], o_r[3]); wim.x = cvt_pk_bf16(o_i[0], o_i[1]); wim.y = cvt_pk_bf16(o_i[2], o_i[3]);
                    *(u32x2*)(dp + 4 * n) = wre; *(u32x2*)(dp + 64 + 4 * n) = wim;
                    asm volatile("" ::: "memory"); } } }
    }
};
struct EpiG3 {
    bf16_t* out; const float* gate0; int gstride;
    __device__ __forceinline__ void operator()(const Acc& acc, const Unit& u, int wr, int wc, int fr, int fq) const {
        if (wr != 0) return;
        const int chblk = u.pn & 3, ka = (u.pn >> 2) & 127, b = u.pn >> 9, ch0 = chblk * 256 + wc * 32 + 8 * fq;
        const float* gp = gate0 + (size_t)b * gstride + ch0;
#pragma unroll
        for (int m = 0; m < 4; ++m) { const int kb = m * 16 + fr; const size_t off = ((size_t)b * 8192 + ka + 128 * kb) * 1024 + ch0;
#pragma unroll
            for (int bj = 0; bj < 2; ++bj) { const f32x4 g0 = *(const f32x4*)(gp + bj * HALF), g1 = *(const f32x4*)(gp + bj * HALF + 4); f32x4 r0, r1; ld8(out + off + bj * HALF, r0, r1);
                st8(out + off + bj * HALF, r0 + g0 * acc[0][bj][m][0], r1 + g1 * acc[0][bj][m][1]); } }
    }
};
struct ProbWc {
    const char* WfT; const char* D; int K; unsigned rsA, rsB; size_t hsA, hsB;
    __device__ __forceinline__ const char* a_base(const Unit& u) const { return WfT + ((size_t)(u.pm & 3) * 256 * 1024 + (size_t)u.pn * 256) * 2; }
    __device__ __forceinline__ const char* b_base(const Unit& u) const { return D + (size_t)(u.pm >> 2) * 256 * 256 * 2; }
};
struct ProbG1 {
    const char* WcT; const char* XN; int K; unsigned rsA, rsB; size_t hsA, hsB;
    __device__ __forceinline__ const char* a_base(const Unit& u) const { return WcT + (size_t)u.pm * 256 * 1024 * 2; }
    __device__ __forceinline__ const char* b_base(const Unit& u) const { return XN + ((size_t)(u.pn >> 5) * 8192 + 2 * (u.pn & 31)) * 2048; }
};
struct ProbG3 {
    const char* W2d; const char* G2; int K; unsigned rsA, rsB; size_t hsA, hsB;
    __device__ __forceinline__ const char* a_base(const Unit&) const { return W2d; }
    __device__ __forceinline__ const char* b_base(const Unit& u) const { const int chblk = u.pn & 3, ka = (u.pn >> 2) & 127, b = u.pn >> 9;
        return G2 + (((size_t)(b * 1024 + chblk * 256) * 128 + ka) * 128) * 2; }
};
}

#define RLX_AGENT __ATOMIC_RELAXED, __HIP_MEMORY_SCOPE_AGENT
#define XB_TMO      128
#define XB_XCNT(j)  (256  + 64 * (j))
#define XB_XSUB(j)  (1280 + 64 * (j))
#define XB_XGEN(j)  (2304 + 64 * (j))
#define XB_TOP      3328
#define XB_TOPGEN   3392
#define XCD_BAR_WORDS 3456
#define XB_SPIN_CAP (1u << 18)

__device__ __forceinline__ unsigned xb_ld(unsigned* p)              { return __hip_atomic_load(p, __ATOMIC_RELAXED, __HIP_MEMORY_SCOPE_AGENT); }
__device__ __forceinline__ unsigned xb_add(unsigned* p, unsigned v) { return __hip_atomic_fetch_add(p, v, __ATOMIC_RELAXED, __HIP_MEMORY_SCOPE_AGENT); }
__device__ __forceinline__ unsigned xb_xcc_id() { return (unsigned)__builtin_amdgcn_s_getreg((3 << 11) | 20) & 0xFu; }
#define XB_SPIN(cond, bar) do { unsigned _sp = 0; while (cond) { __builtin_amdgcn_s_sleep(1); \
    if ((++_sp & 255u) == 0u) { if (xb_ld(&(bar)[XB_TMO])) break; if (_sp > XB_SPIN_CAP) { atomicAdd(&(bar)[XB_TMO], 1u); break; } } } } while (0)

struct XcdBarrier {
    unsigned* bar; unsigned x;
    volatile LAS unsigned* st;
};

__device__ __forceinline__ XcdBarrier xcd_barrier_post(unsigned* bar, volatile LAS unsigned* st) {
    XcdBarrier b; b.bar = bar; b.x = xb_xcc_id(); b.st = st;
    if (threadIdx.x == 0) (void)xb_add(&bar[XB_XCNT(b.x)], 1u);
    return b;
}
__device__ __forceinline__ void xcd_barrier_complete(unsigned* bar, unsigned x, unsigned& nloc, unsigned& nx) {
    const unsigned G = gridDim.x * gridDim.y * gridDim.z;
    unsigned sum, cnt, mine, sp = 0u;
    for (;;) {
        sum = 0u; cnt = 0u; mine = 0u;
#pragma unroll
        for (unsigned j = 0; j < 16; ++j) { const unsigned c = xb_ld(&bar[XB_XCNT(j)]); sum += c; cnt += (c > 0u) ? 1u : 0u; mine = (j == x) ? c : mine; }
        if (sum == G) break;
        __builtin_amdgcn_s_sleep(1);
        if ((++sp & 255u) == 0u) { if (xb_ld(&bar[XB_TMO])) break; if (sp > XB_SPIN_CAP) { atomicAdd(&bar[XB_TMO], 1u); break; } }
    }
    nloc = mine > 0u ? mine : 1u; nx = cnt > 0u ? cnt : 1u;
}

__device__ __forceinline__ void xcd_barrier(const XcdBarrier& b) {
    asm volatile("s_waitcnt vmcnt(0)" ::: "memory");
    __syncthreads();
    if (threadIdx.x == 0) {
        unsigned* bar = b.bar;
        __builtin_amdgcn_s_waitcnt(0);
        unsigned nloc = b.st[0], nx = b.st[1];
        if (nloc == 0u) { xcd_barrier_complete(bar, b.x, nloc, nx); b.st[0] = nloc; b.st[1] = nx; }
        const unsigned old = xb_add(&bar[XB_XSUB(b.x)], 1u);
        const unsigned gen = old / nloc;
        if (old + 1u == (gen + 1u) * nloc) {
            __builtin_amdgcn_fence(__ATOMIC_RELEASE, "agent");
            asm volatile("s_waitcnt vmcnt(0)" ::: "memory");
            const unsigned og = xb_add(&bar[XB_TOP], 1u);
            const unsigned tg = og / nx;
            if (og + 1u == (tg + 1u) * nx) xb_add(&bar[XB_TOPGEN], 1u);
            else XB_SPIN(xb_ld(&bar[XB_TOPGEN]) == tg, bar);
            __builtin_amdgcn_fence(__ATOMIC_ACQUIRE, "agent");
            xb_add(&bar[XB_XGEN(b.x)], 1u);
            asm volatile("s_waitcnt vmcnt(0)" ::: "memory");
        } else {
            XB_SPIN(xb_ld(&bar[XB_XGEN(b.x)]) == gen, bar);
            __builtin_amdgcn_fence(__ATOMIC_ACQUIRE, "agent");
            asm volatile("s_waitcnt vmcnt(0)" ::: "memory");
        }
    }
    __syncthreads();
}
struct Args {
    const float* in[21]; float* out; unsigned char* ws;
};
constexpr int NWAVES = 8, NTHR = 512;
constexpr int LDS_BYTES = 147456;

__device__ __forceinline__ void ada_item(const Args& a, int item, LAS unsigned char* lds, int tid, int lane, int wave) {
    const int layer = item / 96, n0 = (item % 96) * 64;
    LAS float* sil = (LAS float*)lds; LAS float* red = sil + 3072;
    const float* c = a.in[1]; const float* cc = a.in[3];
    for (int i = tid; i < 3072; i += NTHR) { const int v = i >> 10, k = i & 1023; const float cv = (v < 2) ? c[v * 1024 + k] : cc[k]; sil[i] = cv / (1.0f + __expf(-cv)); }
    __syncthreads();
    const float* W = a.in[4] + (size_t)layer * 1024 * 6144 + n0 + lane;
    float a0 = 0.f, a1 = 0.f, a2 = 0.f; const int k0 = wave * 128;
#pragma unroll 8
    for (int kk = 0; kk < 128; ++kk) { const int k = k0 + kk; const float w = W[(size_t)k * 6144]; a0 += sil[k] * w; a1 += sil[1024 + k] * w; a2 += sil[2048 + k] * w; }
    red[(wave * 3 + 0) * 64 + lane] = a0; red[(wave * 3 + 1) * 64 + lane] = a1; red[(wave * 3 + 2) * 64 + lane] = a2;
    __syncthreads();
    if (tid < 192) { const int v = tid >> 6, l = tid & 63; float s = a.in[5][layer * 6144 + n0 + l];
#pragma unroll
        for (int w = 0; w < 8; ++w) s += red[(w * 3 + v) * 64 + l];
        ((float*)(a.ws + WS_MOD))[(layer * 3 + v) * 6144 + n0 + l] = s; }
    __syncthreads();
}
__device__ __forceinline__ void transpose_item(const float* W, int N, bf16_t* WT, int ldk, int k0, int n0, int drow0, LAS float* scr, int lane) {
#pragma unroll 8
    for (int i = 0; i < 32; ++i) { const int kk = 2 * i + (lane >> 5); scr[kk * 33 + (lane & 31)] = W[(size_t)(k0 + kk) * N + n0 + (lane & 31)]; }
    LDS_WAIT(); asm volatile("" ::: "memory");
    const int c = lane & 7;
#pragma unroll
    for (int j = 0; j < 4; ++j) { const int n = (lane >> 3) + 8 * j; const LAS float* s = scr + (8 * c) * 33 + n;
        u32x4 o; o.x = pk2(s[0 * 33], s[1 * 33]); o.y = pk2(s[2 * 33], s[3 * 33]); o.z = pk2(s[4 * 33], s[5 * 33]); o.w = pk2(s[6 * 33], s[7 * 33]);
        *(u32x4*)(WT + (size_t)(drow0 + n) * ldk + k0 + 8 * c) = o; }
    LDS_WAIT(); asm volatile("" ::: "memory");
}
__device__ __forceinline__ void p0_prologue(const Args& a, LAS unsigned char* lds, int tid, int lane, int wave) {
    asm volatile("" : "+v"(lane), "+v"(tid));
    unsigned char* ws = a.ws;
    if (blockIdx.x < 192) ada_item(a, blockIdx.x, lds, tid, lane, wave);
    LAS float* scr = (LAS float*)(lds + wave * 16384);
    const int gw = blockIdx.x * NWAVES + wave, NGW = gridDim.x * NWAVES;
    constexpr int I_IN = 16 * 69, I_UQ = 6 * 24, I_UKV = 4 * 32, I_O = 512, I_F = 512, I_13 = 16 * 88, I_2 = 44 * 32;
    constexpr int NITEMS = I_IN + I_UQ + I_UKV + I_O + I_F + 2 * (2 * I_13 + I_2);
    for (int it = gw; it < NITEMS; it += NGW) {
        int r = it;
        if (r < I_IN) { const int kb = r / 69, nb = r % 69; transpose_item(a.in[8], NIN, (bf16_t*)(ws + WS_WIN), 1024, 64 * kb, 32 * nb, 32 * nb, scr, lane); continue; } r -= I_IN;
        if (r < I_UQ) { const int kb = r / 24, nb = r % 24; transpose_item(a.in[11], 768, (bf16_t*)(ws + WS_WUQ), 384, 64 * kb, 32 * nb, 32 * nb, scr, lane); continue; } r -= I_UQ;
        if (r < I_UKV) { const int kb = r / 32, nb = r % 32; transpose_item(a.in[12], 1024, (bf16_t*)(ws + WS_WUKV), 256, 64 * kb, 32 * nb, 32 * nb, scr, lane); continue; } r -= I_UKV;
        if (r < I_O) { const int kb = r / 32, nb = r % 32; transpose_item(a.in[16], 1024, (bf16_t*)(ws + WS_WO), 1024, 64 * kb, 32 * nb, 32 * nb, scr, lane); continue; } r -= I_O;
        if (r < I_F) { const int kb = r / 32, nb = r % 32; transpose_item(a.in[17], 1024, (bf16_t*)(ws + WS_WF), 1024, 64 * kb, 32 * nb, 32 * nb, scr, lane); continue; } r -= I_F;
        const int layer = r / (2 * I_13 + I_2); r -= layer * (2 * I_13 + I_2);
        if (r < 2 * I_13) { const int s = r / I_13; r -= s * I_13; const int kb = r / 88, nb = r % 88, n0 = 32 * nb;
            transpose_item(a.in[s ? 19 : 18] + (size_t)layer * 1024 * DFF, DFF, (bf16_t*)(ws + WS_W13 + layer * W13_BYTES), 1024, 64 * kb, n0, 256 * (n0 >> 7) + 128 * s + (n0 & 127), scr, lane); continue; }
        r -= 2 * I_13;
        { const int kb = r / 32, nb = r % 32; transpose_item(a.in[20] + (size_t)layer * DFF * 1024, 1024, (bf16_t*)(ws + WS_W2 + layer * W2_BYTES), DFF, 64 * kb, 32 * nb, 32 * nb, scr, lane); }
    }
    const int gt = blockIdx.x * NTHR + tid, NGT = gridDim.x * NTHR;
    { unsigned* z = (unsigned*)(ws + WS_WIN + (size_t)NIN * 1024 * 2); for (int i = gt; i < 96 * 1024 / 2; i += NGT) z[i] = 0u; }
    { bf16_t* d = (bf16_t*)(ws + WS_D256);
      for (int i = gt; i < 131072; i += NGT) { const int cs = i >> 16, c = (i >> 8) & 255, cp = i & 255; const float rev = (float)((c * cp) & 255) * (1.0f / 256.0f);
          const float v = cs ? -sin_rev(rev) : cos_rev(rev); d[i] = (bf16_t)f2bf(v * 0.0625f); } }
    { bf16_t* d = (bf16_t*)(ws + WS_W1D);
      for (int i = gt; i < 65536; i += NGT) { const int row = i >> 8, col = i & 255, ro = row >> 7, ka = row & 127, ri = col >> 7, n = col & 127; const float rev = (float)((n * ka) & 127) * (1.0f / 128.0f);
          const float c = cos_rev(rev), s = sin_rev(rev); const float v = (ro == 0) ? (ri == 0 ? c : s) : (ri == 0 ? -s : c); d[i] = (bf16_t)f2bf(v * 0.08838834764831845f); } }
    { bf16_t* d = (bf16_t*)(ws + WS_W2D);
      for (int i = gt; i < 32768; i += NGT) { const int row = i >> 7, col = i & 127, ri = col >> 6, n2 = col & 63; float v = 0.f;
          if (row < 64) { const float rev = (float)((n2 * row) & 63) * (1.0f / 64.0f); v = (ri == 0 ? cos_rev(rev) : sin_rev(rev)) * 0.125f; }
          d[i] = (bf16_t)f2bf(v); } }
}

__device__ __forceinline__ void norm_row(const float* xrow, bf16_t* orow, const float* g, const float* sc, const float* sh, int lane) {
    const f32x4* xr = (const f32x4*)xrow + lane;
    f32x4 v[4]; float s = 0.f;
#pragma unroll
    for (int j = 0; j < 4; ++j) { v[j] = xr[64 * j]; s += (v[j].x * v[j].x + v[j].y * v[j].y) + (v[j].z * v[j].z + v[j].w * v[j].w); }
    const float rstd = rsqrtf(wave_sum(s) * (1.0f / 1024.0f) + EPS);
    u32x2* o8 = (u32x2*)orow + lane;
#pragma unroll
    for (int j = 0; j < 4; ++j) { const f32x4 gg = ((const f32x4*)g)[64 * j + lane], cc = ((const f32x4*)sc)[64 * j + lane], hh = ((const f32x4*)sh)[64 * j + lane];
        const f32x4 y = v[j] * rstd * gg * (cc + 1.0f) + hh; u32x2 w; w.x = pk2(y.x, y.y); w.y = pk2(y.z, y.w); o8[64 * j] = w; }
}
__device__ __forceinline__ void norm_pass(const float* src, int nrows, bf16_t* dst, const float* g, const float* mod, int sh_chunk, int vfixed, int lane, int wave) {
    asm volatile("" : "+v"(lane));
    const int gw = blockIdx.x * NWAVES + wave, NGW = gridDim.x * NWAVES;
    for (int r = gw; r < nrows; r += NGW) { const int v = vfixed >= 0 ? vfixed : (r >> 13); const float* mv = mod + v * 6144 + sh_chunk * 1024;
        norm_row(src + (size_t)r * 1024, dst + (size_t)r * 1024, g, mv + 1024, mv, lane); }
}

__device__ __forceinline__ void norm_row_b(const bf16_t* xrow, bf16_t* orow, const float* g, const float* sc, const float* sh, int lane) {
    f32x4 v[4]; pg8::ld8(xrow + lane * 8, v[0], v[1]); pg8::ld8(xrow + 512 + lane * 8, v[2], v[3]); float s = 0.f;
#pragma unroll
    for (int j = 0; j < 4; ++j) s += (v[j].x * v[j].x + v[j].y * v[j].y) + (v[j].z * v[j].z + v[j].w * v[j].w);
    const float rstd = rsqrtf(wave_sum(s) * (1.0f / 1024.0f) + EPS);
#pragma unroll
    for (int hh = 0; hh < 2; ++hh) { const int c = hh * 512 + lane * 8; f32x4 y[2];
#pragma unroll
        for (int k = 0; k < 2; ++k) { const f32x4 gg = *(const f32x4*)(g + c + 4 * k), cc = *(const f32x4*)(sc + c + 4 * k), h4 = *(const f32x4*)(sh + c + 4 * k); y[k] = v[2 * hh + k] * rstd * gg * (cc + 1.0f) + h4; }
        pg8::st8(orow + c, y[0], y[1]); }
}
__device__ __forceinline__ void norm_pass_b(const bf16_t* src, int nrows, bf16_t* dst, const float* g, const float* mod, int sh_chunk, int lane, int wave) {
    asm volatile("" : "+v"(lane));
    const int gw = blockIdx.x * NWAVES + wave, NGW = gridDim.x * NWAVES;
    for (int r = gw; r < nrows; r += NGW) { const float* mv = mod + (r >> 13) * 6144 + sh_chunk * 1024;
        norm_row_b(src + (size_t)r * 1024, dst + (size_t)r * 1024, g, mv + 1024, mv, lane); }
}

__device__ __forceinline__ float sumsq8(u32x4 c) { float s = 0.f;
#pragma unroll
    for (int i = 0; i < 4; ++i) { const float a = bflo(c[i]), b = bfhi(c[i]); s += a * a + b * b; } return s; }
__device__ __forceinline__ u32x4 scale8(u32x4 c, float r, const float* g) { const f32x4 g0 = *(const f32x4*)g, g1 = *(const f32x4*)(g + 4); u32x4 o;
    o.x = pk2(bflo(c.x) * r * g0.x, bfhi(c.x) * r * g0.y); o.y = pk2(bflo(c.y) * r * g0.z, bfhi(c.y) * r * g0.w);
    o.z = pk2(bflo(c.z) * r * g1.x, bfhi(c.z) * r * g1.y); o.w = pk2(bflo(c.w) * r * g1.z, bfhi(c.w) * r * g1.w); return o; }
__device__ __forceinline__ void prep1_pass(const Args& a, int lane, int wave) {
    asm volatile("" : "+v"(lane));
    unsigned char* ws = a.ws;
    const bf16_t* P = (const bf16_t*)(ws + WS_B); bf16_t* CQN = (bf16_t*)(ws + WS_CQN); bf16_t* CKVN = (bf16_t*)(ws + WS_CKVN); bf16_t* KPE = (bf16_t*)(ws + WS_KPE); bf16_t* MIX = (bf16_t*)(ws + WS_A);
    const float* qg = a.in[9]; const float* kvg = a.in[10]; const float* cw = a.in[15];
    f32x4 w0[2], w1[2], w2[2];
#pragma unroll
    for (int i = 0; i < 2; ++i) { w0[i] = *(const f32x4*)(cw + 8 * lane + 4 * i); w1[i] = *(const f32x4*)(cw + 512 + 8 * lane + 4 * i); w2[i] = *(const f32x4*)(cw + 1024 + 8 * lane + 4 * i); }
    const int gw = blockIdx.x * NWAVES + wave, NGW = gridDim.x * NWAVES;
    for (int r = gw; r < MT; r += NGW) {
        const bf16_t* pr = P + (size_t)r * NINP;
        const u32x4 c1 = *(const u32x4*)(pr + lane * 8);
        u32x4 c2 = (u32x4){0u, 0u, 0u, 0u}; if (lane < 20) c2 = *(const u32x4*)(pr + 512 + lane * 8);
        const float ss1 = sumsq8(c1), ss2 = sumsq8(c2);
        const float sq = wave_sum(lane < 48 ? ss1 : 0.f);
        const float skv = wave_sum((lane >= 48 ? ss1 : 0.f) + (lane < 16 ? ss2 : 0.f));
        const float rq = rsqrtf(sq * (1.0f / 384.0f) + EPS), rkv = rsqrtf(skv * (1.0f / 256.0f) + EPS);
        if (lane < 48) *(u32x4*)(CQN + (size_t)r * QR + 8 * lane) = scale8(c1, rq, qg + 8 * lane);
        else *(u32x4*)(CKVN + (size_t)r * KVR + 8 * (lane - 48)) = scale8(c1, rkv, kvg + 8 * (lane - 48));
        if (lane < 16) *(u32x4*)(CKVN + (size_t)r * KVR + 128 + 8 * lane) = scale8(c2, rkv, kvg + 128 + 8 * lane);
        else if (lane < 20) *(u32x4*)(KPE + (size_t)r * 32 + 8 * (lane - 16)) = c2;
        if (r < ML) {
            const int t = r & (SEQ - 1);
            const bf16_t* cb = pr + 672 + 8 * lane;
            const u32x4 bg = *(const u32x4*)cb, cg0 = *(const u32x4*)(cb + 512), u0 = *(const u32x4*)(cb + 1024);
            u32x4 cgm = (u32x4){0u, 0u, 0u, 0u}, um = cgm, cgp = cgm, up = cgm;
            if (t > 0) { cgm = *(const u32x4*)(cb - NINP + 512); um = *(const u32x4*)(cb - NINP + 1024); }
            if (t < SEQ - 1) { cgp = *(const u32x4*)(cb + NINP + 512); up = *(const u32x4*)(cb + NINP + 1024); }
            u32x4 o;
#pragma unroll
            for (int i = 0; i < 4; ++i) {
                const float zl_m = bflo(cgm[i]) * bflo(um[i]), zh_m = bfhi(cgm[i]) * bfhi(um[i]);
                const float zl_0 = bflo(cg0[i]) * bflo(u0[i]), zh_0 = bfhi(cg0[i]) * bfhi(u0[i]);
                const float zl_p = bflo(cgp[i]) * bflo(up[i]), zh_p = bfhi(cgp[i]) * bfhi(up[i]);
                const int e = 2 * i;
                const float yl = zl_m * w0[e >> 2][e & 3] + zl_0 * w1[e >> 2][e & 3] + zl_p * w2[e >> 2][e & 3];
                const float yh = zh_m * w0[(e + 1) >> 2][(e + 1) & 3] + zh_0 * w1[(e + 1) >> 2][(e + 1) & 3] + zh_p * w2[(e + 1) >> 2][(e + 1) & 3];
                o[i] = pk2(bflo(bg[i]) * yl, bfhi(bg[i]) * yh);
            }
            *(u32x4*)(MIX + (size_t)r * 1024 + 512 + 8 * lane) = o;
        }
    }
}

__device__ __forceinline__ void prep2_pass(const Args& a, LAS unsigned char* lds, int tid, int lane, int wave) {
    asm volatile("" : "+v"(lane), "+v"(tid));
    unsigned char* ws = a.ws;
    bf16_t* Q = (bf16_t*)(ws + WS_Q); const bf16_t* KV = (const bf16_t*)(ws + WS_KV); const bf16_t* KPE = (const bf16_t*)(ws + WS_KPE);
    bf16_t* Kf = (bf16_t*)(ws + WS_KF); bf16_t* Vt = (bf16_t*)(ws + WS_VT);
    const float* qgain = a.in[13]; const float* kgain = a.in[14];
    const int head = lane >> 3, sub = lane & 7;
    const float inv = __builtin_amdgcn_exp2f(-(float)sub * 1.6609640474436813f) * 0.15915494309189535f;
    float qgn[8], kgn[8], qgp[4], kgp[4];
#pragma unroll
    for (int e = 0; e < 8; ++e) { qgn[e] = qgain[8 * sub + e] * QSC; kgn[e] = kgain[8 * sub + e]; }
#pragma unroll
    for (int i = 0; i < 4; ++i) { qgp[i] = qgain[64 + sub + 8 * i] * QSC; kgp[i] = kgain[64 + sub + 8 * i]; }
    for (int blk = blockIdx.x; blk < MT / 64; blk += gridDim.x) {
        const int r0 = blk * 64; const bool latent = blk < 256;
        const int b = latent ? (blk >> 7) : ((blk - 256) >> 2);
        const int key0 = latent ? ((blk & 127) * 64) : (SEQ + ((blk - 256) & 3) * 64);
#pragma unroll
        for (int i = 0; i < 8; ++i) { const int id = tid + 512 * i, row = id >> 6, cc = id & 63, h = cc >> 3, part = cc & 7;
            const u32x4 v = *(const u32x4*)(KV + (size_t)(r0 + row) * 1024 + h * 128 + 64 + part * 8);
            *(LAS u32x4*)(lds + row * 1024 + cc * 16) = v; }
        for (int i = 0; i < 8; ++i) {
            const int r = r0 + 8 * wave + i, kl = 8 * wave + i;
            float cr = 1.f, sr = 0.f, ccol = 1.f, scol = 0.f;
            if (latent) { const int t = r & (SEQ - 1); const float ar = (float)(t >> 6) * inv, ac = (float)(t & 63) * inv;
                cr = cos_rev(ar - floorf(ar)); sr = sin_rev(ar - floorf(ar)); ccol = cos_rev(ac - floorf(ac)); scol = sin_rev(ac - floorf(ac)); }
            const bf16_t* kpe = KPE + (size_t)r * 32;
            if (latent) {
                bf16_t* qp = Q + (size_t)r * 768 + head * 96;
                const u32x4 nv = *(const u32x4*)(qp + 8 * sub);
                float pe[4];
#pragma unroll
                for (int j = 0; j < 4; ++j) pe[j] = bf1(qp[64 + sub + 8 * j]);
                float ss = sumsq8(nv) + (pe[0] * pe[0] + pe[1] * pe[1]) + (pe[2] * pe[2] + pe[3] * pe[3]);
                ss += __shfl_xor(ss, 1); ss += __shfl_xor(ss, 2); ss += __shfl_xor(ss, 4);
                const float rs = rsqrtf(ss * (1.0f / 96.0f) + EPS);
                u32x4 o; o.x = pk2(bflo(nv.x) * rs * qgn[0], bfhi(nv.x) * rs * qgn[1]); o.y = pk2(bflo(nv.y) * rs * qgn[2], bfhi(nv.y) * rs * qgn[3]);
                o.z = pk2(bflo(nv.z) * rs * qgn[4], bfhi(nv.z) * rs * qgn[5]); o.w = pk2(bflo(nv.w) * rs * qgn[6], bfhi(nv.w) * rs * qgn[7]);
                *(u32x4*)(qp + 8 * sub) = o;
                const float p0 = pe[0] * rs * qgp[0], p1 = pe[1] * rs * qgp[1], p2 = pe[2] * rs * qgp[2], p3 = pe[3] * rs * qgp[3];
                qp[64 + sub] = (bf16_t)f2bf(p0 * cr - p1 * sr); qp[72 + sub] = (bf16_t)f2bf(p1 * cr + p0 * sr);
                qp[80 + sub] = (bf16_t)f2bf(p2 * ccol - p3 * scol); qp[88 + sub] = (bf16_t)f2bf(p3 * ccol + p2 * scol);
            }
            {
                const u32x4 nv = *(const u32x4*)(KV + (size_t)r * 1024 + head * 128 + 8 * sub);
                float pe[4];
#pragma unroll
                for (int j = 0; j < 4; ++j) pe[j] = bf1(kpe[sub + 8 * j]);
                float ss = sumsq8(nv) + (pe[0] * pe[0] + pe[1] * pe[1]) + (pe[2] * pe[2] + pe[3] * pe[3]);
                ss += __shfl_xor(ss, 1); ss += __shfl_xor(ss, 2); ss += __shfl_xor(ss, 4);
                const float rs = rsqrtf(ss * (1.0f / 96.0f) + EPS);
                bf16_t* kp = Kf + ((size_t)(b * NH + head) * NKEY + key0 + kl) * DQK;
                u32x4 o; o.x = pk2(bflo(nv.x) * rs * kgn[0], bfhi(nv.x) * rs * kgn[1]); o.y = pk2(bflo(nv.y) * rs * kgn[2], bfhi(nv.y) * rs * kgn[3]);
                o.z = pk2(bflo(nv.z) * rs * kgn[4], bfhi(nv.z) * rs * kgn[5]); o.w = pk2(bflo(nv.w) * rs * kgn[6], bfhi(nv.w) * rs * kgn[7]);
                *(u32x4*)(kp + 8 * sub) = o;
                const float p0 = pe[0] * rs * kgp[0], p1 = pe[1] * rs * kgp[1], p2 = pe[2] * rs * kgp[2], p3 = pe[3] * rs * kgp[3];
                kp[64 + sub] = (bf16_t)f2bf(p0 * cr - p1 * sr); kp[72 + sub] = (bf16_t)f2bf(p1 * cr + p0 * sr);
                kp[80 + sub] = (bf16_t)f2bf(p2 * ccol - p3 * scol); kp[88 + sub] = (bf16_t)f2bf(p3 * ccol + p2 * scol);
            }
        }
        __syncthreads();
        { const int h = tid >> 6, d = tid & 63; bf16_t* vp = Vt + ((size_t)(b * NH + h) * 64 + d) * NKEY + key0;
#pragma unroll
          for (int i = 0; i < 8; ++i) { unsigned short e[8];
#pragma unroll
              for (int k = 0; k < 8; ++k) e[k] = *(const LAS unsigned short*)(lds + (8 * i + k) * 1024 + tid * 2);
              u32x4 o; o.x = e[0] | ((unsigned)e[1] << 16); o.y = e[2] | ((unsigned)e[3] << 16); o.z = e[4] | ((unsigned)e[5] << 16); o.w = e[6] | ((unsigned)e[7] << 16);
              *(u32x4*)(vp + 8 * i) = o; } }
        __syncthreads();
    }
}

__device__ __forceinline__ float attn_rowmax(const f32x16& p0, const f32x16& p1) {
    float a = __builtin_fmaxf(__builtin_fmaxf(p0[0], p0[1]), p1[0]), b = __builtin_fmaxf(__builtin_fmaxf(p0[2], p0[3]), p1[1]);
    a = __builtin_fmaxf(__builtin_fmaxf(a, p1[2]), p1[3]);
#pragma unroll
    for (int r = 4; r < 16; r += 4) { a = __builtin_fmaxf(__builtin_fmaxf(a, p0[r]), p0[r + 1]); b = __builtin_fmaxf(__builtin_fmaxf(b, p0[r + 2]), p0[r + 3]);
        a = __builtin_fmaxf(__builtin_fmaxf(a, p1[r]), p1[r + 1]); b = __builtin_fmaxf(__builtin_fmaxf(b, p1[r + 2]), p1[r + 3]); }
    const float mx = __builtin_fmaxf(a, b);
    auto rr = __builtin_amdgcn_permlane32_swap(__float_as_uint(mx), __float_as_uint(mx), false, false);
    return __builtin_fmaxf(__uint_as_float(rr[0]), __uint_as_float(rr[1]));
}
__device__ __forceinline__ void attn_phase(const Args& a, LAS unsigned char* lds, int tid, int lane, int wid) {
    asm volatile("" : "+v"(lane), "+v"(tid));
    unsigned char* ws = a.ws;
    const bf16_t* Q = (const bf16_t*)(ws + WS_Q); const char* Kf = (const char*)(ws + WS_KF); const char* Vt = (const char*)(ws + WS_VT); bf16_t* MIX = (bf16_t*)(ws + WS_A);
    constexpr int NS = 4, KSLOT = 13312, VBASE = NS * KSLOT, VSLOT = 8192, NT = NKEY / 64;
    constexpr float THR = 8.0f;
    const int q = lane & 31, hi = lane >> 5;
    const int xcd = blockIdx.x & 7, l = blockIdx.x >> 3;
    const unsigned lds0 = (unsigned)(size_t)lds;
    unsigned koff[2];
#pragma unroll
    for (int i = 0; i < 2; ++i) { const int p = 64 * (wid + 8 * i) + lane, row = p / 13, c = p % 13, r31 = row & 31;
        const int key = (row & 32) + ((r31 & 19) | ((r31 & 4) << 1) | ((r31 & 8) >> 1)); koff[i] = (unsigned)(key * 192 + (c < 12 ? c : 11) * 16); }
    const bool k2 = wid < 5;
    unsigned voffv; { const int d = 8 * wid + (lane >> 3), cp = lane & 7, c = cp ^ ((d >> 1) & 7); voffv = (unsigned)(d * (NKEY * 2) + c * 16); }
    const unsigned kdst0 = lds0 + (unsigned)wid * 1024u, kdst1 = lds0 + (unsigned)(wid + 8) * 1024u, vdst = lds0 + VBASE + (unsigned)wid * 1024u;
    const int kro = q * 208 + hi * 16;
    int vro[4];
#pragma unroll
    for (int s = 0; s < 4; ++s) vro[s] = VBASE + q * 128 + (((2 * s + hi) ^ ((q >> 1) & 7)) * 16);
#define DMA_K(tile, slot) do { const char* kb_ = Kh + (size_t)(tile) * (64 * 192); pg8::glds16s(kb_, koff[0], kdst0 + (slot) * KSLOT); if (k2) pg8::glds16s(kb_, koff[1], kdst1 + (slot) * KSLOT); } while (0)
#define DMA_V(tile, slot) pg8::glds16s(Vh + (size_t)(tile) * 128, voffv, vdst + (slot) * VSLOT)
#define SBAR() __builtin_amdgcn_sched_barrier(0)
#define EXP2(P, R) do { P[R] = __builtin_amdgcn_exp2f(P[R]); P[R + 1] = __builtin_amdgcn_exp2f(P[R + 1]); rs2 += (f32x2){P[R], P[R + 1]}; } while (0)
#define PKP(P, B) __builtin_bit_cast(bf16x8, (u32x4){cvt_pk_bf16(P[B], P[B + 1]), cvt_pk_bf16(P[B + 2], P[B + 3]), cvt_pk_bf16(P[B + 4], P[B + 5]), cvt_pk_bf16(P[B + 6], P[B + 7])})
    for (int it = 0; it < 2; ++it) {
        const int bh = 2 * xcd + it, b = bh >> 3, h = bh & 7, qb = l;
        const size_t qrow = (size_t)b * SEQ + qb * 256 + wid * 32 + q;
        const char* Kh = Kf + (size_t)bh * NKEY * 192; const char* Vh = Vt + (size_t)bh * 64 * NKEY * 2;
        DMA_K(0, 0); DMA_K(1, 1); DMA_V(0, 0); DMA_K(2, 2); DMA_V(1, 1); DMA_K(3, 3); DMA_V(2, 2);
        bf16x8 qf[6];
#pragma unroll
        for (int d0 = 0; d0 < 6; ++d0) qf[d0] = *(const bf16x8*)(Q + qrow * 768 + h * 96 + d0 * 16 + hi * 8);
        asm volatile("s_waitcnt vmcnt(0) lgkmcnt(0)\n\ts_barrier" ::: "memory");
        f32x16 pc0 = {}, pc1 = {};
#pragma unroll
        for (int d0 = 0; d0 < 6; ++d0) {
            const bf16x8 a0 = *(const LAS bf16x8*)(lds + kro + d0 * 32), a1 = *(const LAS bf16x8*)(lds + kro + 32 * 208 + d0 * 32);
            pc0 = __builtin_amdgcn_mfma_f32_32x32x16_bf16(a0, qf[d0], pc0, 0, 0, 0); pc1 = __builtin_amdgcn_mfma_f32_32x32x16_bf16(a1, qf[d0], pc1, 0, 0, 0);
        }
        float m = attn_rowmax(pc0, pc1), lsum = 0.f;
#pragma unroll
        for (int r = 0; r < 16; ++r) { pc0[r] -= m; pc1[r] -= m; }
        f32x16 o0 = {}, o1 = {};
        f32x2 rs2 = (f32x2){0.f, 0.f};
        asm volatile("s_waitcnt lgkmcnt(0)\n\ts_barrier" ::: "memory");
        for (int t = 0; t < NT; ++t) {
            { const int tk = (t + 4 < NT) ? t + 4 : NT - 1, tv = (t + 3 < NT) ? t + 3 : NT - 1; DMA_K(tk, t & 3); DMA_V(tv, (t + 3) & 3); }
            const float mx = attn_rowmax(pc0, pc1);
            if (__builtin_expect(__any(mx > THR), 0)) {
                const float dl = __builtin_fmaxf(mx, 0.f); m += dl; const float al = __builtin_amdgcn_exp2f(-dl); lsum *= al; rs2 *= al;
#pragma unroll
                for (int r = 0; r < 16; ++r) { pc0[r] -= dl; pc1[r] -= dl; o0[r] *= al; o1[r] *= al; }
            }
            SBAR();
            const LAS unsigned char* kn = lds + ((t + 1) & 3) * KSLOT + kro;
            bf16x8 kfa[6], kfb[6];
#pragma unroll
            for (int d0 = 0; d0 < 3; ++d0) { kfa[2 * d0] = *(const LAS bf16x8*)(kn + d0 * 32); kfa[2 * d0 + 1] = *(const LAS bf16x8*)(kn + 32 * 208 + d0 * 32); }
            SBAR();
            f32x16 pn0, pn1; const float nm = -m;
#pragma unroll
            for (int r = 0; r < 16; ++r) { pn0[r] = nm; pn1[r] = nm; }
            pn0 = __builtin_amdgcn_mfma_f32_32x32x16_bf16(kfa[0], qf[0], pn0, 0, 0, 0); EXP2(pc0, 0); SBAR();
#pragma unroll
            for (int d0 = 3; d0 < 6; ++d0) { kfb[2 * (d0 - 3)] = *(const LAS bf16x8*)(kn + d0 * 32); kfb[2 * (d0 - 3) + 1] = *(const LAS bf16x8*)(kn + 32 * 208 + d0 * 32); }
            SBAR();
            pn1 = __builtin_amdgcn_mfma_f32_32x32x16_bf16(kfa[1], qf[0], pn1, 0, 0, 0); EXP2(pc0, 2); SBAR();
            pn0 = __builtin_amdgcn_mfma_f32_32x32x16_bf16(kfa[2], qf[1], pn0, 0, 0, 0); EXP2(pc0, 4); EXP2(pc0, 6); SBAR();
            pn1 = __builtin_amdgcn_mfma_f32_32x32x16_bf16(kfa[3], qf[1], pn1, 0, 0, 0); EXP2(pc0, 8); SBAR();
            pn0 = __builtin_amdgcn_mfma_f32_32x32x16_bf16(kfa[4], qf[2], pn0, 0, 0, 0); EXP2(pc0, 10); EXP2(pc0, 12); SBAR();
            pn1 = __builtin_amdgcn_mfma_f32_32x32x16_bf16(kfa[5], qf[2], pn1, 0, 0, 0); EXP2(pc0, 14); SBAR();
            const LAS unsigned char* vb = lds + (t & 3) * VSLOT;
            bf16x8 va[8];
#pragma unroll
            for (int s = 0; s < 4; ++s) { va[2 * s] = *(const LAS bf16x8*)(vb + vro[s]); va[2 * s + 1] = *(const LAS bf16x8*)(vb + vro[s] + 32 * 128); }
            SBAR();
            pn0 = __builtin_amdgcn_mfma_f32_32x32x16_bf16(kfb[0], qf[3], pn0, 0, 0, 0); EXP2(pc1, 0); EXP2(pc1, 2); SBAR();
            pn1 = __builtin_amdgcn_mfma_f32_32x32x16_bf16(kfb[1], qf[3], pn1, 0, 0, 0); EXP2(pc1, 4); SBAR();
            pn0 = __builtin_amdgcn_mfma_f32_32x32x16_bf16(kfb[2], qf[4], pn0, 0, 0, 0); EXP2(pc1, 6); EXP2(pc1, 8); SBAR();
            pn1 = __builtin_amdgcn_mfma_f32_32x32x16_bf16(kfb[3], qf[4], pn1, 0, 0, 0); EXP2(pc1, 10); SBAR();
            pn0 = __builtin_amdgcn_mfma_f32_32x32x16_bf16(kfb[4], qf[5], pn0, 0, 0, 0); EXP2(pc1, 12); SBAR();
            pn1 = __builtin_amdgcn_mfma_f32_32x32x16_bf16(kfb[5], qf[5], pn1, 0, 0, 0); EXP2(pc1, 14); SBAR();
            { const bf16x8 pb0 = PKP(pc0, 0);
              o0 = __builtin_amdgcn_mfma_f32_32x32x16_bf16(va[0], pb0, o0, 0, 0, 0); o1 = __builtin_amdgcn_mfma_f32_32x32x16_bf16(va[1], pb0, o1, 0, 0, 0);
              const bf16x8 pb1 = PKP(pc0, 8);
              o0 = __builtin_amdgcn_mfma_f32_32x32x16_bf16(va[2], pb1, o0, 0, 0, 0); o1 = __builtin_amdgcn_mfma_f32_32x32x16_bf16(va[3], pb1, o1, 0, 0, 0);
              const bf16x8 pb2 = PKP(pc1, 0);
              o0 = __builtin_amdgcn_mfma_f32_32x32x16_bf16(va[4], pb2, o0, 0, 0, 0); o1 = __builtin_amdgcn_mfma_f32_32x32x16_bf16(va[5], pb2, o1, 0, 0, 0);
              const bf16x8 pb3 = PKP(pc1, 8);
              o0 = __builtin_amdgcn_mfma_f32_32x32x16_bf16(va[6], pb3, o0, 0, 0, 0); o1 = __builtin_amdgcn_mfma_f32_32x32x16_bf16(va[7], pb3, o1, 0, 0, 0); }
            if (k2) asm volatile("s_waitcnt vmcnt(6) lgkmcnt(0)\n\ts_barrier" ::: "memory");
            else asm volatile("s_waitcnt vmcnt(4) lgkmcnt(0)\n\ts_barrier" ::: "memory");
            pc0 = pn0; pc1 = pn1;
        }
        lsum += rs2.x + rs2.y;
        const float lt = lsum + __shfl_xor(lsum, 32); const float il = 1.0f / lt;
        bf16_t* op = MIX + qrow * 1024 + h * 64 + 4 * hi;
#pragma unroll
        for (int g = 0; g < 4; ++g) {
            u32x2 w0, w1; w0.x = cvt_pk_bf16(o0[4 * g] * il, o0[4 * g + 1] * il); w0.y = cvt_pk_bf16(o0[4 * g + 2] * il, o0[4 * g + 3] * il);
            w1.x = cvt_pk_bf16(o1[4 * g] * il, o1[4 * g + 1] * il); w1.y = cvt_pk_bf16(o1[4 * g + 2] * il, o1[4 * g + 3] * il);
            *(u32x2*)(op + 8 * g) = w0; *(u32x2*)(op + 32 + 8 * g) = w1;
        }
        asm volatile("s_waitcnt vmcnt(0) lgkmcnt(0)\n\ts_barrier" ::: "memory");
    }
#undef DMA_K
#undef DMA_V
#undef SBAR
#undef EXP2
#undef PKP
}

__global__ void __launch_bounds__(NTHR, 2) fwd_kernel(Args a) {
    extern __shared__ __attribute__((aligned(16))) unsigned char lds_raw[];
    LAS unsigned char* lds = (LAS unsigned char*)lds_raw;
    cg::grid_group grid = cg::this_grid();
    unsigned* barw = (unsigned*)a.ws;
    volatile LAS unsigned* bst = (volatile LAS unsigned*)(lds_raw + 131072 + 64);
    if (threadIdx.x < 2) bst[threadIdx.x] = 0u;
    if (blockIdx.x == 0) for (int i = threadIdx.x; i < XCD_BAR_WORDS; i += NTHR) barw[i] = 0u;
    __syncthreads();
    XcdBarrier xbar; xbar.bar = barw; xbar.x = 0; xbar.st = bst;
#define GSYNC() do { for (int s_ = 0; s_ < PROBE_SYNC; ++s_) xcd_barrier(xbar); } while (0)
    const int tid = threadIdx.x, lane = tid & 63, wave = __builtin_amdgcn_readfirstlane(tid >> 6);
    const int G = gridDim.x, cu = blockIdx.x;
    unsigned char* ws = a.ws;
    const float* mod = (const float*)(ws + WS_MOD);
    bf16_t* XN = (bf16_t*)(ws + WS_A);
    bf16_t* XB = (bf16_t*)(ws + WS_XB);

    p0_prologue(a, lds, tid, lane, wave);
    grid.sync();
    xbar = xcd_barrier_post(barw, bst);
    norm_pass(a.in[0], ML, XN, a.in[6], mod, 0, -1, lane, wave);
    norm_pass(a.in[2], MC, XN + (size_t)ML * 1024, a.in[6], mod, 0, 2, lane, wave);
    GSYNC();
    { pg8::ProbStd p = pg8::make_std(XN, 1024, ws + WS_WIN, 1024, 1024); pg8::StaticOrder S; S.init(MT, NINP, G, cu);
      pg8::EpiBf16 E{(bf16_t*)(ws + WS_B), NINP}; pg8::gemm_phase<pg8::EpiBf16, pg8::ProbStd, true>(lds, p, S, E); }
    { pg8::ProbWc p{(const char*)(ws + WS_WF), (const char*)(ws + WS_D256), 256, 1024 * 2, 256 * 2, (size_t)128 * 1024 * 2, (size_t)128 * 256 * 2};
      pg8::StaticOrder S; S.init(2048, 1024, G, (cu + 32) & 255);
      pg8::EpiBf16 E{(bf16_t*)(ws + WS_WC), 1024}; pg8::gemm_phase<pg8::EpiBf16, pg8::ProbWc, true>(lds, p, S, E); }
    GSYNC();
    prep1_pass(a, lane, wave);
    GSYNC();
    { pg8::ProbStd p = pg8::make_std(ws + WS_CQN, QR, ws + WS_WUQ, QR, QR); pg8::StaticOrder S; S.init(ML, 768, G, cu);
      pg8::EpiBf16 E{(bf16_t*)(ws + WS_Q), 768}; pg8::gemm_phase<pg8::EpiBf16, pg8::ProbStd, true>(lds, p, S, E); }
    { pg8::ProbStd p = pg8::make_std(ws + WS_CKVN, KVR, ws + WS_WUKV, KVR, KVR); pg8::StaticOrder S; S.init(MT, 1024, G, (cu + 64) & 255);
      pg8::EpiBf16 E{(bf16_t*)(ws + WS_KV), 1024}; pg8::gemm_phase<pg8::EpiBf16, pg8::ProbStd, true>(lds, p, S, E); }
    GSYNC();
    prep2_pass(a, lds, tid, lane, wave);
    GSYNC();
    for (int p_ = 0; p_ < PROBE_ATTN; ++p_) attn_phase(a, lds, tid, lane, wave);
    GSYNC();
    { pg8::ProbStd p = pg8::make_std(ws + WS_A, 1024, ws + WS_WO, 1024, 1024); pg8::StaticOrder S; S.init(ML, 1024, G, cu);
      typedef pg8::EpiResid<float, bf16_t> EP; EP E{a.in[0], XB, mod + 2 * 1024, 6144}; pg8::gemm_phase<EP, pg8::ProbStd, true>(lds, p, S, E); }
    GSYNC();
#pragma unroll
    for (int layer = 0; layer < 2; ++layer) {
        const float* modl = mod + layer * 3 * 6144;
        if (layer == 1) {
            norm_pass_b(XB, ML, XN, a.in[6] + 1024, modl, 0, lane, wave);
            GSYNC();
            { pg8::ProbG1 p{(const char*)(ws + WS_WC), (const char*)XN, 1024, 1024 * 2, 64 * 2048, (size_t)128 * 1024 * 2, (size_t)2048};
              pg8::StaticOrder S; S.init(2048, 16384, G, cu);
              pg8::EpiG1 E{(bf16_t*)(ws + WS_Z1)}; pg8::gemm_phase<pg8::EpiG1, pg8::ProbG1, true>(lds, p, S, E); }
            GSYNC();
            { pg8::ProbStd p = pg8::make_std(ws + WS_W1D, 256, ws + WS_Z1, 256, 256); pg8::StaticOrder S; S.init(256, 131072, G, cu);
              pg8::EpiG2 E{(bf16_t*)(ws + WS_G2)}; pg8::gemm_phase<pg8::EpiG2, pg8::ProbStd, true>(lds, p, S, E); }
            GSYNC();
            { pg8::ProbG3 p{(const char*)(ws + WS_W2D), (const char*)(ws + WS_G2), 128, 128 * 2, 128 * 128 * 2, (size_t)128 * 128 * 2, (size_t)128 * 128 * 128 * 2};
              pg8::StaticOrder S; S.init(256, 262144, G, cu);
              pg8::EpiG3 E{XB, modl + 2 * 1024, 6144}; pg8::gemm_phase<pg8::EpiG3, pg8::ProbG3, true>(lds, p, S, E); }
            GSYNC();
        }
        norm_pass_b(XB, ML, XN, a.in[7] + layer * 1024, modl, 3, lane, wave);
        GSYNC();
        { pg8::ProbStd p = pg8::make_std(XN, 1024, ws + WS_W13 + layer * W13_BYTES, 1024, 1024); pg8::StaticOrder S; S.init(ML, 2 * DFF, G, cu);
          pg8::EpiSwiglu E{(bf16_t*)(ws + WS_H)}; for (int p_ = 0; p_ < PROBE_FFNUP; ++p_) pg8::gemm_phase<pg8::EpiSwiglu, pg8::ProbStd, true>(lds, p, S, E); }
        GSYNC();
        { pg8::ProbStd p = pg8::make_std(ws + WS_H, DFF, ws + WS_W2 + layer * W2_BYTES, DFF, DFF); pg8::StaticOrder S; S.init(ML, 1024, G, cu);
          if (layer == 0) { typedef pg8::EpiResid<bf16_t, bf16_t> EP; EP E{XB, XB, modl + 5 * 1024, 6144}; pg8::gemm_phase<EP, pg8::ProbStd, true>(lds, p, S, E); }
          else { typedef pg8::EpiResid<bf16_t, float> EP; EP E{XB, a.out, modl + 5 * 1024, 6144}; pg8::gemm_phase<EP, pg8::ProbStd, true>(lds, p, S, E); } }
        if (layer == 0) GSYNC();
    }
}

extern "C" void kernel_launch(void* const* d_in, const int* in_sizes, int n_in, void* d_out, int out_size, void* d_ws, size_t ws_size, hipStream_t stream) {
    static int grid = 0;
    if (grid == 0) {
        if (n_in != 21 || out_size != ML * DM || ws_size < WS_END) { fprintf(stderr, "kernel_launch: unexpected problem (n_in %d out %d ws %zu)\n", n_in, out_size, ws_size); grid = -1; return; }
        int dev = 0, cus = 0, per_cu = 0;
        (void)hipGetDevice(&dev);
        (void)hipDeviceGetAttribute(&cus, hipDeviceAttributeMultiprocessorCount, dev);
        (void)hipFuncSetAttribute((const void*)fwd_kernel, hipFuncAttributeMaxDynamicSharedMemorySize, LDS_BYTES);
        (void)hipOccupancyMaxActiveBlocksPerMultiprocessor(&per_cu, (const void*)fwd_kernel, NTHR, LDS_BYTES);
        (void)hipGetLastError();
        grid = 256;
        if (cus < 256 || per_cu < 1) fprintf(stderr, "kernel_launch: cus %d per_cu %d\n", cus, per_cu);
    }
    if (grid < 0) return;
    Args a{};
    for (int i = 0; i < 21; ++i) a.in[i] = (const float*)d_in[i];
    a.out = (float*)d_out; a.ws = (unsigned char*)d_ws;
    void* args[] = {&a};
    hipError_t e = hipLaunchCooperativeKernel((const void*)fwd_kernel, dim3(grid), dim3(NTHR), args, LDS_BYTES, stream);
    if (e != hipSuccess) fprintf(stderr, "cooperative launch failed: %s\n", hipGetErrorString(e));
}
```

```cpp
#include <hip/hip_runtime.h>
#include <hip/hip_cooperative_groups.h>
#include <cstdio>
#include <cstdint>
namespace cg = cooperative_groups;
#ifndef PROBE_SYNC
#define PROBE_SYNC 1
#endif
#ifndef PROBE_ATTN
#define PROBE_ATTN 1
#endif
#ifndef PROBE_FFNUP
#define PROBE_FFNUP 1
#endif

#define LAS __attribute__((address_space(3)))
typedef unsigned short bf16_t;
typedef short bf16x8 __attribute__((ext_vector_type(8)));
typedef short s16x4 __attribute__((ext_vector_type(4)));
typedef float f32x4 __attribute__((ext_vector_type(4)));
typedef float f32x16 __attribute__((ext_vector_type(16)));
typedef unsigned u32x4 __attribute__((ext_vector_type(4)));
typedef unsigned u32x2 __attribute__((ext_vector_type(2)));
typedef float f32x2 __attribute__((ext_vector_type(2)));

constexpr int DM = 1024, SEQ = 8192, ML = 16384, MC = 512, MT = ML + MC;
constexpr int NINP = 2304, NIN = 2208, QR = 384, KVR = 256, NH = 8, DQK = 96, DFF = 2816, NKEY = 8448;
constexpr float EPS = 1e-6f;
constexpr float QSC = 0.10206207261596575f * 1.4426950408889634f;

constexpr size_t MiB = 1u << 20;
constexpr size_t WS_MOD = 1 * MiB;
constexpr size_t WS_WIN = 2 * MiB;
constexpr size_t WS_WUQ = WS_WIN + (size_t)NINP * 1024 * 2;
constexpr size_t WS_WUKV = WS_WUQ + (size_t)768 * 384 * 2;
constexpr size_t WS_WO = WS_WUKV + (size_t)1024 * 256 * 2;
constexpr size_t WS_WF = WS_WO + 2 * MiB;
constexpr size_t WS_WC = WS_WF + 2 * MiB;
constexpr size_t WS_D256 = WS_WC + 4 * MiB;
constexpr size_t WS_W1D = WS_D256 + 262144;
constexpr size_t WS_W2D = WS_W1D + 131072;
constexpr size_t WS_W13 = WS_W2D + 262144;
constexpr size_t W13_BYTES = (size_t)2 * DFF * 1024 * 2;
constexpr size_t WS_W2 = WS_W13 + 2 * W13_BYTES;
constexpr size_t W2_BYTES = (size_t)1024 * DFF * 2;
constexpr size_t WS_WEND = WS_W2 + 2 * W2_BYTES;
static_assert(WS_WEND <= 52 * MiB, "weights");
constexpr size_t WS_A = 52 * MiB;
constexpr int PLD = 2208;
constexpr size_t WS_B = 85 * MiB;
constexpr size_t WS_Q = 157 * MiB;
constexpr size_t WS_KV = 181 * MiB;
constexpr size_t WS_KF = 214 * MiB;
constexpr size_t WS_VT = 239 * MiB;
constexpr size_t WS_H = WS_B;
constexpr size_t WS_Z1 = WS_B;
constexpr size_t WS_G2 = WS_B + 64 * MiB;
constexpr size_t WS_XB = 218 * MiB;
constexpr size_t WS_END = 256 * MiB;

__device__ __forceinline__ unsigned f2bf(float f) { unsigned u = __builtin_bit_cast(unsigned, f); return (u + 0x7fffu + ((u >> 16) & 1u)) >> 16; }
__device__ __forceinline__ unsigned pk2(float lo, float hi) { return f2bf(lo) | (f2bf(hi) << 16); }
__device__ __forceinline__ float bflo(unsigned w) { return __builtin_bit_cast(float, w << 16); }
__device__ __forceinline__ float bfhi(unsigned w) { return __builtin_bit_cast(float, w & 0xffff0000u); }
__device__ __forceinline__ float bf1(bf16_t h) { return __builtin_bit_cast(float, (unsigned)h << 16); }
__device__ __forceinline__ unsigned cvt_pk_bf16(float lo, float hi) { unsigned r; asm volatile("v_cvt_pk_bf16_f32 %0, %1, %2" : "=v"(r) : "v"(lo), "v"(hi)); return r; }
__device__ __forceinline__ float wave_sum(float v) {
#pragma unroll
    for (int o = 1; o < 64; o <<= 1) v += __shfl_xor(v, o);
    return v;
}
__device__ __forceinline__ float sin_rev(float r) { return __builtin_amdgcn_sinf(r); }
__device__ __forceinline__ float cos_rev(float r) { return __builtin_amdgcn_cosf(r); }
__device__ __forceinline__ float silu_f(float x) { return x * __builtin_amdgcn_rcpf(1.0f + __builtin_amdgcn_exp2f(-1.4426950408889634f * x)); }
#define LDS_WAIT() asm volatile("s_waitcnt lgkmcnt(0)" ::: "memory")

namespace pg8 {
constexpr int BM = 256, BK = 64, HALF = 128, HTB = HALF * BK * 2, STAGE_BYTES = 8 * HTB, NXCD = 8, WGM = 8;
__host__ __device__ __forceinline__ int lds_byte(int r, int c) { const int st = (r >> 4) * 2 + (c >> 5), rr = r & 15, cc = c & 31, ob = rr * 64 + cc * 2; return st * 1024 + (ob ^ (((ob >> 9) & 1) << 5)); }
__host__ __device__ __forceinline__ void stage_rc(int b, int& R, int& C) { const int st = b / 1024, sb = b % 1024, swz = sb ^ (((sb >> 9) & 1) << 5); R = (st >> 1) * 16 + swz / 64; C = (st & 1) * 32 + (swz % 64) / 2; }
__host__ __device__ __forceinline__ int perm32(int rho) { const int n = rho >> 4, i = rho & 15; return 8 * (i >> 2) + 4 * n + (i & 3); }

__device__ __forceinline__ void glds16s(const char* sbase, unsigned voff, unsigned lds_dst) { unsigned keep;
    asm volatile("s_mov_b32 %0, m0\n\ts_mov_b32 m0, %3\n\ts_nop 0\n\tglobal_load_lds_dwordx4 %1, %2\n\ts_mov_b32 m0, %0" : "=&s"(keep) : "v"(voff), "s"(sbase), "s"(lds_dst) : "memory"); }
struct Unit { int pm, pn; };
struct StaticOrder {
    int nM, nN, nwg, G, c;
    __device__ void init(int M, int N, int G_, int c_) { nM = M / BM; nN = N / BM; nwg = nM * nN; G = G_; c = c_; }
    __device__ bool next(int i, Unit& u) const {
        const long L = (long)i * G + c; if (L >= nwg) return false;
        int wgid = (int)L; { const int q = nwg / NXCD, r = nwg % NXCD, xcd = wgid % NXCD, off = wgid / NXCD; wgid = (xcd < r ? xcd * (q + 1) : r * (q + 1) + (xcd - r) * q) + off; }
        const int nig = WGM * nN, gid = wgid / nig, fm = gid * WGM, gsz = (nM - fm) < WGM ? (nM - fm) : WGM;
        u.pm = fm + ((wgid % nig) % gsz); u.pn = (wgid % nig) / gsz; return true;
    }
};
struct ProbStd {
    const char* A; const char* B; int K; unsigned rsA, rsB; size_t hsA, hsB, tsA, tsB;
    __device__ __forceinline__ const char* a_base(const Unit& u) const { return A + (size_t)u.pm * tsA; }
    __device__ __forceinline__ const char* b_base(const Unit& u) const { return B + (size_t)u.pn * tsB; }
};
__device__ __forceinline__ ProbStd make_std(const void* A, int lda, const void* B, int ldb, int K) {
    ProbStd p; p.A = (const char*)A; p.B = (const char*)B; p.K = K; p.rsA = lda * 2; p.rsB = ldb * 2;
    p.hsA = (size_t)128 * lda * 2; p.hsB = (size_t)128 * ldb * 2; p.tsA = 2 * p.hsA; p.tsB = 2 * p.hsB; return p;
}

template <class Epi, class Prob, bool ALIGN_EPI>
__device__ __forceinline__ void gemm_phase(LAS unsigned char* lds, const Prob& P, const StaticOrder& S, const Epi& E) {
    int tid = threadIdx.x; asm volatile("" : "+v"(tid));
    const int wid = __builtin_amdgcn_readfirstlane(tid >> 6), lane = tid & 63, wr = wid >> 2, wc = wid & 3, fr = lane & 15, fq = lane >> 4;
    const int nt = P.K / BK;
    unsigned voffA[2], voffB[2];
#pragma unroll
    for (int i = 0; i < 2; ++i) { int R, C; stage_rc(tid * 16 + i * 8192, R, C); const int Rb = (R & ~31) + perm32(R & 31);
        voffA[i] = (unsigned)R * P.rsA + (unsigned)C * 2u; voffB[i] = (unsigned)Rb * P.rsB + (unsigned)C * 2u; }
    const size_t kstep = (size_t)(BK * 2);
    const size_t hstepA = P.hsA, hstepB = P.hsB;
    const unsigned ldsw = (unsigned)wid * 1024u;
    const unsigned lds0 = (unsigned)(size_t)lds;
    const int aoff = lds_byte(wr * 64 + fr, fq * 8), boff = lds_byte(wc * 32 + fr, fq * 8);
#define PG8_SA(b, h) (((b) * 2 + (h)) * HTB)
#define PG8_SB(b, h) ((4 + (b) * 2 + (h)) * HTB)
#define PG8_STAGE(bufoff, gbase, voff) do { _Pragma("unroll") for (int _i = 0; _i < 2; ++_i) \
        glds16s((gbase), (voff)[_i], lds0 + (unsigned)(bufoff) + ldsw + _i * 8192u); } while (0)
#define PG8_LDA(dst, b, h) do { _Pragma("unroll") for (int m = 0; m < 4; ++m) _Pragma("unroll") for (int k = 0; k < 2; ++k) dst[m][k] = *(const LAS bf16x8*)(lds + PG8_SA(b, h) + aoff + m * 2048 + k * 1024); } while (0)
#define PG8_LDB(dst, b, h) do { _Pragma("unroll") for (int n = 0; n < 2; ++n) _Pragma("unroll") for (int k = 0; k < 2; ++k) dst[n][k] = *(const LAS bf16x8*)(lds + PG8_SB(b, h) + boff + n * 2048 + k * 1024); } while (0)
#define PG8_MMA(ai, bj, At, Bt) do { __builtin_amdgcn_s_setprio(1); _Pragma("unroll") for (int m = 0; m < 4; ++m) _Pragma("unroll") for (int n = 0; n < 2; ++n) _Pragma("unroll") for (int k = 0; k < 2; ++k) \
        acc[ai][bj][m][n] = __builtin_amdgcn_mfma_f32_16x16x32_bf16(Bt[n][k], At[m][k], acc[ai][bj][m][n], 0, 0, 0); __builtin_amdgcn_s_setprio(0); } while (0)
#define PG8_WAIT_V(n) asm volatile("s_waitcnt vmcnt(" #n ")" ::: "memory")
#define PG8_WAIT_L(n) asm volatile("s_waitcnt lgkmcnt(" #n ")" ::: "memory")
#define PG8_BAR __builtin_amdgcn_s_barrier()
#define PG8_SCHED __builtin_amdgcn_sched_barrier(0)
    Unit cur, nxt; int ui = 0;
    if (!S.next(0, cur)) return;
    f32x4 acc[2][2][4][2];
#pragma unroll
    for (int a = 0; a < 2; ++a)
#pragma unroll
        for (int b = 0; b < 2; ++b)
#pragma unroll
            for (int m = 0; m < 4; ++m)
#pragma unroll
                for (int n = 0; n < 2; ++n) acc[a][b][m][n] = (f32x4){0.f, 0.f, 0.f, 0.f};
    bf16x8 At[4][2], B0[2][2], B1[2][2];
    const char* cA = P.a_base(cur); const char* cB = P.b_base(cur);
    PG8_STAGE(PG8_SB(0, 0), cB, voffB); PG8_STAGE(PG8_SB(0, 1), cB + hstepB, voffB); PG8_STAGE(PG8_SA(0, 0), cA, voffA); PG8_STAGE(PG8_SA(0, 1), cA + hstepA, voffA);
    if (wr == 1) PG8_BAR;
    PG8_WAIT_V(2); PG8_BAR;
    PG8_STAGE(PG8_SB(1, 0), cB + kstep, voffB); PG8_STAGE(PG8_SA(1, 0), cA + kstep, voffA); PG8_STAGE(PG8_SB(1, 1), cB + hstepB + kstep, voffB);
    PG8_WAIT_V(6); PG8_BAR;
    for (;;) {
        const bool has_next = S.next(ui + 1, nxt);
        const char* nA = has_next ? P.a_base(nxt) : cA; const char* nB = has_next ? P.b_base(nxt) : cB;
        for (int t = 0; t < nt; t += 2) {
            const bool last = (t == nt - 2);
            const char* a1 = cA + (size_t)(t + 1) * kstep;
            const char* a2 = last ? nA : cA + (size_t)(t + 2) * kstep; const char* b2 = last ? nB : cB + (size_t)(t + 2) * kstep;
            const char* a3 = a2 + kstep; const char* b3 = b2 + kstep;
            PG8_LDB(B0, 0, 0); PG8_LDB(B1, 0, 1); PG8_SCHED; PG8_LDA(At, 0, 0); PG8_STAGE(PG8_SA(1, 1), a1 + hstepA, voffA);
            PG8_WAIT_V(8); PG8_WAIT_L(0); PG8_BAR; PG8_MMA(0, 0, At, B0); PG8_MMA(0, 1, At, B1); PG8_BAR; PG8_SCHED;
            PG8_LDA(At, 0, 1); PG8_STAGE(PG8_SB(0, 0), b2, voffB); PG8_STAGE(PG8_SB(0, 1), b2 + hstepB, voffB); PG8_STAGE(PG8_SA(0, 0), a2, voffA);
            PG8_WAIT_V(8); PG8_WAIT_L(0); PG8_BAR; PG8_MMA(1, 0, At, B0); PG8_MMA(1, 1, At, B1); PG8_BAR; PG8_SCHED;
            PG8_LDB(B0, 1, 0); PG8_LDB(B1, 1, 1); PG8_SCHED; PG8_LDA(At, 1, 0); PG8_STAGE(PG8_SA(0, 1), a2 + hstepA, voffA);
            PG8_WAIT_V(8); PG8_WAIT_L(0); PG8_BAR; PG8_MMA(0, 0, At, B0); PG8_MMA(0, 1, At, B1); PG8_BAR; PG8_SCHED;
            PG8_LDA(At, 1, 1); PG8_STAGE(PG8_SB(1, 0), b3, voffB); PG8_STAGE(PG8_SB(1, 1), b3 + hstepB, voffB); PG8_STAGE(PG8_SA(1, 0), a3, voffA);
            PG8_WAIT_V(8); PG8_WAIT_L(0); PG8_BAR; PG8_MMA(1, 0, At, B0); PG8_MMA(1, 1, At, B1); PG8_BAR; PG8_SCHED;
        }
        if constexpr (ALIGN_EPI) { if (wr == 0) PG8_BAR; }
        { int fr_ = fr, fq_ = fq; asm volatile("" : "+v"(fr_), "+v"(fq_)); E(acc, cur, wr, wc, fr_, fq_); }
        if (!has_next) break;
#pragma unroll
        for (int a = 0; a < 2; ++a)
#pragma unroll
            for (int b = 0; b < 2; ++b)
#pragma unroll
                for (int m = 0; m < 4; ++m)
#pragma unroll
                    for (int n = 0; n < 2; ++n) acc[a][b][m][n] = (f32x4){0.f, 0.f, 0.f, 0.f};
        cur = nxt; cA = nA; cB = nB; ++ui;
        if constexpr (ALIGN_EPI) { if (wr == 1) PG8_BAR; }
    }
    PG8_WAIT_V(0);
    if constexpr (!ALIGN_EPI) { if (wr == 0) PG8_BAR; }
    PG8_BAR;
#undef PG8_SA
#undef PG8_SB
#undef PG8_STAGE
#undef PG8_LDA
#undef PG8_LDB
#undef PG8_MMA
#undef PG8_WAIT_V
#undef PG8_WAIT_L
#undef PG8_BAR
#undef PG8_SCHED
}

typedef f32x4 Acc[2][2][4][2];
struct EpiBf16 {
    bf16_t* O; int ldc; int ncols;
    __device__ __forceinline__ void operator()(const Acc& acc, const Unit& u, int wr, int wc, int fr, int fq) const {
        const int row0 = u.pm * BM + wr * 64 + fr, col0 = u.pn * BM + wc * 32 + 8 * fq;
#pragma unroll
        for (int ai = 0; ai < 2; ++ai)
#pragma unroll
            for (int m = 0; m < 4; ++m) { bf16_t* rowp = O + (size_t)(row0 + ai * HALF + m * 16) * ldc + col0;
#pragma unroll
                for (int bj = 0; bj < 2; ++bj) { const f32x4 v0 = acc[ai][bj][m][0], v1 = acc[ai][bj][m][1];
                    u32x4 w; w.x = cvt_pk_bf16(v0[0], v0[1]); w.y = cvt_pk_bf16(v0[2], v0[3]); w.z = cvt_pk_bf16(v1[0], v1[1]); w.w = cvt_pk_bf16(v1[2], v1[3]);
                    if (col0 + bj * HALF < ncols) *(u32x4*)(rowp + bj * HALF) = w; } }
    }
};
__device__ __forceinline__ void ld8(const float* p, f32x4& a, f32x4& b) { a = *(const f32x4*)p; b = *(const f32x4*)(p + 4); }
__device__ __forceinline__ void ld8(const bf16_t* p, f32x4& a, f32x4& b) { const u32x4 w = *(const u32x4*)p; a = (f32x4){bflo(w.x), bfhi(w.x), bflo(w.y), bfhi(w.y)}; b = (f32x4){bflo(w.z), bfhi(w.z), bflo(w.w), bfhi(w.w)}; }
__device__ __forceinline__ void st8(float* p, const f32x4& a, const f32x4& b) { *(f32x4*)p = a; *(f32x4*)(p + 4) = b; }
__device__ __forceinline__ void st8(bf16_t* p, const f32x4& a, const f32x4& b) { u32x4 w; w.x = cvt_pk_bf16(a[0], a[1]); w.y = cvt_pk_bf16(a[2], a[3]); w.z = cvt_pk_bf16(b[0], b[1]); w.w = cvt_pk_bf16(b[2], b[3]); *(u32x4*)p = w; }
template <class TR, class TO> struct EpiResid {
    const TR* res; TO* out; const float* gate0; int gstride;
    __device__ __forceinline__ void operator()(const Acc& acc, const Unit& u, int wr, int wc, int fr, int fq) const {
        const int row0 = u.pm * BM + wr * 64 + fr, col0 = u.pn * BM + wc * 32 + 8 * fq;
        const float* gp = gate0 + (size_t)(u.pm >> 5) * gstride + col0;
        f32x4 g[2][2];
#pragma unroll
        for (int bj = 0; bj < 2; ++bj)
#pragma unroll
            for (int n = 0; n < 2; ++n) g[bj][n] = *(const f32x4*)(gp + bj * HALF + 4 * n);
#pragma unroll
        for (int ai = 0; ai < 2; ++ai)
#pragma unroll
            for (int m = 0; m < 4; ++m) { const size_t off = (size_t)(row0 + ai * HALF + m * 16) * 1024 + col0;
#pragma unroll
                for (int bj = 0; bj < 2; ++bj) { f32x4 r0, r1; ld8(res + off + bj * HALF, r0, r1);
                    st8(out + off + bj * HALF, r0 + g[bj][0] * acc[ai][bj][m][0], r1 + g[bj][1] * acc[ai][bj][m][1]); } }
    }
};
struct EpiSwiglu {
    bf16_t* H;
    __device__ __forceinline__ void operator()(const Acc& acc, const Unit& u, int wr, int wc, int fr, int fq) const {
        const int row0 = u.pm * BM + wr * 64 + fr, col0 = u.pn * HALF + wc * 32 + 8 * fq;
#pragma unroll
        for (int ai = 0; ai < 2; ++ai)
#pragma unroll
            for (int m = 0; m < 4; ++m) { bf16_t* rowp = H + (size_t)(row0 + ai * HALF + m * 16) * DFF + col0;
                f32x4 h0, h1;
#pragma unroll
                for (int j = 0; j < 4; ++j) { h0[j] = silu_f(acc[ai][0][m][0][j]) * acc[ai][1][m][0][j]; h1[j] = silu_f(acc[ai][0][m][1][j]) * acc[ai][1][m][1][j]; }
                u32x4 w; w.x = cvt_pk_bf16(h0[0], h0[1]); w.y = cvt_pk_bf16(h0[2], h0[3]); w.z = cvt_pk_bf16(h1[0], h1[1]); w.w = cvt_pk_bf16(h1[2], h1[3]);
                *(u32x4*)rowp = w; }
    }
};
struct EpiG1 {
    bf16_t* Z1;
    __device__ __forceinline__ void operator()(const Acc& acc, const Unit& u, int wr, int wc, int fr, int fq) const {
        const unsigned b = u.pn >> 5, q = u.pn & 31, ns0 = wc * 32 + 8 * fq;
        const unsigned j0 = u.pm * BM + wr * 64 + fr;
        const unsigned cs = j0 >> 10;
        bf16_t* base = Z1 + ((size_t)(b * 1024u) * 64u * 256u + (size_t)(2u * q) * 256u + cs * 128u + ns0);
#pragma unroll
        for (int ai = 0; ai < 2; ++ai)
#pragma unroll
            for (int m = 0; m < 4; ++m) { const unsigned ch = (j0 + ai * HALF + m * 16) & 1023u; bf16_t* rp = base + (size_t)ch * (64u * 256u);
#pragma unroll
                for (int bj = 0; bj < 2; ++bj) { const f32x4 v0 = acc[ai][bj][m][0], v1 = acc[ai][bj][m][1];
                    u32x4 w; w.x = cvt_pk_bf16(v0[0], v0[1]); w.y = cvt_pk_bf16(v0[2], v0[3]); w.z = cvt_pk_bf16(v1[0], v1[1]); w.w = cvt_pk_bf16(v1[2], v1[3]);
                    *(u32x4*)(rp + bj * 256) = w; }
                asm volatile("" ::: "memory"); }
    }
};
struct EpiG2 {
    bf16_t* G2;
    __device__ __forceinline__ void operator()(const Acc& acc, const Unit& u, int wr, int wc, int fr, int fq) const {
        const unsigned rho00 = u.pn * BM + wc * 32 + 8 * fq;
#pragma unroll
        for (int m = 0; m < 4; ++m) { const unsigned ka = wr * 64 + m * 16 + fr; const float kaf = (float)ka * (1.0f / 8192.0f);
#pragma unroll
            for (int bj = 0; bj < 2; ++bj) { const unsigned rho0 = rho00 + bj * HALF, bc = rho0 >> 6, nf0 = rho0 & 63u;
                bf16_t* dp = G2 + ((size_t)(bc * 128u + ka) * 128u + nf0);
#pragma unroll
                for (int n = 0; n < 2; ++n) { const f32x4 gr = acc[0][bj][m][n], gi = acc[1][bj][m][n]; f32x4 o_r, o_i;
#pragma unroll
                    for (int j = 0; j < 4; ++j) { const float rev = (float)(nf0 + 4 * n + j) * kaf; const float c = cos_rev(rev), s = sin_rev(rev);
                        o_r[j] = gr[j] * c + gi[j] * s; o_i[j] = gi[j] * c - gr[j] * s; }
                    u32x2 wre, wim; wre.x = cvt_pk_bf16(o_r[0], o_r[1]); wre.y = cvt_pk_bf16(o_r[2], o_r[3]); wim.x = cvt_pk_bf16(o_i[0], o_i[1]); wim.y = cvt_pk_bf16(o_i[2], o_i[3]);
                    *(u32x2*)(dp + 4 * n) = wre; *(u32x2*)(dp + 64 + 4 * n) = wim;
                    asm volatile("" ::: "memory"); } } }
    }
};
struct EpiG3 {
    bf16_t* out; const float* gate0; int gstride;
    __device__ __forceinline__ void operator()(const Acc& acc, const Unit& u, int wr, int wc, int fr, int fq) const {
        const int chblk = u.pn & 3, kag = (u.pn >> 2) & 31, b = u.pn >> 7, ch0 = chblk * 256 + wc * 32 + 8 * fq;
        const float* gp = gate0 + (size_t)b * gstride + ch0;
        f32x4 g[2][2];
#pragma unroll
        for (int bj = 0; bj < 2; ++bj)
#pragma unroll
            for (int n = 0; n < 2; ++n) g[bj][n] = *(const f32x4*)(gp + bj * HALF + 4 * n);
#pragma unroll
        for (int ai = 0; ai < 2; ++ai)
#pragma unroll
            for (int m = 0; m < 4; ++m) { const int r = ai * HALF + wr * 64 + m * 16 + fr, s = r >> 6, kb = r & 63;
                const size_t off = ((size_t)b * 8192 + 4 * kag + s + 128 * kb) * 1024 + ch0;
#pragma unroll
                for (int bj = 0; bj < 2; ++bj) { f32x4 r0, r1; ld8(out + off + bj * HALF, r0, r1);
                    st8(out + off + bj * HALF, r0 + g[bj][0] * acc[ai][bj][m][0], r1 + g[bj][1] * acc[ai][bj][m][1]); } }
    }
};
struct ProbWc {
    const char* WfT; const char* D; int K; unsigned rsA, rsB; size_t hsA, hsB;
    __device__ __forceinline__ const char* a_base(const Unit& u) const { return WfT + ((size_t)(u.pm & 3) * 256 * 1024 + (size_t)u.pn * 256) * 2; }
    __device__ __forceinline__ const char* b_base(const Unit& u) const { return D + (size_t)(u.pm >> 2) * 256 * 256 * 2; }
};
struct ProbG1 {
    const char* WcT; const char* XN; int K; unsigned rsA, rsB; size_t hsA, hsB;
    __device__ __forceinline__ const char* a_base(const Unit& u) const { return WcT + (size_t)u.pm * 256 * 1024 * 2; }
    __device__ __forceinline__ const char* b_base(const Unit& u) const { return XN + ((size_t)(u.pn >> 5) * 8192 + 2 * (u.pn & 31)) * 2048; }
};
struct ProbG3 {
    const char* W2d; const char* G2; int K; unsigned rsA, rsB; size_t hsA, hsB;
    __device__ __forceinline__ const char* a_base(const Unit&) const { return W2d; }
    __device__ __forceinline__ const char* b_base(const Unit& u) const { const int chblk = u.pn & 3, kag = (u.pn >> 2) & 31, b = u.pn >> 7;
        return G2 + (((size_t)(b * 1024 + chblk * 256) * 128 + 4 * kag) * 128) * 2; }
};
}

#define RLX_AGENT __ATOMIC_RELAXED, __HIP_MEMORY_SCOPE_AGENT
#define XB_TMO      128
#define XB_XCNT(j)  (256  + 64 * (j))
#define XB_XSUB(j)  (1280 + 64 * (j))
#define XB_XGEN(j)  (2304 + 64 * (j))
#define XB_TOP      3328
#define XB_TOPGEN   3392
#define XCD_BAR_WORDS 3456
#define XB_SPIN_CAP (1u << 18)

__device__ __forceinline__ unsigned xb_ld(unsigned* p)              { return __hip_atomic_load(p, __ATOMIC_RELAXED, __HIP_MEMORY_SCOPE_AGENT); }
__device__ __forceinline__ unsigned xb_add(unsigned* p, unsigned v) { return __hip_atomic_fetch_add(p, v, __ATOMIC_RELAXED, __HIP_MEMORY_SCOPE_AGENT); }
__device__ __forceinline__ unsigned xb_xcc_id() { return (unsigned)__builtin_amdgcn_s_getreg((3 << 11) | 20) & 0xFu; }
#define XB_SPIN(cond, bar) do { unsigned _sp = 0; while (cond) { __builtin_amdgcn_s_sleep(1); \
    if ((++_sp & 255u) == 0u) { if (xb_ld(&(bar)[XB_TMO])) break; if (_sp > XB_SPIN_CAP) { atomicAdd(&(bar)[XB_TMO], 1u); break; } } } } while (0)

struct XcdBarrier {
    unsigned* bar; unsigned x;
    volatile LAS unsigned* st;
};

__device__ __forceinline__ XcdBarrier xcd_barrier_post(unsigned* bar, volatile LAS unsigned* st) {
    XcdBarrier b; b.bar = bar; b.x = xb_xcc_id(); b.st = st;
    if (threadIdx.x == 0) (void)xb_add(&bar[XB_XCNT(b.x)], 1u);
    return b;
}
__device__ __forceinline__ void xcd_barrier_complete(unsigned* bar, unsigned x, unsigned& nloc, unsigned& nx) {
    const unsigned G = gridDim.x * gridDim.y * gridDim.z;
    unsigned sum, cnt, mine, sp = 0u;
    for (;;) {
        sum = 0u; cnt = 0u; mine = 0u;
#pragma unroll
        for (unsigned j = 0; j < 16; ++j) { const unsigned c = xb_ld(&bar[XB_XCNT(j)]); sum += c; cnt += (c > 0u) ? 1u : 0u; mine = (j == x) ? c : mine; }
        if (sum == G) break;
        __builtin_amdgcn_s_sleep(1);
        if ((++sp & 255u) == 0u) { if (xb_ld(&bar[XB_TMO])) break; if (sp > XB_SPIN_CAP) { atomicAdd(&bar[XB_TMO], 1u); break; } }
    }
    nloc = mine > 0u ? mine : 1u; nx = cnt > 0u ? cnt : 1u;
}

__device__ __forceinline__ void xcd_barrier(const XcdBarrier& b) {
    asm volatile("s_waitcnt vmcnt(0)" ::: "memory");
    __syncthreads();
    if (threadIdx.x == 0) {
        unsigned* bar = b.bar;
        __builtin_amdgcn_s_waitcnt(0);
        unsigned nloc = b.st[0], nx = b.st[1];
        if (nloc == 0u) { xcd_barrier_complete(bar, b.x, nloc, nx); b.st[0] = nloc; b.st[1] = nx; }
        const unsigned old = xb_add(&bar[XB_XSUB(b.x)], 1u);
        const unsigned gen = old / nloc;
        if (old + 1u == (gen + 1u) * nloc) {
            __builtin_amdgcn_fence(__ATOMIC_RELEASE, "agent");
            asm volatile("s_waitcnt vmcnt(0)" ::: "memory");
            const unsigned og = xb_add(&bar[XB_TOP], 1u);
            const unsigned tg = og / nx;
            if (og + 1u == (tg + 1u) * nx) xb_add(&bar[XB_TOPGEN], 1u);
            else XB_SPIN(xb_ld(&bar[XB_TOPGEN]) == tg, bar);
            __builtin_amdgcn_fence(__ATOMIC_ACQUIRE, "agent");
            xb_add(&bar[XB_XGEN(b.x)], 1u);
            asm volatile("s_waitcnt vmcnt(0)" ::: "memory");
        } else {
            XB_SPIN(xb_ld(&bar[XB_XGEN(b.x)]) == gen, bar);
            __builtin_amdgcn_fence(__ATOMIC_ACQUIRE, "agent");
            asm volatile("s_waitcnt vmcnt(0)" ::: "memory");
        }
    }
    __syncthreads();
}
struct Args {
    const float* in[21]; float* out; unsigned char* ws;
};
constexpr int NWAVES = 8, NTHR = 512;
constexpr int LDS_BYTES = 147456;

__device__ __forceinline__ void ada_item(const Args& a, int item, LAS unsigned char* lds, int tid, int lane, int wave) {
    const int layer = item / 96, n0 = (item % 96) * 64;
    LAS float* sil = (LAS float*)lds; LAS float* red = sil + 3072;
    const float* c = a.in[1]; const float* cc = a.in[3];
    for (int i = tid; i < 3072; i += NTHR) { const int v = i >> 10, k = i & 1023; const float cv = (v < 2) ? c[v * 1024 + k] : cc[k]; sil[i] = cv / (1.0f + __expf(-cv)); }
    __syncthreads();
    const float* W = a.in[4] + (size_t)layer * 1024 * 6144 + n0 + lane;
    float a0 = 0.f, a1 = 0.f, a2 = 0.f; const int k0 = wave * 128;
#pragma unroll 8
    for (int kk = 0; kk < 128; ++kk) { const int k = k0 + kk; const float w = W[(size_t)k * 6144]; a0 += sil[k] * w; a1 += sil[1024 + k] * w; a2 += sil[2048 + k] * w; }
    red[(wave * 3 + 0) * 64 + lane] = a0; red[(wave * 3 + 1) * 64 + lane] = a1; red[(wave * 3 + 2) * 64 + lane] = a2;
    __syncthreads();
    if (tid < 192) { const int v = tid >> 6, l = tid & 63; float s = a.in[5][layer * 6144 + n0 + l];
#pragma unroll
        for (int w = 0; w < 8; ++w) s += red[(w * 3 + v) * 64 + l];
        ((float*)(a.ws + WS_MOD))[(layer * 3 + v) * 6144 + n0 + l] = s; }
    __syncthreads();
}
__device__ __forceinline__ void transpose_item(const float* W, int N, bf16_t* WT, int ldk, int k0, int n0, int drow0, LAS float* scr, int lane, const float* kscale = nullptr) {
#pragma unroll 8
    for (int i = 0; i < 32; ++i) { const int kk = 2 * i + (lane >> 5); float w = W[(size_t)(k0 + kk) * N + n0 + (lane & 31)]; if (kscale) w *= kscale[k0 + kk]; scr[kk * 33 + (lane & 31)] = w; }
    LDS_WAIT(); asm volatile("" ::: "memory");
    const int c = lane & 7;
#pragma unroll
    for (int j = 0; j < 4; ++j) { const int n = (lane >> 3) + 8 * j; const LAS float* s = scr + (8 * c) * 33 + n;
        u32x4 o; o.x = pk2(s[0 * 33], s[1 * 33]); o.y = pk2(s[2 * 33], s[3 * 33]); o.z = pk2(s[4 * 33], s[5 * 33]); o.w = pk2(s[6 * 33], s[7 * 33]);
        *(u32x4*)(WT + (size_t)(drow0 + n) * ldk + k0 + 8 * c) = o; }
    LDS_WAIT(); asm volatile("" ::: "memory");
}
__device__ __forceinline__ void p0_prologue(const Args& a, LAS unsigned char* lds, int tid, int lane, int wave) {
    asm volatile("" : "+v"(lane), "+v"(tid));
    unsigned char* ws = a.ws;
    if (blockIdx.x < 192) ada_item(a, blockIdx.x, lds, tid, lane, wave);
    LAS float* scr = (LAS float*)(lds + wave * 16384);
    const int gw = blockIdx.x * NWAVES + wave, NGW = gridDim.x * NWAVES;
    constexpr int I_IN = 16 * 69, I_UQ = 6 * 24, I_UKV = 4 * 32, I_O = 512, I_F = 512, I_13 = 16 * 88, I_2 = 44 * 32;
    constexpr int NITEMS = I_IN + I_UQ + I_UKV + I_O + I_F + 2 * (2 * I_13 + I_2);
    for (int it = gw; it < NITEMS; it += NGW) {
        int r = it;
        if (r < I_IN) { const int kb = r / 69, nb = r % 69; transpose_item(a.in[8], NIN, (bf16_t*)(ws + WS_WIN), 1024, 64 * kb, 32 * nb, 32 * nb, scr, lane); continue; } r -= I_IN;
        if (r < I_UQ) { const int kb = r / 24, nb = r % 24; transpose_item(a.in[11], 768, (bf16_t*)(ws + WS_WUQ), 384, 64 * kb, 32 * nb, 32 * nb, scr, lane, a.in[9]); continue; } r -= I_UQ;
        if (r < I_UKV) { const int kb = r / 32, nb = r % 32; transpose_item(a.in[12], 1024, (bf16_t*)(ws + WS_WUKV), 256, 64 * kb, 32 * nb, 32 * nb, scr, lane, a.in[10]); continue; } r -= I_UKV;
        if (r < I_O) { const int kb = r / 32, nb = r % 32; transpose_item(a.in[16], 1024, (bf16_t*)(ws + WS_WO), 1024, 64 * kb, 32 * nb, 32 * nb, scr, lane); continue; } r -= I_O;
        if (r < I_F) { const int kb = r / 32, nb = r % 32; transpose_item(a.in[17], 1024, (bf16_t*)(ws + WS_WF), 1024, 64 * kb, 32 * nb, 32 * nb, scr, lane); continue; } r -= I_F;
        const int layer = r / (2 * I_13 + I_2); r -= layer * (2 * I_13 + I_2);
        if (r < 2 * I_13) { const int s = r / I_13; r -= s * I_13; const int kb = r / 88, nb = r % 88, n0 = 32 * nb;
            transpose_item(a.in[s ? 19 : 18] + (size_t)layer * 1024 * DFF, DFF, (bf16_t*)(ws + WS_W13 + layer * W13_BYTES), 1024, 64 * kb, n0, 256 * (n0 >> 7) + 128 * s + (n0 & 127), scr, lane); continue; }
        r -= 2 * I_13;
        { const int kb = r / 32, nb = r % 32; transpose_item(a.in[20] + (size_t)layer * DFF * 1024, 1024, (bf16_t*)(ws + WS_W2 + layer * W2_BYTES), DFF, 64 * kb, 32 * nb, 32 * nb, scr, lane); }
    }
    const int gt = blockIdx.x * NTHR + tid, NGT = gridDim.x * NTHR;
    { unsigned* z = (unsigned*)(ws + WS_WIN + (size_t)NIN * 1024 * 2); for (int i = gt; i < 96 * 1024 / 2; i += NGT) z[i] = 0u; }
    { bf16_t* d = (bf16_t*)(ws + WS_D256);
      for (int i = gt; i < 131072; i += NGT) { const int cs = i >> 16, c = (i >> 8) & 255, cp = i & 255; const float rev = (float)((c * cp) & 255) * (1.0f / 256.0f);
          const float v = cs ? -sin_rev(rev) : cos_rev(rev); d[i] = (bf16_t)f2bf(v * 0.0625f); } }
    { bf16_t* d = (bf16_t*)(ws + WS_W1D);
      for (int i = gt; i < 65536; i += NGT) { const int row = i >> 8, col = i & 255, ro = row >> 7, ka = row & 127, ri = col >> 7, n = col & 127; const float rev = (float)((n * ka) & 127) * (1.0f / 128.0f);
          const float c = cos_rev(rev), s = sin_rev(rev); const float v = (ro == 0) ? (ri == 0 ? c : s) : (ri == 0 ? -s : c); d[i] = (bf16_t)f2bf(v * 0.08838834764831845f); } }
    { bf16_t* d = (bf16_t*)(ws + WS_W2D);
      for (int i = gt; i < 256 * 512; i += NGT) { const int row = i >> 9, col = i & 511, s = row >> 6, kb = row & 63, sp = col >> 7, ri = (col >> 6) & 1, n2 = col & 63; float v = 0.f;
          if (s == sp) { const float rev = (float)((n2 * kb) & 63) * (1.0f / 64.0f); v = (ri == 0 ? cos_rev(rev) : sin_rev(rev)) * 0.125f; }
          d[i] = (bf16_t)f2bf(v); } }
}

__device__ __forceinline__ void norm_row(const float* xrow, bf16_t* orow, const float* g, const float* sc, const float* sh, int lane) {
    const f32x4* xr = (const f32x4*)xrow + lane;
    f32x4 v[4]; float s = 0.f;
#pragma unroll
    for (int j = 0; j < 4; ++j) { v[j] = xr[64 * j]; s += (v[j].x * v[j].x + v[j].y * v[j].y) + (v[j].z * v[j].z + v[j].w * v[j].w); }
    const float rstd = rsqrtf(wave_sum(s) * (1.0f / 1024.0f) + EPS);
    u32x2* o8 = (u32x2*)orow + lane;
#pragma unroll
    for (int j = 0; j < 4; ++j) { const f32x4 gg = ((const f32x4*)g)[64 * j + lane], cc = ((const f32x4*)sc)[64 * j + lane], hh = ((const f32x4*)sh)[64 * j + lane];
        const f32x4 y = v[j] * rstd * gg * (cc + 1.0f) + hh; u32x2 w; w.x = pk2(y.x, y.y); w.y = pk2(y.z, y.w); o8[64 * j] = w; }
}
__device__ __forceinline__ void norm_pass(const float* src, int nrows, bf16_t* dst, const float* g, const float* mod, int sh_chunk, int vfixed, int lane, int wave) {
    asm volatile("" : "+v"(lane));
    const int gw = blockIdx.x * NWAVES + wave, NGW = gridDim.x * NWAVES;
    for (int r = gw; r < nrows; r += NGW) { const int v = vfixed >= 0 ? vfixed : (r >> 13); const float* mv = mod + v * 6144 + sh_chunk * 1024;
        norm_row(src + (size_t)r * 1024, dst + (size_t)r * 1024, g, mv + 1024, mv, lane); }
}

__device__ __forceinline__ void norm_pass_b(const bf16_t* src, int nrows, bf16_t* dst, const float* g, const float* mod, int sh_chunk, int lane, int wave) {
    asm volatile("" : "+v"(lane));
    const int gw = blockIdx.x * NWAVES + wave, NGW = gridDim.x * NWAVES;
#pragma unroll 1
    for (int b = 0; b < 2; ++b) {
        const float* mv = mod + b * 6144 + sh_chunk * 1024;
        f32x4 cg[4], cs[4];
#pragma unroll
        for (int j = 0; j < 4; ++j) { const int c = (j >> 1) * 512 + lane * 8 + (j & 1) * 4; const f32x4 gg = *(const f32x4*)(g + c), sc = *(const f32x4*)(mv + 1024 + c); cg[j] = gg * (sc + 1.0f); cs[j] = *(const f32x4*)(mv + c); }
        for (int r = b * 8192 + gw; r < (b + 1) * 8192 && r < nrows; r += NGW) {
            const bf16_t* xrow = src + (size_t)r * 1024; bf16_t* orow = dst + (size_t)r * 1024;
            f32x4 v[4]; pg8::ld8(xrow + lane * 8, v[0], v[1]); pg8::ld8(xrow + 512 + lane * 8, v[2], v[3]); float s = 0.f;
#pragma unroll
            for (int j = 0; j < 4; ++j) s += (v[j].x * v[j].x + v[j].y * v[j].y) + (v[j].z * v[j].z + v[j].w * v[j].w);
            const float rstd = rsqrtf(wave_sum(s) * (1.0f / 1024.0f) + EPS);
            pg8::st8(orow + lane * 8, v[0] * rstd * cg[0] + cs[0], v[1] * rstd * cg[1] + cs[1]);
            pg8::st8(orow + 512 + lane * 8, v[2] * rstd * cg[2] + cs[2], v[3] * rstd * cg[3] + cs[3]);
        }
    }
}

__device__ __forceinline__ float sumsq8(u32x4 c) { float s = 0.f;
#pragma unroll
    for (int i = 0; i < 4; ++i) { const float a = bflo(c[i]), b = bfhi(c[i]); s += a * a + b * b; } return s; }
__device__ __forceinline__ u32x4 scale8(u32x4 c, float r, const float* g) { const f32x4 g0 = *(const f32x4*)g, g1 = *(const f32x4*)(g + 4); u32x4 o;
    o.x = pk2(bflo(c.x) * r * g0.x, bfhi(c.x) * r * g0.y); o.y = pk2(bflo(c.y) * r * g0.z, bfhi(c.y) * r * g0.w);
    o.z = pk2(bflo(c.z) * r * g1.x, bfhi(c.z) * r * g1.y); o.w = pk2(bflo(c.w) * r * g1.z, bfhi(c.w) * r * g1.w); return o; }
__device__ __forceinline__ void conv_pass(const Args& a, int lane, int wave) {
    asm volatile("" : "+v"(lane));
    unsigned char* ws = a.ws;
    const bf16_t* P = (const bf16_t*)(ws + WS_B); bf16_t* MIX = (bf16_t*)(ws + WS_A);
    const float* cw = a.in[15];
    f32x4 w0[2], w1[2], w2[2];
#pragma unroll
    for (int i = 0; i < 2; ++i) { w0[i] = *(const f32x4*)(cw + 8 * lane + 4 * i); w1[i] = *(const f32x4*)(cw + 512 + 8 * lane + 4 * i); w2[i] = *(const f32x4*)(cw + 1024 + 8 * lane + 4 * i); }
    const int gw = blockIdx.x * NWAVES + wave, NGW = gridDim.x * NWAVES;
    for (int r = gw; r < ML; r += NGW) {
        const int t = r & (SEQ - 1);
        const bf16_t* cb = P + (size_t)r * PLD + 672 + 8 * lane;
        const u32x4 bg = *(const u32x4*)cb, cg0 = *(const u32x4*)(cb + 512), u0 = *(const u32x4*)(cb + 1024);
        u32x4 cgm = (u32x4){0u, 0u, 0u, 0u}, um = cgm, cgp = cgm, up = cgm;
        if (t > 0) { cgm = *(const u32x4*)(cb - PLD + 512); um = *(const u32x4*)(cb - PLD + 1024); }
        if (t < SEQ - 1) { cgp = *(const u32x4*)(cb + PLD + 512); up = *(const u32x4*)(cb + PLD + 1024); }
        u32x4 o;
#pragma unroll
        for (int i = 0; i < 4; ++i) {
            const float zl_m = bflo(cgm[i]) * bflo(um[i]), zh_m = bfhi(cgm[i]) * bfhi(um[i]);
            const float zl_0 = bflo(cg0[i]) * bflo(u0[i]), zh_0 = bfhi(cg0[i]) * bfhi(u0[i]);
            const float zl_p = bflo(cgp[i]) * bflo(up[i]), zh_p = bfhi(cgp[i]) * bfhi(up[i]);
            const int e = 2 * i;
            const float yl = zl_m * w0[e >> 2][e & 3] + zl_0 * w1[e >> 2][e & 3] + zl_p * w2[e >> 2][e & 3];
            const float yh = zh_m * w0[(e + 1) >> 2][(e + 1) & 3] + zh_0 * w1[(e + 1) >> 2][(e + 1) & 3] + zh_p * w2[(e + 1) >> 2][(e + 1) & 3];
            o[i] = pk2(bflo(bg[i]) * yl, bfhi(bg[i]) * yh);
        }
        *(u32x4*)(MIX + (size_t)r * 1024 + 512 + 8 * lane) = o;
    }
}

__device__ __forceinline__ void prep2_pass(const Args& a, LAS unsigned char* lds, int tid, int lane, int wave) {
    asm volatile("" : "+v"(lane), "+v"(tid));
    unsigned char* ws = a.ws;
    bf16_t* Q = (bf16_t*)(ws + WS_Q); const bf16_t* KV = (const bf16_t*)(ws + WS_KV); const bf16_t* P = (const bf16_t*)(ws + WS_B);
    LAS float* rkl = (LAS float*)(lds + 65536);
    bf16_t* Kf = (bf16_t*)(ws + WS_KF); bf16_t* Vt = (bf16_t*)(ws + WS_VT);
    const float* qgain = a.in[13]; const float* kgain = a.in[14];
    const int head = lane >> 3, sub = lane & 7;
    const float inv = __builtin_amdgcn_exp2f(-(float)sub * 1.6609640474436813f) * 0.15915494309189535f;
    float qgn[8], kgn[8], qgp[4], kgp[4];
#pragma unroll
    for (int e = 0; e < 8; ++e) { qgn[e] = qgain[8 * sub + e] * QSC; kgn[e] = kgain[8 * sub + e]; }
#pragma unroll
    for (int i = 0; i < 4; ++i) { qgp[i] = qgain[64 + sub + 8 * i] * QSC; kgp[i] = kgain[64 + sub + 8 * i]; }
    for (int blk = blockIdx.x; blk < MT / 64; blk += gridDim.x) {
        const int r0 = blk * 64; const bool latent = blk < 256;
        const int b = latent ? (blk >> 7) : ((blk - 256) >> 2);
        const int key0 = latent ? ((blk & 127) * 64) : (SEQ + ((blk - 256) & 3) * 64);
#pragma unroll
        for (int i = 0; i < 8; ++i) { const int id = tid + 512 * i, row = id >> 6, cc = id & 63, h = cc >> 3, part = cc & 7;
            const u32x4 v = *(const u32x4*)(KV + (size_t)(r0 + row) * 1024 + h * 128 + 64 + part * 8);
            *(LAS u32x4*)(lds + row * 1024 + cc * 16) = v; }
        for (int i = 0; i < 8; ++i) {
            const int r = r0 + 8 * wave + i, kl = 8 * wave + i;
            float cr = 1.f, sr = 0.f, ccol = 1.f, scol = 0.f;
            if (latent) { const int t = r & (SEQ - 1); const float ar = (float)(t >> 6) * inv, ac = (float)(t & 63) * inv;
                cr = cos_rev(ar - floorf(ar)); sr = sin_rev(ar - floorf(ar)); ccol = cos_rev(ac - floorf(ac)); scol = sin_rev(ac - floorf(ac)); }
            const bf16_t* prow = P + (size_t)r * PLD; const bf16_t* kpe = prow + 640;
            float rq, rkv;
            { const u32x4 c1 = *(const u32x4*)(prow + lane * 8); u32x4 c2 = (u32x4){0u, 0u, 0u, 0u}; if (lane < 16) c2 = *(const u32x4*)(prow + 512 + lane * 8);
              const float ss1 = sumsq8(c1), ss2 = sumsq8(c2);
              const float sq = wave_sum(lane < 48 ? ss1 : 0.f), skv = wave_sum((lane >= 48 ? ss1 : 0.f) + ss2);
              rq = rsqrtf(sq * (1.0f / 384.0f) + EPS); rkv = rsqrtf(skv * (1.0f / 256.0f) + EPS); if (lane == 0) rkl[kl] = rkv; }
            if (latent) {
                bf16_t* qp = Q + (size_t)r * 768 + head * 96;
                const u32x4 nv = *(const u32x4*)(qp + 8 * sub);
                float pe[4];
#pragma unroll
                for (int j = 0; j < 4; ++j) pe[j] = bf1(qp[64 + sub + 8 * j]) * rq;
                float ss = sumsq8(nv) * (rq * rq) + (pe[0] * pe[0] + pe[1] * pe[1]) + (pe[2] * pe[2] + pe[3] * pe[3]);
                ss += __shfl_xor(ss, 1); ss += __shfl_xor(ss, 2); ss += __shfl_xor(ss, 4);
                const float rs0 = rsqrtf(ss * (1.0f / 96.0f) + EPS), rs = rs0 * rq;
                u32x4 o; o.x = pk2(bflo(nv.x) * rs * qgn[0], bfhi(nv.x) * rs * qgn[1]); o.y = pk2(bflo(nv.y) * rs * qgn[2], bfhi(nv.y) * rs * qgn[3]);
                o.z = pk2(bflo(nv.z) * rs * qgn[4], bfhi(nv.z) * rs * qgn[5]); o.w = pk2(bflo(nv.w) * rs * qgn[6], bfhi(nv.w) * rs * qgn[7]);
                *(u32x4*)(qp + 8 * sub) = o;
                const float p0 = pe[0] * rs0 * qgp[0], p1 = pe[1] * rs0 * qgp[1], p2 = pe[2] * rs0 * qgp[2], p3 = pe[3] * rs0 * qgp[3];
                qp[64 + sub] = (bf16_t)f2bf(p0 * cr - p1 * sr); qp[72 + sub] = (bf16_t)f2bf(p1 * cr + p0 * sr);
                qp[80 + sub] = (bf16_t)f2bf(p2 * ccol - p3 * scol); qp[88 + sub] = (bf16_t)f2bf(p3 * ccol + p2 * scol);
            }
            {
                const u32x4 nv = *(const u32x4*)(KV + (size_t)r * 1024 + head * 128 + 8 * sub);
                float pe[4];
#pragma unroll
                for (int j = 0; j < 4; ++j) pe[j] = bf1(kpe[sub + 8 * j]);
                float ss = sumsq8(nv) * (rkv * rkv) + (pe[0] * pe[0] + pe[1] * pe[1]) + (pe[2] * pe[2] + pe[3] * pe[3]);
                ss += __shfl_xor(ss, 1); ss += __shfl_xor(ss, 2); ss += __shfl_xor(ss, 4);
                const float rs0 = rsqrtf(ss * (1.0f / 96.0f) + EPS), rs = rs0 * rkv;
                bf16_t* kp = Kf + ((size_t)(b * NH + head) * NKEY + key0 + kl) * DQK;
                u32x4 o; o.x = pk2(bflo(nv.x) * rs * kgn[0], bfhi(nv.x) * rs * kgn[1]); o.y = pk2(bflo(nv.y) * rs * kgn[2], bfhi(nv.y) * rs * kgn[3]);
                o.z = pk2(bflo(nv.z) * rs * kgn[4], bfhi(nv.z) * rs * kgn[5]); o.w = pk2(bflo(nv.w) * rs * kgn[6], bfhi(nv.w) * rs * kgn[7]);
                *(u32x4*)(kp + 8 * sub) = o;
                const float p0 = pe[0] * rs0 * kgp[0], p1 = pe[1] * rs0 * kgp[1], p2 = pe[2] * rs0 * kgp[2], p3 = pe[3] * rs0 * kgp[3];
                kp[64 + sub] = (bf16_t)f2bf(p0 * cr - p1 * sr); kp[72 + sub] = (bf16_t)f2bf(p1 * cr + p0 * sr);
                kp[80 + sub] = (bf16_t)f2bf(p2 * ccol - p3 * scol); kp[88 + sub] = (bf16_t)f2bf(p3 * ccol + p2 * scol);
            }
        }
        __syncthreads();
        { const int h = tid >> 6, d = tid & 63; bf16_t* vp = Vt + ((size_t)(b * NH + h) * 64 + d) * NKEY + key0;
#pragma unroll
          for (int i = 0; i < 8; ++i) { float e[8];
#pragma unroll
              for (int k = 0; k < 8; ++k) e[k] = bf1(*(const LAS unsigned short*)(lds + (8 * i + k) * 1024 + tid * 2)) * rkl[8 * i + k];
              u32x4 o; o.x = pk2(e[0], e[1]); o.y = pk2(e[2], e[3]); o.z = pk2(e[4], e[5]); o.w = pk2(e[6], e[7]);
              *(u32x4*)(vp + 8 * i) = o; } }
        __syncthreads();
    }
}

__device__ __forceinline__ float attn_rowmax(const f32x16& p0, const f32x16& p1) {
    float a = __builtin_fmaxf(__builtin_fmaxf(p0[0], p0[1]), p1[0]), b = __builtin_fmaxf(__builtin_fmaxf(p0[2], p0[3]), p1[1]);
    a = __builtin_fmaxf(__builtin_fmaxf(a, p1[2]), p1[3]);
#pragma unroll
    for (int r = 4; r < 16; r += 4) { a = __builtin_fmaxf(__builtin_fmaxf(a, p0[r]), p0[r + 1]); b = __builtin_fmaxf(__builtin_fmaxf(b, p0[r + 2]), p0[r + 3]);
        a = __builtin_fmaxf(__builtin_fmaxf(a, p1[r]), p1[r + 1]); b = __builtin_fmaxf(__builtin_fmaxf(b, p1[r + 2]), p1[r + 3]); }
    const float mx = __builtin_fmaxf(a, b);
    auto rr = __builtin_amdgcn_permlane32_swap(__float_as_uint(mx), __float_as_uint(mx), false, false);
    return __builtin_fmaxf(__uint_as_float(rr[0]), __uint_as_float(rr[1]));
}
__device__ __forceinline__ void attn_phase(const Args& a, LAS unsigned char* lds, int tid, int lane, int wid) {
    asm volatile("" : "+v"(lane), "+v"(tid));
    unsigned char* ws = a.ws;
    const bf16_t* Q = (const bf16_t*)(ws + WS_Q); const char* Kf = (const char*)(ws + WS_KF); const char* Vt = (const char*)(ws + WS_VT); bf16_t* MIX = (bf16_t*)(ws + WS_A);
    constexpr int NS = 4, KSLOT = 13312, VBASE = NS * KSLOT, VSLOT = 8192, NT = NKEY / 64;
    constexpr float THR = 8.0f;
    const int q = lane & 31, hi = lane >> 5;
    const int xcd = blockIdx.x & 7, l = blockIdx.x >> 3;
    const unsigned lds0 = (unsigned)(size_t)lds;
    unsigned koff[2];
#pragma unroll
    for (int i = 0; i < 2; ++i) { const int p = 64 * (wid + 8 * i) + lane, row = p / 13, c = p % 13, r31 = row & 31;
        const int key = (row & 32) + ((r31 & 19) | ((r31 & 4) << 1) | ((r31 & 8) >> 1)); koff[i] = (unsigned)(key * 192 + (c < 12 ? c : 11) * 16); }
    const bool k2 = wid < 5;
    unsigned voffv; { const int d = 8 * wid + (lane >> 3), cp = lane & 7, c = cp ^ ((d >> 1) & 7); voffv = (unsigned)(d * (NKEY * 2) + c * 16); }
    const unsigned kdst0 = lds0 + (unsigned)wid * 1024u, kdst1 = lds0 + (unsigned)(wid + 8) * 1024u, vdst = lds0 + VBASE + (unsigned)wid * 1024u;
    const int kro = q * 208 + hi * 16;
    int vro[4];
#pragma unroll
    for (int s = 0; s < 4; ++s) vro[s] = VBASE + q * 128 + (((2 * s + hi) ^ ((q >> 1) & 7)) * 16);
#define DMA_K(tile, slot) do { const char* kb_ = Kh + (size_t)(tile) * (64 * 192); pg8::glds16s(kb_, koff[0], kdst0 + (slot) * KSLOT); if (k2) pg8::glds16s(kb_, koff[1], kdst1 + (slot) * KSLOT); } while (0)
#define DMA_V(tile, slot) pg8::glds16s(Vh + (size_t)(tile) * 128, voffv, vdst + (slot) * VSLOT)
#define SBAR() __builtin_amdgcn_sched_barrier(0)
#define EXP2(P, R) do { P[R] = __builtin_amdgcn_exp2f(P[R]); P[R + 1] = __builtin_amdgcn_exp2f(P[R + 1]); rs2 += (f32x2){P[R], P[R + 1]}; } while (0)
#define PKP(P, B) __builtin_bit_cast(bf16x8, (u32x4){cvt_pk_bf16(P[B], P[B + 1]), cvt_pk_bf16(P[B + 2], P[B + 3]), cvt_pk_bf16(P[B + 4], P[B + 5]), cvt_pk_bf16(P[B + 6], P[B + 7])})
    for (int it = 0; it < 2; ++it) {
        const int bh = 2 * xcd + it, b = bh >> 3, h = bh & 7, qb = l;
        const size_t qrow = (size_t)b * SEQ + qb * 256 + wid * 32 + q;
        const char* Kh = Kf + (size_t)bh * NKEY * 192; const char* Vh = Vt + (size_t)bh * 64 * NKEY * 2;
        DMA_K(0, 0); DMA_K(1, 1); DMA_V(0, 0); DMA_K(2, 2); DMA_V(1, 1); DMA_K(3, 3); DMA_V(2, 2);
        bf16x8 qf[6];
#pragma unroll
        for (int d0 = 0; d0 < 6; ++d0) qf[d0] = *(const bf16x8*)(Q + qrow * 768 + h * 96 + d0 * 16 + hi * 8);
        asm volatile("s_waitcnt vmcnt(0) lgkmcnt(0)\n\ts_barrier" ::: "memory");
        f32x16 pc0 = {}, pc1 = {};
#pragma unroll
        for (int d0 = 0; d0 < 6; ++d0) {
            const bf16x8 a0 = *(const LAS bf16x8*)(lds + kro + d0 * 32), a1 = *(const LAS bf16x8*)(lds + kro + 32 * 208 + d0 * 32);
            pc0 = __builtin_amdgcn_mfma_f32_32x32x16_bf16(a0, qf[d0], pc0, 0, 0, 0); pc1 = __builtin_amdgcn_mfma_f32_32x32x16_bf16(a1, qf[d0], pc1, 0, 0, 0);
        }
        float m = attn_rowmax(pc0, pc1), lsum = 0.f;
#pragma unroll
        for (int r = 0; r < 16; ++r) { pc0[r] -= m; pc1[r] -= m; }
        f32x16 o0 = {}, o1 = {};
        f32x2 rs2 = (f32x2){0.f, 0.f};
        f32x16 negm;
#pragma unroll
        for (int r = 0; r < 16; ++r) negm[r] = -m;
        asm volatile("" : "+v"(negm));
        asm volatile("s_waitcnt lgkmcnt(0)\n\ts_barrier" ::: "memory");
#define ATT_ITER(PC0, PC1, PN0, PN1, T) do { \
            { const int tk_ = ((T) + 4 < NT) ? (T) + 4 : NT - 1, tv_ = ((T) + 3 < NT) ? (T) + 3 : NT - 1; DMA_K(tk_, (T) & 3); DMA_V(tv_, ((T) + 3) & 3); } \
            const LAS unsigned char* kn = lds + (((T) + 1) & 3) * KSLOT + kro; \
            bf16x8 kfa[6], kfb[6]; \
            _Pragma("unroll") for (int d0 = 0; d0 < 3; ++d0) { kfa[2 * d0] = *(const LAS bf16x8*)(kn + d0 * 32); kfa[2 * d0 + 1] = *(const LAS bf16x8*)(kn + 32 * 208 + d0 * 32); } \
            SBAR(); \
            PN0 = __builtin_amdgcn_mfma_f32_32x32x16_bf16(kfa[0], qf[0], negm, 0, 0, 0); EXP2(PC0, 0); SBAR(); \
            _Pragma("unroll") for (int d0 = 3; d0 < 6; ++d0) { kfb[2 * (d0 - 3)] = *(const LAS bf16x8*)(kn + d0 * 32); kfb[2 * (d0 - 3) + 1] = *(const LAS bf16x8*)(kn + 32 * 208 + d0 * 32); } \
            SBAR(); \
            PN1 = __builtin_amdgcn_mfma_f32_32x32x16_bf16(kfa[1], qf[0], negm, 0, 0, 0); EXP2(PC0, 2); SBAR(); \
            PN0 = __builtin_amdgcn_mfma_f32_32x32x16_bf16(kfa[2], qf[1], PN0, 0, 0, 0); EXP2(PC0, 4); EXP2(PC0, 6); SBAR(); \
            PN1 = __builtin_amdgcn_mfma_f32_32x32x16_bf16(kfa[3], qf[1], PN1, 0, 0, 0); EXP2(PC0, 8); SBAR(); \
            PN0 = __builtin_amdgcn_mfma_f32_32x32x16_bf16(kfa[4], qf[2], PN0, 0, 0, 0); EXP2(PC0, 10); EXP2(PC0, 12); SBAR(); \
            PN1 = __builtin_amdgcn_mfma_f32_32x32x16_bf16(kfa[5], qf[2], PN1, 0, 0, 0); EXP2(PC0, 14); SBAR(); \
            const LAS unsigned char* vb = lds + ((T) & 3) * VSLOT; \
            bf16x8 va[8]; \
            _Pragma("unroll") for (int s = 0; s < 4; ++s) { va[2 * s] = *(const LAS bf16x8*)(vb + vro[s]); va[2 * s + 1] = *(const LAS bf16x8*)(vb + vro[s] + 32 * 128); } \
            SBAR(); \
            PN0 = __builtin_amdgcn_mfma_f32_32x32x16_bf16(kfb[0], qf[3], PN0, 0, 0, 0); EXP2(PC1, 0); EXP2(PC1, 2); SBAR(); \
            PN1 = __builtin_amdgcn_mfma_f32_32x32x16_bf16(kfb[1], qf[3], PN1, 0, 0, 0); EXP2(PC1, 4); SBAR(); \
            PN0 = __builtin_amdgcn_mfma_f32_32x32x16_bf16(kfb[2], qf[4], PN0, 0, 0, 0); EXP2(PC1, 6); EXP2(PC1, 8); SBAR(); \
            PN1 = __builtin_amdgcn_mfma_f32_32x32x16_bf16(kfb[3], qf[4], PN1, 0, 0, 0); EXP2(PC1, 10); SBAR(); \
            PN0 = __builtin_amdgcn_mfma_f32_32x32x16_bf16(kfb[4], qf[5], PN0, 0, 0, 0); EXP2(PC1, 12); SBAR(); \
            PN1 = __builtin_amdgcn_mfma_f32_32x32x16_bf16(kfb[5], qf[5], PN1, 0, 0, 0); EXP2(PC1, 14); SBAR(); \
            { const bf16x8 pb0 = PKP(PC0, 0); \
              o0 = __builtin_amdgcn_mfma_f32_32x32x16_bf16(va[0], pb0, o0, 0, 0, 0); o1 = __builtin_amdgcn_mfma_f32_32x32x16_bf16(va[1], pb0, o1, 0, 0, 0); \
              const bf16x8 pb1 = PKP(PC0, 8); \
              o0 = __builtin_amdgcn_mfma_f32_32x32x16_bf16(va[2], pb1, o0, 0, 0, 0); o1 = __builtin_amdgcn_mfma_f32_32x32x16_bf16(va[3], pb1, o1, 0, 0, 0); \
              const bf16x8 pb2 = PKP(PC1, 0); \
              o0 = __builtin_amdgcn_mfma_f32_32x32x16_bf16(va[4], pb2, o0, 0, 0, 0); o1 = __builtin_amdgcn_mfma_f32_32x32x16_bf16(va[5], pb2, o1, 0, 0, 0); \
              const bf16x8 pb3 = PKP(PC1, 8); \
              o0 = __builtin_amdgcn_mfma_f32_32x32x16_bf16(va[6], pb3, o0, 0, 0, 0); o1 = __builtin_amdgcn_mfma_f32_32x32x16_bf16(va[7], pb3, o1, 0, 0, 0); } \
            if (k2) asm volatile("s_waitcnt vmcnt(6) lgkmcnt(0)\n\ts_barrier" ::: "memory"); \
            else asm volatile("s_waitcnt vmcnt(4) lgkmcnt(0)\n\ts_barrier" ::: "memory"); \
        } while (0)
        f32x16 pd0, pd1;
        static_assert(NT % 2 == 0, "two tiles per loop trip");
        for (int t = 0; t < NT; t += 2) {
            ATT_ITER(pc0, pc1, pd0, pd1, t);
            ATT_ITER(pd0, pd1, pc0, pc1, t + 1);
        }
#undef ATT_ITER
        lsum += rs2.x + rs2.y;
        const float lt = lsum + __shfl_xor(lsum, 32); const float il = 1.0f / lt;
        bf16_t* op = MIX + qrow * 1024 + h * 64 + 4 * hi;
#pragma unroll
        for (int g = 0; g < 4; ++g) {
            u32x2 w0, w1; w0.x = cvt_pk_bf16(o0[4 * g] * il, o0[4 * g + 1] * il); w0.y = cvt_pk_bf16(o0[4 * g + 2] * il, o0[4 * g + 3] * il);
            w1.x = cvt_pk_bf16(o1[4 * g] * il, o1[4 * g + 1] * il); w1.y = cvt_pk_bf16(o1[4 * g + 2] * il, o1[4 * g + 3] * il);
            *(u32x2*)(op + 8 * g) = w0; *(u32x2*)(op + 32 + 8 * g) = w1;
        }
        asm volatile("s_waitcnt vmcnt(0) lgkmcnt(0)\n\ts_barrier" ::: "memory");
    }
#undef DMA_K
#undef DMA_V
#undef SBAR
#undef EXP2
#undef PKP
}

__global__ void __launch_bounds__(NTHR, 2) fwd_kernel(Args a) {
    extern __shared__ __attribute__((aligned(16))) unsigned char lds_raw[];
    LAS unsigned char* lds = (LAS unsigned char*)lds_raw;
    cg::grid_group grid = cg::this_grid();
    unsigned* barw = (unsigned*)a.ws;
    volatile LAS unsigned* bst = (volatile LAS unsigned*)(lds_raw + 131072 + 64);
    if (threadIdx.x < 2) bst[threadIdx.x] = 0u;
    __syncthreads();
    XcdBarrier xbar = xcd_barrier_post(barw, bst);
    if (a.out == nullptr) grid.sync();
#define GSYNC() do { for (int s_ = 0; s_ < PROBE_SYNC; ++s_) xcd_barrier(xbar); } while (0)
    const int tid = threadIdx.x, lane = tid & 63, wave = __builtin_amdgcn_readfirstlane(tid >> 6);
    const int G = gridDim.x, cu = blockIdx.x;
    unsigned char* ws = a.ws;
    const float* mod = (const float*)(ws + WS_MOD);
    bf16_t* XN = (bf16_t*)(ws + WS_A);
    bf16_t* XB = (bf16_t*)(ws + WS_XB);

    p0_prologue(a, lds, tid, lane, wave);
    GSYNC();
    norm_pass(a.in[0], ML, XN, a.in[6], mod, 0, -1, lane, wave);
    norm_pass(a.in[2], MC, XN + (size_t)ML * 1024, a.in[6], mod, 0, 2, lane, wave);
    GSYNC();
    { pg8::ProbStd p = pg8::make_std(XN, 1024, ws + WS_WIN, 1024, 1024); pg8::StaticOrder S; S.init(MT, NINP, G, cu);
      pg8::EpiBf16 E{(bf16_t*)(ws + WS_B), PLD, NIN}; pg8::gemm_phase<pg8::EpiBf16, pg8::ProbStd, true>(lds, p, S, E); }
    { pg8::ProbWc p{(const char*)(ws + WS_WF), (const char*)(ws + WS_D256), 256, 1024 * 2, 256 * 2, (size_t)128 * 1024 * 2, (size_t)128 * 256 * 2};
      pg8::StaticOrder S; S.init(2048, 1024, G, (cu + 32) & 255);
      pg8::EpiBf16 E{(bf16_t*)(ws + WS_WC), 1024, 1 << 30}; pg8::gemm_phase<pg8::EpiBf16, pg8::ProbWc, true>(lds, p, S, E); }
    GSYNC();
    { pg8::ProbStd p = pg8::make_std(ws + WS_B, PLD, ws + WS_WUQ, QR, QR); pg8::StaticOrder S; S.init(ML, 768, G, cu);
      pg8::EpiBf16 E{(bf16_t*)(ws + WS_Q), 768, 1 << 30}; pg8::gemm_phase<pg8::EpiBf16, pg8::ProbStd, true>(lds, p, S, E); }
    { pg8::ProbStd p = pg8::make_std(ws + WS_B + QR * 2, PLD, ws + WS_WUKV, KVR, KVR); pg8::StaticOrder S; S.init(MT, 1024, G, (cu + 64) & 255);
      pg8::EpiBf16 E{(bf16_t*)(ws + WS_KV), 1024, 1 << 30}; pg8::gemm_phase<pg8::EpiBf16, pg8::ProbStd, true>(lds, p, S, E); }
    GSYNC();
    prep2_pass(a, lds, tid, lane, wave);
    conv_pass(a, lane, wave);
    GSYNC();
    for (int p_ = 0; p_ < PROBE_ATTN; ++p_) attn_phase(a, lds, tid, lane, wave);
    GSYNC();
    { pg8::ProbStd p = pg8::make_std(ws + WS_A, 1024, ws + WS_WO, 1024, 1024); pg8::StaticOrder S; S.init(ML, 1024, G, cu);
      typedef pg8::EpiResid<float, bf16_t> EP; EP E{a.in[0], XB, mod + 2 * 1024, 6144}; pg8::gemm_phase<EP, pg8::ProbStd, true>(lds, p, S, E); }
    GSYNC();
#pragma unroll
    for (int layer = 0; layer < 2; ++layer) {
        const float* modl = mod + layer * 3 * 6144;
        if (layer == 1) {
            norm_pass_b(XB, ML, XN, a.in[6] + 1024, modl, 0, lane, wave);
            GSYNC();
            { pg8::ProbG1 p{(const char*)(ws + WS_WC), (const char*)XN, 1024, 1024 * 2, 64 * 2048, (size_t)128 * 1024 * 2, (size_t)2048};
              pg8::StaticOrder S; S.init(2048, 16384, G, cu);
              pg8::EpiG1 E{(bf16_t*)(ws + WS_Z1)}; pg8::gemm_phase<pg8::EpiG1, pg8::ProbG1, true>(lds, p, S, E); }
            GSYNC();
            { pg8::ProbStd p = pg8::make_std(ws + WS_W1D, 256, ws + WS_Z1, 256, 256); pg8::StaticOrder S; S.init(256, 131072, G, cu);
              pg8::EpiG2 E{(bf16_t*)(ws + WS_G2)}; pg8::gemm_phase<pg8::EpiG2, pg8::ProbStd, true>(lds, p, S, E); }
            GSYNC();
            { pg8::ProbG3 p{(const char*)(ws + WS_W2D), (const char*)(ws + WS_G2), 512, 512 * 2, 128 * 128 * 2, (size_t)128 * 512 * 2, (size_t)128 * 128 * 128 * 2};
              pg8::StaticOrder S; S.init(256, 65536, G, cu);
              pg8::EpiG3 E{XB, modl + 2 * 1024, 6144}; pg8::gemm_phase<pg8::EpiG3, pg8::ProbG3, true>(lds, p, S, E); }
            GSYNC();
        }
        norm_pass_b(XB, ML, XN, a.in[7] + layer * 1024, modl, 3, lane, wave);
        GSYNC();
        { pg8::ProbStd p = pg8::make_std(XN, 1024, ws + WS_W13 + layer * W13_BYTES, 1024, 1024); pg8::StaticOrder S; S.init(ML, 2 * DFF, G, cu);
          pg8::EpiSwiglu E{(bf16_t*)(ws + WS_H)}; for (int p_ = 0; p_ < PROBE_FFNUP; ++p_) pg8::gemm_phase<pg8::EpiSwiglu, pg8::ProbStd, true>(lds, p, S, E); }
        GSYNC();
        { pg8::ProbStd p = pg8::make_std(ws + WS_H, DFF, ws + WS_W2 + layer * W2_BYTES, DFF, DFF); pg8::StaticOrder S; S.init(ML, 1024, G, cu);
          if (layer == 0) { typedef pg8::EpiResid<bf16_t, bf16_t> EP; EP E{XB, XB, modl + 5 * 1024, 6144}; pg8::gemm_phase<EP, pg8::ProbStd, true>(lds, p, S, E); }
          else { typedef pg8::EpiResid<bf16_t, float> EP; EP E{XB, a.out, modl + 5 * 1024, 6144}; pg8::gemm_phase<EP, pg8::ProbStd, true>(lds, p, S, E); } }
        if (layer == 0) GSYNC();
    }
}

extern "C" void kernel_launch(void* const* d_in, const int* in_sizes, int n_in, void* d_out, int out_size, void* d_ws, size_t ws_size, hipStream_t stream) {
    static int grid = 0;
    if (grid == 0) {
        if (n_in != 21 || out_size != ML * DM || ws_size < WS_END) { fprintf(stderr, "kernel_launch: unexpected problem (n_in %d out %d ws %zu)\n", n_in, out_size, ws_size); grid = -1; return; }
        int dev = 0, cus = 0, per_cu = 0;
        (void)hipGetDevice(&dev);
        (void)hipDeviceGetAttribute(&cus, hipDeviceAttributeMultiprocessorCount, dev);
        (void)hipFuncSetAttribute((const void*)fwd_kernel, hipFuncAttributeMaxDynamicSharedMemorySize, LDS_BYTES);
        (void)hipOccupancyMaxActiveBlocksPerMultiprocessor(&per_cu, (const void*)fwd_kernel, NTHR, LDS_BYTES);
        (void)hipGetLastError();
        grid = 256;
        if (cus < 256 || per_cu < 1) fprintf(stderr, "kernel_launch: cus %d per_cu %d\n", cus, per_cu);
    }
    if (grid < 0) return;
    Args a{};
    for (int i = 0; i < 21; ++i) a.in[i] = (const float*)d_in[i];
    a.out = (float*)d_out; a.ws = (unsigned char*)d_ws;
    (void)hipMemsetAsync(d_ws, 0, 16384, stream);
    void* args[] = {&a};
    hipError_t e = hipLaunchCooperativeKernel((const void*)fwd_kernel, dim3(grid), dim3(NTHR), args, LDS_BYTES, stream);
    if (e != hipSuccess) fprintf(stderr, "cooperative launch failed: %s\n", hipGetErrorString(e));
}
```

```cpp
#include <hip/hip_runtime.h>
#include <hip/hip_cooperative_groups.h>
#include <cstdio>
#include <cstdint>
namespace cg = cooperative_groups;
#ifndef PROBE_SYNC
#define PROBE_SYNC 1
#endif
#ifndef PROBE_ATTN
#define PROBE_ATTN 1
#endif
#ifndef PROBE_FFNUP
#define PROBE_FFNUP 1
#endif

#define LAS __attribute__((address_space(3)))
typedef unsigned short bf16_t;
typedef short bf16x8 __attribute__((ext_vector_type(8)));
typedef short s16x4 __attribute__((ext_vector_type(4)));
typedef float f32x4 __attribute__((ext_vector_type(4)));
typedef float f32x16 __attribute__((ext_vector_type(16)));
typedef unsigned u32x4 __attribute__((ext_vector_type(4)));
typedef unsigned u32x2 __attribute__((ext_vector_type(2)));
typedef float f32x2 __attribute__((ext_vector_type(2)));

constexpr int DM = 1024, SEQ = 8192, ML = 16384, MC = 512, MT = ML + MC;
constexpr int NINP = 2304, NIN = 2208, QR = 384, KVR = 256, NH = 8, DQK = 96, DFF = 2816, NKEY = 8448;
constexpr float EPS = 1e-6f;
constexpr float QSC = 0.10206207261596575f * 1.4426950408889634f;

constexpr size_t MiB = 1u << 20;
constexpr size_t WS_MOD = 1 * MiB;
constexpr size_t WS_WIN = 2 * MiB;
constexpr size_t WS_WUQ = WS_WIN + (size_t)NINP * 1024 * 2;
constexpr size_t WS_WUKV = WS_WUQ + (size_t)768 * 384 * 2;
constexpr size_t WS_WO = WS_WUKV + (size_t)1024 * 256 * 2;
constexpr size_t WS_WF = WS_WO + 2 * MiB;
constexpr size_t WS_WC = WS_WF + 2 * MiB;
constexpr size_t WS_D256 = WS_WC + 4 * MiB;
constexpr size_t WS_W1D = WS_D256 + 262144;
constexpr size_t WS_W2D = WS_W1D + 131072;
constexpr size_t WS_W13 = WS_W2D + 262144;
constexpr size_t W13_BYTES = (size_t)2 * DFF * 1024 * 2;
constexpr size_t WS_W2 = WS_W13 + 2 * W13_BYTES;
constexpr size_t W2_BYTES = (size_t)1024 * DFF * 2;
constexpr size_t WS_WEND = WS_W2 + 2 * W2_BYTES;
static_assert(WS_WEND <= 52 * MiB, "weights");
constexpr size_t WS_A = 52 * MiB;
constexpr int PLD = 2208;
constexpr size_t WS_B = 85 * MiB;
constexpr size_t WS_Q = 157 * MiB;
constexpr size_t WS_KV = 181 * MiB;
constexpr size_t WS_KF = 214 * MiB;
constexpr size_t WS_VT = 239 * MiB;
constexpr size_t WS_H = WS_B;
constexpr size_t WS_Z1 = WS_B;
constexpr size_t WS_G2 = WS_B + 64 * MiB;
constexpr size_t WS_XB = 218 * MiB;
constexpr size_t WS_END = 256 * MiB;

__device__ __forceinline__ unsigned f2bf(float f) { unsigned u = __builtin_bit_cast(unsigned, f); return (u + 0x7fffu + ((u >> 16) & 1u)) >> 16; }
__device__ __forceinline__ unsigned pk2(float lo, float hi) { return f2bf(lo) | (f2bf(hi) << 16); }
__device__ __forceinline__ float bflo(unsigned w) { return __builtin_bit_cast(float, w << 16); }
__device__ __forceinline__ float bfhi(unsigned w) { return __builtin_bit_cast(float, w & 0xffff0000u); }
__device__ __forceinline__ float bf1(bf16_t h) { return __builtin_bit_cast(float, (unsigned)h << 16); }
__device__ __forceinline__ unsigned cvt_pk_bf16(float lo, float hi) { unsigned r; asm volatile("v_cvt_pk_bf16_f32 %0, %1, %2" : "=v"(r) : "v"(lo), "v"(hi)); return r; }
__device__ __forceinline__ float wave_sum(float v) {
#pragma unroll
    for (int o = 1; o < 64; o <<= 1) v += __shfl_xor(v, o);
    return v;
}
__device__ __forceinline__ float sin_rev(float r) { return __builtin_amdgcn_sinf(r); }
__device__ __forceinline__ float cos_rev(float r) { return __builtin_amdgcn_cosf(r); }
__device__ __forceinline__ float silu_f(float x) { return x * __builtin_amdgcn_rcpf(1.0f + __builtin_amdgcn_exp2f(-1.4426950408889634f * x)); }
#define LDS_WAIT() asm volatile("s_waitcnt lgkmcnt(0)" ::: "memory")

namespace pg8 {
constexpr int BM = 256, BK = 64, HALF = 128, HTB = HALF * BK * 2, STAGE_BYTES = 8 * HTB, NXCD = 8, WGM = 2;
__host__ __device__ __forceinline__ int lds_byte(int r, int c) { const int st = (r >> 4) * 2 + (c >> 5), rr = r & 15, cc = c & 31, ob = rr * 64 + cc * 2; return st * 1024 + (ob ^ (((ob >> 9) & 1) << 5)); }
__host__ __device__ __forceinline__ void stage_rc(int b, int& R, int& C) { const int st = b / 1024, sb = b % 1024, swz = sb ^ (((sb >> 9) & 1) << 5); R = (st >> 1) * 16 + swz / 64; C = (st & 1) * 32 + (swz % 64) / 2; }
__host__ __device__ __forceinline__ int perm32(int rho) { const int n = rho >> 4, i = rho & 15; return 8 * (i >> 2) + 4 * n + (i & 3); }

__device__ __forceinline__ void glds16s(const char* sbase, unsigned voff, unsigned lds_dst) { unsigned keep;
    asm volatile("s_mov_b32 %0, m0\n\ts_mov_b32 m0, %3\n\ts_nop 0\n\tglobal_load_lds_dwordx4 %1, %2\n\ts_mov_b32 m0, %0" : "=&s"(keep) : "v"(voff), "s"(sbase), "s"(lds_dst) : "memory"); }
struct Unit { int pm, pn; };
struct StaticOrder {
    int nM, nN, nwg, G, c;
    __device__ void init(int M, int N, int G_, int c_) { nM = M / BM; nN = N / BM; nwg = nM * nN; G = G_; c = c_; }
    __device__ bool next(int i, Unit& u) const {
        const long L = (long)i * G + c; if (L >= nwg) return false;
        int wgid = (int)L; { const int q = nwg / NXCD, r = nwg % NXCD, xcd = wgid % NXCD, off = wgid / NXCD; wgid = (xcd < r ? xcd * (q + 1) : r * (q + 1) + (xcd - r) * q) + off; }
        const int nig = WGM * nN, gid = wgid / nig, fm = gid * WGM, gsz = (nM - fm) < WGM ? (nM - fm) : WGM;
        u.pm = fm + ((wgid % nig) % gsz); u.pn = (wgid % nig) / gsz; return true;
    }
};
struct ProbStd {
    const char* A; const char* B; int K; unsigned rsA, rsB; size_t hsA, hsB, tsA, tsB;
    __device__ __forceinline__ const char* a_base(const Unit& u) const { return A + (size_t)u.pm * tsA; }
    __device__ __forceinline__ const char* b_base(const Unit& u) const { return B + (size_t)u.pn * tsB; }
};
__device__ __forceinline__ ProbStd make_std(const void* A, int lda, const void* B, int ldb, int K) {
    ProbStd p; p.A = (const char*)A; p.B = (const char*)B; p.K = K; p.rsA = lda * 2; p.rsB = ldb * 2;
    p.hsA = (size_t)128 * lda * 2; p.hsB = (size_t)128 * ldb * 2; p.tsA = 2 * p.hsA; p.tsB = 2 * p.hsB; return p;
}

template <class Epi, class Prob, bool ALIGN_EPI>
__device__ __forceinline__ void gemm_phase(LAS unsigned char* lds, const Prob& P, const StaticOrder& S, const Epi& E) {
    int tid = threadIdx.x; asm volatile("" : "+v"(tid));
    const int wid = __builtin_amdgcn_readfirstlane(tid >> 6), lane = tid & 63, wr = wid >> 2, wc = wid & 3, fr = lane & 15, fq = lane >> 4;
    const int nt = P.K / BK;
    unsigned voffA[2], voffB[2];
#pragma unroll
    for (int i = 0; i < 2; ++i) { int R, C; stage_rc(tid * 16 + i * 8192, R, C); const int Rb = (R & ~31) + perm32(R & 31);
        voffA[i] = (unsigned)R * P.rsA + (unsigned)C * 2u; voffB[i] = (unsigned)Rb * P.rsB + (unsigned)C * 2u; }
    const size_t kstep = (size_t)(BK * 2);
    const size_t hstepA = P.hsA, hstepB = P.hsB;
    const unsigned ldsw = (unsigned)wid * 1024u;
    const unsigned lds0 = (unsigned)(size_t)lds;
    const int aoff = lds_byte(wr * 64 + fr, fq * 8), boff = lds_byte(wc * 32 + fr, fq * 8);
#define PG8_SA(b, h) (((b) * 2 + (h)) * HTB)
#define PG8_SB(b, h) ((4 + (b) * 2 + (h)) * HTB)
#define PG8_STAGE(bufoff, gbase, voff) do { _Pragma("unroll") for (int _i = 0; _i < 2; ++_i) \
        glds16s((gbase), (voff)[_i], lds0 + (unsigned)(bufoff) + ldsw + _i * 8192u); } while (0)
#define PG8_LDA(dst, b, h) do { _Pragma("unroll") for (int m = 0; m < 4; ++m) _Pragma("unroll") for (int k = 0; k < 2; ++k) dst[m][k] = *(const LAS bf16x8*)(lds + PG8_SA(b, h) + aoff + m * 2048 + k * 1024); } while (0)
#define PG8_LDB(dst, b, h) do { _Pragma("unroll") for (int n = 0; n < 2; ++n) _Pragma("unroll") for (int k = 0; k < 2; ++k) dst[n][k] = *(const LAS bf16x8*)(lds + PG8_SB(b, h) + boff + n * 2048 + k * 1024); } while (0)
#define PG8_MMA(ai, bj, At, Bt) do { __builtin_amdgcn_s_setprio(1); _Pragma("unroll") for (int m = 0; m < 4; ++m) _Pragma("unroll") for (int n = 0; n < 2; ++n) _Pragma("unroll") for (int k = 0; k < 2; ++k) \
        acc[ai][bj][m][n] = __builtin_amdgcn_mfma_f32_16x16x32_bf16(Bt[n][k], At[m][k], acc[ai][bj][m][n], 0, 0, 0); __builtin_amdgcn_s_setprio(0); } while (0)
#define PG8_WAIT_V(n) asm volatile("s_waitcnt vmcnt(" #n ")" ::: "memory")
#define PG8_WAIT_L(n) asm volatile("s_waitcnt lgkmcnt(" #n ")" ::: "memory")
#define PG8_BAR __builtin_amdgcn_s_barrier()
#define PG8_SCHED __builtin_amdgcn_sched_barrier(0)
    Unit cur, nxt; int ui = 0;
    if (!S.next(0, cur)) return;
    f32x4 acc[2][2][4][2];
#pragma unroll
    for (int a = 0; a < 2; ++a)
#pragma unroll
        for (int b = 0; b < 2; ++b)
#pragma unroll
            for (int m = 0; m < 4; ++m)
#pragma unroll
                for (int n = 0; n < 2; ++n) acc[a][b][m][n] = (f32x4){0.f, 0.f, 0.f, 0.f};
    bf16x8 At[4][2], B0[2][2], B1[2][2];
    const char* cA = P.a_base(cur); const char* cB = P.b_base(cur);
    PG8_STAGE(PG8_SB(0, 0), cB, voffB); PG8_STAGE(PG8_SB(0, 1), cB + hstepB, voffB); PG8_STAGE(PG8_SA(0, 0), cA, voffA); PG8_STAGE(PG8_SA(0, 1), cA + hstepA, voffA);
    if (wr == 1) PG8_BAR;
    PG8_WAIT_V(2); PG8_BAR;
    PG8_STAGE(PG8_SB(1, 0), cB + kstep, voffB); PG8_STAGE(PG8_SA(1, 0), cA + kstep, voffA); PG8_STAGE(PG8_SB(1, 1), cB + hstepB + kstep, voffB);
    PG8_WAIT_V(6); PG8_BAR;
    for (;;) {
        const bool has_next = S.next(ui + 1, nxt);
        const char* nA = has_next ? P.a_base(nxt) : cA; const char* nB = has_next ? P.b_base(nxt) : cB;
        for (int t = 0; t < nt; t += 2) {
            const bool last = (t == nt - 2);
            const char* a1 = cA + (size_t)(t + 1) * kstep;
            const char* a2 = last ? nA : cA + (size_t)(t + 2) * kstep; const char* b2 = last ? nB : cB + (size_t)(t + 2) * kstep;
            const char* a3 = a2 + kstep; const char* b3 = b2 + kstep;
            PG8_LDB(B0, 0, 0); PG8_LDB(B1, 0, 1); PG8_SCHED; PG8_LDA(At, 0, 0); PG8_STAGE(PG8_SA(1, 1), a1 + hstepA, voffA);
            PG8_WAIT_V(8); PG8_WAIT_L(0); PG8_BAR; PG8_MMA(0, 0, At, B0); PG8_MMA(0, 1, At, B1); PG8_BAR; PG8_SCHED;
            PG8_LDA(At, 0, 1); PG8_STAGE(PG8_SB(0, 0), b2, voffB); PG8_STAGE(PG8_SB(0, 1), b2 + hstepB, voffB); PG8_STAGE(PG8_SA(0, 0), a2, voffA);
            PG8_WAIT_V(8); PG8_WAIT_L(0); PG8_BAR; PG8_MMA(1, 0, At, B0); PG8_MMA(1, 1, At, B1); PG8_BAR; PG8_SCHED;
            PG8_LDB(B0, 1, 0); PG8_LDB(B1, 1, 1); PG8_SCHED; PG8_LDA(At, 1, 0); PG8_STAGE(PG8_SA(0, 1), a2 + hstepA, voffA);
            PG8_WAIT_V(8); PG8_WAIT_L(0); PG8_BAR; PG8_MMA(0, 0, At, B0); PG8_MMA(0, 1, At, B1); PG8_BAR; PG8_SCHED;
            PG8_LDA(At, 1, 1); PG8_STAGE(PG8_SB(1, 0), b3, voffB); PG8_STAGE(PG8_SB(1, 1), b3 + hstepB, voffB); PG8_STAGE(PG8_SA(1, 0), a3, voffA);
            PG8_WAIT_V(8); PG8_WAIT_L(0); PG8_BAR; PG8_MMA(1, 0, At, B0); PG8_MMA(1, 1, At, B1); PG8_BAR; PG8_SCHED;
        }
        if constexpr (ALIGN_EPI) { if (wr == 0) PG8_BAR; }
        { int fr_ = fr, fq_ = fq; asm volatile("" : "+v"(fr_), "+v"(fq_)); E(acc, cur, wr, wc, fr_, fq_); }
        if (!has_next) break;
#pragma unroll
        for (int a = 0; a < 2; ++a)
#pragma unroll
            for (int b = 0; b < 2; ++b)
#pragma unroll
                for (int m = 0; m < 4; ++m)
#pragma unroll
                    for (int n = 0; n < 2; ++n) acc[a][b][m][n] = (f32x4){0.f, 0.f, 0.f, 0.f};
        cur = nxt; cA = nA; cB = nB; ++ui;
        if constexpr (ALIGN_EPI) { if (wr == 1) PG8_BAR; }
    }
    PG8_WAIT_V(0);
    if constexpr (!ALIGN_EPI) { if (wr == 0) PG8_BAR; }
    PG8_BAR;
#undef PG8_SA
#undef PG8_SB
#undef PG8_STAGE
#undef PG8_LDA
#undef PG8_LDB
#undef PG8_MMA
#undef PG8_WAIT_V
#undef PG8_WAIT_L
#undef PG8_BAR
#undef PG8_SCHED
}

typedef f32x4 Acc[2][2][4][2];
struct EpiBf16 {
    bf16_t* O; int ldc; int ncols;
    __device__ __forceinline__ void operator()(const Acc& acc, const Unit& u, int wr, int wc, int fr, int fq) const {
        const int row0 = u.pm * BM + wr * 64 + fr, col0 = u.pn * BM + wc * 32 + 8 * fq;
#pragma unroll
        for (int ai = 0; ai < 2; ++ai)
#pragma unroll
            for (int m = 0; m < 4; ++m) { bf16_t* rowp = O + (size_t)(row0 + ai * HALF + m * 16) * ldc + col0;
#pragma unroll
                for (int bj = 0; bj < 2; ++bj) { const f32x4 v0 = acc[ai][bj][m][0], v1 = acc[ai][bj][m][1];
                    u32x4 w; w.x = cvt_pk_bf16(v0[0], v0[1]); w.y = cvt_pk_bf16(v0[2], v0[3]); w.z = cvt_pk_bf16(v1[0], v1[1]); w.w = cvt_pk_bf16(v1[2], v1[3]);
                    if (col0 + bj * HALF < ncols) *(u32x4*)(rowp + bj * HALF) = w; } }
    }
};
__device__ __forceinline__ void ld8(const float* p, f32x4& a, f32x4& b) { a = *(const f32x4*)p; b = *(const f32x4*)(p + 4); }
__device__ __forceinline__ void ld8(const bf16_t* p, f32x4& a, f32x4& b) { const u32x4 w = *(const u32x4*)p; a = (f32x4){bflo(w.x), bfhi(w.x), bflo(w.y), bfhi(w.y)}; b = (f32x4){bflo(w.z), bfhi(w.z), bflo(w.w), bfhi(w.w)}; }
__device__ __forceinline__ void st8(float* p, const f32x4& a, const f32x4& b) { *(f32x4*)p = a; *(f32x4*)(p + 4) = b; }
__device__ __forceinline__ void st8(bf16_t* p, const f32x4& a, const f32x4& b) { u32x4 w; w.x = cvt_pk_bf16(a[0], a[1]); w.y = cvt_pk_bf16(a[2], a[3]); w.z = cvt_pk_bf16(b[0], b[1]); w.w = cvt_pk_bf16(b[2], b[3]); *(u32x4*)p = w; }
template <class TR, class TO> struct EpiResid {
    const TR* res; TO* out; const float* gate0; int gstride;
    __device__ __forceinline__ void operator()(const Acc& acc, const Unit& u, int wr, int wc, int fr, int fq) const {
        const int row0 = u.pm * BM + wr * 64 + fr, col0 = u.pn * BM + wc * 32 + 8 * fq;
        const float* gp = gate0 + (size_t)(u.pm >> 5) * gstride + col0;
        f32x4 g[2][2];
#pragma unroll
        for (int bj = 0; bj < 2; ++bj)
#pragma unroll
            for (int n = 0; n < 2; ++n) g[bj][n] = *(const f32x4*)(gp + bj * HALF + 4 * n);
#pragma unroll
        for (int ai = 0; ai < 2; ++ai)
#pragma unroll
            for (int m = 0; m < 4; ++m) { const size_t off = (size_t)(row0 + ai * HALF + m * 16) * 1024 + col0;
#pragma unroll
                for (int bj = 0; bj < 2; ++bj) { f32x4 r0, r1; ld8(res + off + bj * HALF, r0, r1);
                    st8(out + off + bj * HALF, r0 + g[bj][0] * acc[ai][bj][m][0], r1 + g[bj][1] * acc[ai][bj][m][1]); } }
    }
};
struct EpiSwiglu {
    bf16_t* H;
    __device__ __forceinline__ void operator()(const Acc& acc, const Unit& u, int wr, int wc, int fr, int fq) const {
        const int row0 = u.pm * BM + wr * 64 + fr, col0 = u.pn * HALF + wc * 32 + 8 * fq;
#pragma unroll
        for (int ai = 0; ai < 2; ++ai)
#pragma unroll
            for (int m = 0; m < 4; ++m) { bf16_t* rowp = H + (size_t)(row0 + ai * HALF + m * 16) * DFF + col0;
                f32x4 h0, h1;
#pragma unroll
                for (int j = 0; j < 4; ++j) { h0[j] = silu_f(acc[ai][0][m][0][j]) * acc[ai][1][m][0][j]; h1[j] = silu_f(acc[ai][0][m][1][j]) * acc[ai][1][m][1][j]; }
                u32x4 w; w.x = cvt_pk_bf16(h0[0], h0[1]); w.y = cvt_pk_bf16(h0[2], h0[3]); w.z = cvt_pk_bf16(h1[0], h1[1]); w.w = cvt_pk_bf16(h1[2], h1[3]);
                *(u32x4*)rowp = w; }
    }
};
struct EpiG1 {
    bf16_t* Z1;
    __device__ __forceinline__ void operator()(const Acc& acc, const Unit& u, int wr, int wc, int fr, int fq) const {
        const unsigned b = u.pn >> 5, q = u.pn & 31, ns0 = wc * 32 + 8 * fq;
        const unsigned j0 = u.pm * BM + wr * 64 + fr;
        const unsigned cs = j0 >> 10;
        bf16_t* base = Z1 + ((size_t)(b * 1024u) * 64u * 256u + (size_t)(2u * q) * 256u + cs * 128u + ns0);
#pragma unroll
        for (int ai = 0; ai < 2; ++ai)
#pragma unroll
            for (int m = 0; m < 4; ++m) { const unsigned ch = (j0 + ai * HALF + m * 16) & 1023u; bf16_t* rp = base + (size_t)ch * (64u * 256u);
#pragma unroll
                for (int bj = 0; bj < 2; ++bj) { const f32x4 v0 = acc[ai][bj][m][0], v1 = acc[ai][bj][m][1];
                    u32x4 w; w.x = cvt_pk_bf16(v0[0], v0[1]); w.y = cvt_pk_bf16(v0[2], v0[3]); w.z = cvt_pk_bf16(v1[0], v1[1]); w.w = cvt_pk_bf16(v1[2], v1[3]);
                    *(u32x4*)(rp + bj * 256) = w; }
                asm volatile("" ::: "memory"); }
    }
};
struct EpiG2 {
    bf16_t* G2;
    __device__ __forceinline__ void operator()(const Acc& acc, const Unit& u, int wr, int wc, int fr, int fq) const {
        const unsigned rho00 = u.pn * BM + wc * 32 + 8 * fq;
#pragma unroll
        for (int m = 0; m < 4; ++m) { const unsigned ka = wr * 64 + m * 16 + fr; const float kaf = (float)ka * (1.0f / 8192.0f);
#pragma unroll
            for (int bj = 0; bj < 2; ++bj) { const unsigned rho0 = rho00 + bj * HALF, bc = rho0 >> 6, nf0 = rho0 & 63u;
                bf16_t* dp = G2 + ((size_t)(bc * 128u + ka) * 128u + nf0);
#pragma unroll
                for (int n = 0; n < 2; ++n) { const f32x4 gr = acc[0][bj][m][n], gi = acc[1][bj][m][n]; f32x4 o_r, o_i;
#pragma unroll
                    for (int j = 0; j < 4; ++j) { const float rev = (float)(nf0 + 4 * n + j) * kaf; const float c = cos_rev(rev), s = sin_rev(rev);
                        o_r[j] = gr[j] * c + gi[j] * s; o_i[j] = gi[j] * c - gr[j] * s; }
                    u32x2 wre, wim; wre.x = cvt_pk_bf16(o_r[0], o_r[1]); wre.y = cvt_pk_bf16(o_r[2], o_r[3]); wim.x = cvt_pk_bf16(o_i[0], o_i[1]); wim.y = cvt_pk_bf16(o_i[2], o_i[3]);
                    *(u32x2*)(dp + 4 * n) = wre; *(u32x2*)(dp + 64 + 4 * n) = wim;
                    asm volatile("" ::: "memory"); } } }
    }
};
struct EpiG3 {
    bf16_t* out; const float* gate0; int gstride;
    __device__ __forceinline__ void operator()(const Acc& acc, const Unit& u, int wr, int wc, int fr, int fq) const {
        const int chblk = u.pn & 3, kag = (u.pn >> 2) & 31, b = u.pn >> 7, ch0 = chblk * 256 + wc * 32 + 8 * fq;
        const float* gp = gate0 + (size_t)b * gstride + ch0;
        f32x4 g[2][2];
#pragma unroll
        for (int bj = 0; bj < 2; ++bj)
#pragma unroll
            for (int n = 0; n < 2; ++n) g[bj][n] = *(const f32x4*)(gp + bj * HALF + 4 * n);
#pragma unroll
        for (int ai = 0; ai < 2; ++ai)
#pragma unroll
            for (int m = 0; m < 4; ++m) { const int r = ai * HALF + wr * 64 + m * 16 + fr, s = r >> 6, kb = r & 63;
                const size_t off = ((size_t)b * 8192 + 4 * kag + s + 128 * kb) * 1024 + ch0;
#pragma unroll
                for (int bj = 0; bj < 2; ++bj) { f32x4 r0, r1; ld8(out + off + bj * HALF, r0, r1);
                    st8(out + off + bj * HALF, r0 + g[bj][0] * acc[ai][bj][m][0], r1 + g[bj][1] * acc[ai][bj][m][1]); } }
    }
};
struct ProbWc {
    const char* WfT; const char* D; int K; unsigned rsA, rsB; size_t hsA, hsB;
    __device__ __forceinline__ const char* a_base(const Unit& u) const { return WfT + ((size_t)(u.pm & 3) * 256 * 1024 + (size_t)u.pn * 256) * 2; }
    __device__ __forceinline__ const char* b_base(const Unit& u) const { return D + (size_t)(u.pm >> 2) * 256 * 256 * 2; }
};
struct ProbG1 {
    const char* WcT; const char* XN; int K; unsigned rsA, rsB; size_t hsA, hsB;
    __device__ __forceinline__ const char* a_base(const Unit& u) const { return WcT + (size_t)u.pm * 256 * 1024 * 2; }
    __device__ __forceinline__ const char* b_base(const Unit& u) const { return XN + ((size_t)(u.pn >> 5) * 8192 + 2 * (u.pn & 31)) * 2048; }
};
struct ProbG3 {
    const char* W2d; const char* G2; int K; unsigned rsA, rsB; size_t hsA, hsB;
    __device__ __forceinline__ const char* a_base(const Unit&) const { return W2d; }
    __device__ __forceinline__ const char* b_base(const Unit& u) const { const int chblk = u.pn & 3, kag = (u.pn >> 2) & 31, b = u.pn >> 7;
        return G2 + (((size_t)(b * 1024 + chblk * 256) * 128 + 4 * kag) * 128) * 2; }
};
}

#define RLX_AGENT __ATOMIC_RELAXED, __HIP_MEMORY_SCOPE_AGENT
#define XB_TMO      128
#define XB_XCNT(j)  (256  + 64 * (j))
#define XB_XSUB(j)  (1280 + 64 * (j))
#define XB_XGEN(j)  (2304 + 64 * (j))
#define XB_TOP      3328
#define XB_TOPGEN   3392
#define XCD_BAR_WORDS 3456
#define XB_SPIN_CAP (1u << 18)

__device__ __forceinline__ unsigned xb_ld(unsigned* p)              { return __hip_atomic_load(p, __ATOMIC_RELAXED, __HIP_MEMORY_SCOPE_AGENT); }
__device__ __forceinline__ unsigned xb_add(unsigned* p, unsigned v) { return __hip_atomic_fetch_add(p, v, __ATOMIC_RELAXED, __HIP_MEMORY_SCOPE_AGENT); }
__device__ __forceinline__ unsigned xb_xcc_id() { return (unsigned)__builtin_amdgcn_s_getreg((3 << 11) | 20) & 0xFu; }
#define XB_SPIN(cond, bar) do { unsigned _sp = 0; while (cond) { __builtin_amdgcn_s_sleep(1); \
    if ((++_sp & 255u) == 0u) { if (xb_ld(&(bar)[XB_TMO])) break; if (_sp > XB_SPIN_CAP) { atomicAdd(&(bar)[XB_TMO], 1u); break; } } } } while (0)

struct XcdBarrier {
    unsigned* bar; unsigned x;
    volatile LAS unsigned* st;
};

__device__ __forceinline__ XcdBarrier xcd_barrier_post(unsigned* bar, volatile LAS unsigned* st) {
    XcdBarrier b; b.bar = bar; b.x = xb_xcc_id(); b.st = st;
    if (threadIdx.x == 0) (void)xb_add(&bar[XB_XCNT(b.x)], 1u);
    return b;
}
__device__ __forceinline__ void xcd_barrier_complete(unsigned* bar, unsigned x, unsigned& nloc, unsigned& nx) {
    const unsigned G = gridDim.x * gridDim.y * gridDim.z;
    unsigned sum, cnt, mine, sp = 0u;
    for (;;) {
        sum = 0u; cnt = 0u; mine = 0u;
#pragma unroll
        for (unsigned j = 0; j < 16; ++j) { const unsigned c = xb_ld(&bar[XB_XCNT(j)]); sum += c; cnt += (c > 0u) ? 1u : 0u; mine = (j == x) ? c : mine; }
        if (sum == G) break;
        __builtin_amdgcn_s_sleep(1);
        if ((++sp & 255u) == 0u) { if (xb_ld(&bar[XB_TMO])) break; if (sp > XB_SPIN_CAP) { atomicAdd(&bar[XB_TMO], 1u); break; } }
    }
    nloc = mine > 0u ? mine : 1u; nx = cnt > 0u ? cnt : 1u;
}

__device__ __forceinline__ void xcd_barrier(const XcdBarrier& b) {
    asm volatile("s_waitcnt vmcnt(0)" ::: "memory");
    __syncthreads();
    if (threadIdx.x == 0) {
        unsigned* bar = b.bar;
        __builtin_amdgcn_s_waitcnt(0);
        unsigned nloc = b.st[0], nx = b.st[1];
        if (nloc == 0u) { xcd_barrier_complete(bar, b.x, nloc, nx); b.st[0] = nloc; b.st[1] = nx; }
        const unsigned old = xb_add(&bar[XB_XSUB(b.x)], 1u);
        const unsigned gen = old / nloc;
        if (old + 1u == (gen + 1u) * nloc) {
            __builtin_amdgcn_fence(__ATOMIC_RELEASE, "agent");
            asm volatile("s_waitcnt vmcnt(0)" ::: "memory");
            const unsigned og = xb_add(&bar[XB_TOP], 1u);
            const unsigned tg = og / nx;
            if (og + 1u == (tg + 1u) * nx) xb_add(&bar[XB_TOPGEN], 1u);
            else XB_SPIN(xb_ld(&bar[XB_TOPGEN]) == tg, bar);
            __builtin_amdgcn_fence(__ATOMIC_ACQUIRE, "agent");
            xb_add(&bar[XB_XGEN(b.x)], 1u);
            asm volatile("s_waitcnt vmcnt(0)" ::: "memory");
        } else {
            XB_SPIN(xb_ld(&bar[XB_XGEN(b.x)]) == gen, bar);
            __builtin_amdgcn_fence(__ATOMIC_ACQUIRE, "agent");
            asm volatile("s_waitcnt vmcnt(0)" ::: "memory");
        }
    }
    __syncthreads();
}
struct Args {
    const float* in[21]; float* out; unsigned char* ws;
};
constexpr int NWAVES = 8, NTHR = 512;
constexpr int LDS_BYTES = 147456;

__device__ __forceinline__ void ada_item(const Args& a, int item, LAS unsigned char* lds, int tid, int lane, int wave) {
    const int layer = item / 96, n0 = (item % 96) * 64;
    LAS float* sil = (LAS float*)lds; LAS float* red = sil + 3072;
    const float* c = a.in[1]; const float* cc = a.in[3];
    for (int i = tid; i < 3072; i += NTHR) { const int v = i >> 10, k = i & 1023; const float cv = (v < 2) ? c[v * 1024 + k] : cc[k]; sil[i] = cv / (1.0f + __expf(-cv)); }
    __syncthreads();
    const float* W = a.in[4] + (size_t)layer * 1024 * 6144 + n0 + lane;
    float a0 = 0.f, a1 = 0.f, a2 = 0.f; const int k0 = wave * 128;
#pragma unroll 8
    for (int kk = 0; kk < 128; ++kk) { const int k = k0 + kk; const float w = W[(size_t)k * 6144]; a0 += sil[k] * w; a1 += sil[1024 + k] * w; a2 += sil[2048 + k] * w; }
    red[(wave * 3 + 0) * 64 + lane] = a0; red[(wave * 3 + 1) * 64 + lane] = a1; red[(wave * 3 + 2) * 64 + lane] = a2;
    __syncthreads();
    if (tid < 192) { const int v = tid >> 6, l = tid & 63; float s = a.in[5][layer * 6144 + n0 + l];
#pragma unroll
        for (int w = 0; w < 8; ++w) s += red[(w * 3 + v) * 64 + l];
        ((float*)(a.ws + WS_MOD))[(layer * 3 + v) * 6144 + n0 + l] = s; }
    __syncthreads();
}
__device__ __forceinline__ void transpose_item(const float* W, int N, bf16_t* WT, int ldk, int k0, int n0, int drow0, LAS float* scr, int lane, const float* kscale = nullptr) {
#pragma unroll 8
    for (int i = 0; i < 32; ++i) { const int kk = 2 * i + (lane >> 5); float w = W[(size_t)(k0 + kk) * N + n0 + (lane & 31)]; if (kscale) w *= kscale[k0 + kk]; scr[kk * 33 + (lane & 31)] = w; }
    LDS_WAIT(); asm volatile("" ::: "memory");
    const int c = lane & 7;
#pragma unroll
    for (int j = 0; j < 4; ++j) { const int n = (lane >> 3) + 8 * j; const LAS float* s = scr + (8 * c) * 33 + n;
        u32x4 o; o.x = pk2(s[0 * 33], s[1 * 33]); o.y = pk2(s[2 * 33], s[3 * 33]); o.z = pk2(s[4 * 33], s[5 * 33]); o.w = pk2(s[6 * 33], s[7 * 33]);
        *(u32x4*)(WT + (size_t)(drow0 + n) * ldk + k0 + 8 * c) = o; }
    LDS_WAIT(); asm volatile("" ::: "memory");
}
__device__ __forceinline__ void p0_prologue(const Args& a, LAS unsigned char* lds, int tid, int lane, int wave) {
    asm volatile("" : "+v"(lane), "+v"(tid));
    unsigned char* ws = a.ws;
    if (blockIdx.x < 192) ada_item(a, blockIdx.x, lds, tid, lane, wave);
    LAS float* scr = (LAS float*)(lds + wave * 16384);
    const int gw = blockIdx.x * NWAVES + wave, NGW = gridDim.x * NWAVES;
    constexpr int I_IN = 16 * 69, I_UQ = 6 * 24, I_UKV = 4 * 32, I_O = 512, I_F = 512, I_13 = 16 * 88, I_2 = 44 * 32;
    constexpr int NITEMS = I_IN + I_UQ + I_UKV + I_O + I_F + 2 * (2 * I_13 + I_2);
    for (int it = gw; it < NITEMS; it += NGW) {
        int r = it;
        if (r < I_IN) { const int kb = r / 69, nb = r % 69; transpose_item(a.in[8], NIN, (bf16_t*)(ws + WS_WIN), 1024, 64 * kb, 32 * nb, 32 * nb, scr, lane); continue; } r -= I_IN;
        if (r < I_UQ) { const int kb = r / 24, nb = r % 24; transpose_item(a.in[11], 768, (bf16_t*)(ws + WS_WUQ), 384, 64 * kb, 32 * nb, 32 * nb, scr, lane, a.in[9]); continue; } r -= I_UQ;
        if (r < I_UKV) { const int kb = r / 32, nb = r % 32; transpose_item(a.in[12], 1024, (bf16_t*)(ws + WS_WUKV), 256, 64 * kb, 32 * nb, 32 * nb, scr, lane, a.in[10]); continue; } r -= I_UKV;
        if (r < I_O) { const int kb = r / 32, nb = r % 32; transpose_item(a.in[16], 1024, (bf16_t*)(ws + WS_WO), 1024, 64 * kb, 32 * nb, 32 * nb, scr, lane); continue; } r -= I_O;
        if (r < I_F) { const int kb = r / 32, nb = r % 32; transpose_item(a.in[17], 1024, (bf16_t*)(ws + WS_WF), 1024, 64 * kb, 32 * nb, 32 * nb, scr, lane); continue; } r -= I_F;
        const int layer = r / (2 * I_13 + I_2); r -= layer * (2 * I_13 + I_2);
        if (r < 2 * I_13) { const int s = r / I_13; r -= s * I_13; const int kb = r / 88, nb = r % 88, n0 = 32 * nb;
            transpose_item(a.in[s ? 19 : 18] + (size_t)layer * 1024 * DFF, DFF, (bf16_t*)(ws + WS_W13 + layer * W13_BYTES), 1024, 64 * kb, n0, 256 * (n0 >> 7) + 128 * s + (n0 & 127), scr, lane); continue; }
        r -= 2 * I_13;
        { const int kb = r / 32, nb = r % 32; transpose_item(a.in[20] + (size_t)layer * DFF * 1024, 1024, (bf16_t*)(ws + WS_W2 + layer * W2_BYTES), DFF, 64 * kb, 32 * nb, 32 * nb, scr, lane); }
    }
    const int gt = blockIdx.x * NTHR + tid, NGT = gridDim.x * NTHR;
    { unsigned* z = (unsigned*)(ws + WS_WIN + (size_t)NIN * 1024 * 2); for (int i = gt; i < 96 * 1024 / 2; i += NGT) z[i] = 0u; }
    { bf16_t* d = (bf16_t*)(ws + WS_D256);
      for (int i = gt; i < 131072; i += NGT) { const int cs = i >> 16, c = (i >> 8) & 255, cp = i & 255; const float rev = (float)((c * cp) & 255) * (1.0f / 256.0f);
          const float v = cs ? -sin_rev(rev) : cos_rev(rev); d[i] = (bf16_t)f2bf(v * 0.0625f); } }
    { bf16_t* d = (bf16_t*)(ws + WS_W1D);
      for (int i = gt; i < 65536; i += NGT) { const int row = i >> 8, col = i & 255, ro = row >> 7, ka = row & 127, ri = col >> 7, n = col & 127; const float rev = (float)((n * ka) & 127) * (1.0f / 128.0f);
          const float c = cos_rev(rev), s = sin_rev(rev); const float v = (ro == 0) ? (ri == 0 ? c : s) : (ri == 0 ? -s : c); d[i] = (bf16_t)f2bf(v * 0.08838834764831845f); } }
    { bf16_t* d = (bf16_t*)(ws + WS_W2D);
      for (int i = gt; i < 256 * 512; i += NGT) { const int row = i >> 9, col = i & 511, s = row >> 6, kb = row & 63, sp = col >> 7, ri = (col >> 6) & 1, n2 = col & 63; float v = 0.f;
          if (s == sp) { const float rev = (float)((n2 * kb) & 63) * (1.0f / 64.0f); v = (ri == 0 ? cos_rev(rev) : sin_rev(rev)) * 0.125f; }
          d[i] = (bf16_t)f2bf(v); } }
}

__device__ __forceinline__ void norm_row(const float* xrow, bf16_t* orow, const float* g, const float* sc, const float* sh, int lane) {
    const f32x4* xr = (const f32x4*)xrow + lane;
    f32x4 v[4]; float s = 0.f;
#pragma unroll
    for (int j = 0; j < 4; ++j) { v[j] = xr[64 * j]; s += (v[j].x * v[j].x + v[j].y * v[j].y) + (v[j].z * v[j].z + v[j].w * v[j].w); }
    const float rstd = rsqrtf(wave_sum(s) * (1.0f / 1024.0f) + EPS);
    u32x2* o8 = (u32x2*)orow + lane;
#pragma unroll
    for (int j = 0; j < 4; ++j) { const f32x4 gg = ((const f32x4*)g)[64 * j + lane], cc = ((const f32x4*)sc)[64 * j + lane], hh = ((const f32x4*)sh)[64 * j + lane];
        const f32x4 y = v[j] * rstd * gg * (cc + 1.0f) + hh; u32x2 w; w.x = pk2(y.x, y.y); w.y = pk2(y.z, y.w); o8[64 * j] = w; }
}
__device__ __forceinline__ void norm_pass(const float* src, int nrows, bf16_t* dst, const float* g, const float* mod, int sh_chunk, int vfixed, int lane, int wave) {
    asm volatile("" : "+v"(lane));
    const int gw = blockIdx.x * NWAVES + wave, NGW = gridDim.x * NWAVES;
    for (int r = gw; r < nrows; r += NGW) { const int v = vfixed >= 0 ? vfixed : (r >> 13); const float* mv = mod + v * 6144 + sh_chunk * 1024;
        norm_row(src + (size_t)r * 1024, dst + (size_t)r * 1024, g, mv + 1024, mv, lane); }
}

__device__ __forceinline__ void norm_pass_b(const bf16_t* src, int nrows, bf16_t* dst, const float* g, const float* mod, int sh_chunk, int lane, int wave) {
    asm volatile("" : "+v"(lane));
    const int gw = blockIdx.x * NWAVES + wave, NGW = gridDim.x * NWAVES;
#pragma unroll 1
    for (int b = 0; b < 2; ++b) {
        const float* mv = mod + b * 6144 + sh_chunk * 1024;
        f32x4 cg[4], cs[4];
#pragma unroll
        for (int j = 0; j < 4; ++j) { const int c = (j >> 1) * 512 + lane * 8 + (j & 1) * 4; const f32x4 gg = *(const f32x4*)(g + c), sc = *(const f32x4*)(mv + 1024 + c); cg[j] = gg * (sc + 1.0f); cs[j] = *(const f32x4*)(mv + c); }
        for (int r = b * 8192 + gw; r < (b + 1) * 8192 && r < nrows; r += NGW) {
            const bf16_t* xrow = src + (size_t)r * 1024; bf16_t* orow = dst + (size_t)r * 1024;
            f32x4 v[4]; pg8::ld8(xrow + lane * 8, v[0], v[1]); pg8::ld8(xrow + 512 + lane * 8, v[2], v[3]); float s = 0.f;
#pragma unroll
            for (int j = 0; j < 4; ++j) s += (v[j].x * v[j].x + v[j].y * v[j].y) + (v[j].z * v[j].z + v[j].w * v[j].w);
            const float rstd = rsqrtf(wave_sum(s) * (1.0f / 1024.0f) + EPS);
            pg8::st8(orow + lane * 8, v[0] * rstd * cg[0] + cs[0], v[1] * rstd * cg[1] + cs[1]);
            pg8::st8(orow + 512 + lane * 8, v[2] * rstd * cg[2] + cs[2], v[3] * rstd * cg[3] + cs[3]);
        }
    }
}

__device__ __forceinline__ float sumsq8(u32x4 c) { float s = 0.f;
#pragma unroll
    for (int i = 0; i < 4; ++i) { const float a = bflo(c[i]), b = bfhi(c[i]); s += a * a + b * b; } return s; }
__device__ __forceinline__ u32x4 scale8(u32x4 c, float r, const float* g) { const f32x4 g0 = *(const f32x4*)g, g1 = *(const f32x4*)(g + 4); u32x4 o;
    o.x = pk2(bflo(c.x) * r * g0.x, bfhi(c.x) * r * g0.y); o.y = pk2(bflo(c.y) * r * g0.z, bfhi(c.y) * r * g0.w);
    o.z = pk2(bflo(c.z) * r * g1.x, bfhi(c.z) * r * g1.y); o.w = pk2(bflo(c.w) * r * g1.z, bfhi(c.w) * r * g1.w); return o; }
__device__ __forceinline__ void conv_pass(const Args& a, int lane, int wave) {
    asm volatile("" : "+v"(lane));
    unsigned char* ws = a.ws;
    const bf16_t* P = (const bf16_t*)(ws + WS_B); bf16_t* MIX = (bf16_t*)(ws + WS_A);
    const float* cw = a.in[15];
    f32x4 w0[2], w1[2], w2[2];
#pragma unroll
    for (int i = 0; i < 2; ++i) { w0[i] = *(const f32x4*)(cw + 8 * lane + 4 * i); w1[i] = *(const f32x4*)(cw + 512 + 8 * lane + 4 * i); w2[i] = *(const f32x4*)(cw + 1024 + 8 * lane + 4 * i); }
    const int gw = blockIdx.x * NWAVES + wave, NGW = gridDim.x * NWAVES;
    for (int r = gw; r < ML; r += NGW) {
        const int t = r & (SEQ - 1);
        const bf16_t* cb = P + (size_t)r * PLD + 672 + 8 * lane;
        const u32x4 bg = *(const u32x4*)cb, cg0 = *(const u32x4*)(cb + 512), u0 = *(const u32x4*)(cb + 1024);
        u32x4 cgm = (u32x4){0u, 0u, 0u, 0u}, um = cgm, cgp = cgm, up = cgm;
        if (t > 0) { cgm = *(const u32x4*)(cb - PLD + 512); um = *(const u32x4*)(cb - PLD + 1024); }
        if (t < SEQ - 1) { cgp = *(const u32x4*)(cb + PLD + 512); up = *(const u32x4*)(cb + PLD + 1024); }
        u32x4 o;
#pragma unroll
        for (int i = 0; i < 4; ++i) {
            const float zl_m = bflo(cgm[i]) * bflo(um[i]), zh_m = bfhi(cgm[i]) * bfhi(um[i]);
            const float zl_0 = bflo(cg0[i]) * bflo(u0[i]), zh_0 = bfhi(cg0[i]) * bfhi(u0[i]);
            const float zl_p = bflo(cgp[i]) * bflo(up[i]), zh_p = bfhi(cgp[i]) * bfhi(up[i]);
            const int e = 2 * i;
            const float yl = zl_m * w0[e >> 2][e & 3] + zl_0 * w1[e >> 2][e & 3] + zl_p * w2[e >> 2][e & 3];
            const float yh = zh_m * w0[(e + 1) >> 2][(e + 1) & 3] + zh_0 * w1[(e + 1) >> 2][(e + 1) & 3] + zh_p * w2[(e + 1) >> 2][(e + 1) & 3];
            o[i] = pk2(bflo(bg[i]) * yl, bfhi(bg[i]) * yh);
        }
        *(u32x4*)(MIX + (size_t)r * 1024 + 512 + 8 * lane) = o;
    }
}

__device__ __forceinline__ void prep2_pass(const Args& a, LAS unsigned char* lds, int tid, int lane, int wave) {
    asm volatile("" : "+v"(lane), "+v"(tid));
    unsigned char* ws = a.ws;
    bf16_t* Q = (bf16_t*)(ws + WS_Q); const bf16_t* KV = (const bf16_t*)(ws + WS_KV); const bf16_t* P = (const bf16_t*)(ws + WS_B);
    LAS float* rkl = (LAS float*)(lds + 65536);
    bf16_t* Kf = (bf16_t*)(ws + WS_KF); bf16_t* Vt = (bf16_t*)(ws + WS_VT);
    const float* qgain = a.in[13]; const float* kgain = a.in[14];
    const int head = lane >> 3, sub = lane & 7;
    const float inv = __builtin_amdgcn_exp2f(-(float)sub * 1.6609640474436813f) * 0.15915494309189535f;
    float qgn[8], kgn[8], qgp[4], kgp[4];
#pragma unroll
    for (int e = 0; e < 8; ++e) { qgn[e] = qgain[8 * sub + e] * QSC; kgn[e] = kgain[8 * sub + e]; }
#pragma unroll
    for (int i = 0; i < 4; ++i) { qgp[i] = qgain[64 + sub + 8 * i] * QSC; kgp[i] = kgain[64 + sub + 8 * i]; }
    for (int blk = blockIdx.x; blk < MT / 64; blk += gridDim.x) {
        const int r0 = blk * 64; const bool latent = blk < 256;
        const int b = latent ? (blk >> 7) : ((blk - 256) >> 2);
        const int key0 = latent ? ((blk & 127) * 64) : (SEQ + ((blk - 256) & 3) * 64);
#pragma unroll
        for (int i = 0; i < 8; ++i) { const int id = tid + 512 * i, row = id >> 6, cc = id & 63, h = cc >> 3, part = cc & 7;
            const u32x4 v = *(const u32x4*)(KV + (size_t)(r0 + row) * 1024 + h * 128 + 64 + part * 8);
            *(LAS u32x4*)(lds + row * 1024 + cc * 16) = v; }
        for (int i = 0; i < 8; ++i) {
            const int r = r0 + 8 * wave + i, kl = 8 * wave + i;
            float cr = 1.f, sr = 0.f, ccol = 1.f, scol = 0.f;
            if (latent) { const int t = r & (SEQ - 1); const float ar = (float)(t >> 6) * inv, ac = (float)(t & 63) * inv;
                cr = cos_rev(ar - floorf(ar)); sr = sin_rev(ar - floorf(ar)); ccol = cos_rev(ac - floorf(ac)); scol = sin_rev(ac - floorf(ac)); }
            const bf16_t* prow = P + (size_t)r * PLD; const bf16_t* kpe = prow + 640;
            float rq, rkv;
            { const u32x4 c1 = *(const u32x4*)(prow + lane * 8); u32x4 c2 = (u32x4){0u, 0u, 0u, 0u}; if (lane < 16) c2 = *(const u32x4*)(prow + 512 + lane * 8);
              const float ss1 = sumsq8(c1), ss2 = sumsq8(c2);
              const float sq = wave_sum(lane < 48 ? ss1 : 0.f), skv = wave_sum((lane >= 48 ? ss1 : 0.f) + ss2);
              rq = rsqrtf(sq * (1.0f / 384.0f) + EPS); rkv = rsqrtf(skv * (1.0f / 256.0f) + EPS); if (lane == 0) rkl[kl] = rkv; }
            if (latent) {
                bf16_t* qp = Q + (size_t)r * 768 + head * 96;
                const u32x4 nv = *(const u32x4*)(qp + 8 * sub);
                float pe[4];
#pragma unroll
                for (int j = 0; j < 4; ++j) pe[j] = bf1(qp[64 + sub + 8 * j]) * rq;
                float ss = sumsq8(nv) * (rq * rq) + (pe[0] * pe[0] + pe[1] * pe[1]) + (pe[2] * pe[2] + pe[3] * pe[3]);
                ss += __shfl_xor(ss, 1); ss += __shfl_xor(ss, 2); ss += __shfl_xor(ss, 4);
                const float rs0 = rsqrtf(ss * (1.0f / 96.0f) + EPS), rs = rs0 * rq;
                u32x4 o; o.x = pk2(bflo(nv.x) * rs * qgn[0], bfhi(nv.x) * rs * qgn[1]); o.y = pk2(bflo(nv.y) * rs * qgn[2], bfhi(nv.y) * rs * qgn[3]);
                o.z = pk2(bflo(nv.z) * rs * qgn[4], bfhi(nv.z) * rs * qgn[5]); o.w = pk2(bflo(nv.w) * rs * qgn[6], bfhi(nv.w) * rs * qgn[7]);
                *(u32x4*)(qp + 8 * sub) = o;
                const float p0 = pe[0] * rs0 * qgp[0], p1 = pe[1] * rs0 * qgp[1], p2 = pe[2] * rs0 * qgp[2], p3 = pe[3] * rs0 * qgp[3];
                qp[64 + sub] = (bf16_t)f2bf(p0 * cr - p1 * sr); qp[72 + sub] = (bf16_t)f2bf(p1 * cr + p0 * sr);
                qp[80 + sub] = (bf16_t)f2bf(p2 * ccol - p3 * scol); qp[88 + sub] = (bf16_t)f2bf(p3 * ccol + p2 * scol);
            }
            {
                const u32x4 nv = *(const u32x4*)(KV + (size_t)r * 1024 + head * 128 + 8 * sub);
                float pe[4];
#pragma unroll
                for (int j = 0; j < 4; ++j) pe[j] = bf1(kpe[sub + 8 * j]);
                float ss = sumsq8(nv) * (rkv * rkv) + (pe[0] * pe[0] + pe[1] * pe[1]) + (pe[2] * pe[2] + pe[3] * pe[3]);
                ss += __shfl_xor(ss, 1); ss += __shfl_xor(ss, 2); ss += __shfl_xor(ss, 4);
                const float rs0 = rsqrtf(ss * (1.0f / 96.0f) + EPS), rs = rs0 * rkv;
                bf16_t* kp = Kf + ((size_t)(b * NH + head) * NKEY + key0 + kl) * DQK;
                u32x4 o; o.x = pk2(bflo(nv.x) * rs * kgn[0], bfhi(nv.x) * rs * kgn[1]); o.y = pk2(bflo(nv.y) * rs * kgn[2], bfhi(nv.y) * rs * kgn[3]);
                o.z = pk2(bflo(nv.z) * rs * kgn[4], bfhi(nv.z) * rs * kgn[5]); o.w = pk2(bflo(nv.w) * rs * kgn[6], bfhi(nv.w) * rs * kgn[7]);
                *(u32x4*)(kp + 8 * sub) = o;
                const float p0 = pe[0] * rs0 * kgp[0], p1 = pe[1] * rs0 * kgp[1], p2 = pe[2] * rs0 * kgp[2], p3 = pe[3] * rs0 * kgp[3];
                kp[64 + sub] = (bf16_t)f2bf(p0 * cr - p1 * sr); kp[72 + sub] = (bf16_t)f2bf(p1 * cr + p0 * sr);
                kp[80 + sub] = (bf16_t)f2bf(p2 * ccol - p3 * scol); kp[88 + sub] = (bf16_t)f2bf(p3 * ccol + p2 * scol);
            }
        }
        __syncthreads();
        { const int h = tid >> 6, d = tid & 63; bf16_t* vp = Vt + ((size_t)(b * NH + h) * 64 + d) * NKEY + key0;
#pragma unroll
          for (int i = 0; i < 8; ++i) { float e[8];
#pragma unroll
              for (int k = 0; k < 8; ++k) e[k] = bf1(*(const LAS unsigned short*)(lds + (8 * i + k) * 1024 + tid * 2)) * rkl[8 * i + k];
              u32x4 o; o.x = pk2(e[0], e[1]); o.y = pk2(e[2], e[3]); o.z = pk2(e[4], e[5]); o.w = pk2(e[6], e[7]);
              *(u32x4*)(vp + 8 * i) = o; } }
        __syncthreads();
    }
}

__device__ __forceinline__ float attn_rowmax(const f32x16& p0, const f32x16& p1) {
    float a = __builtin_fmaxf(__builtin_fmaxf(p0[0], p0[1]), p1[0]), b = __builtin_fmaxf(__builtin_fmaxf(p0[2], p0[3]), p1[1]);
    a = __builtin_fmaxf(__builtin_fmaxf(a, p1[2]), p1[3]);
#pragma unroll
    for (int r = 4; r < 16; r += 4) { a = __builtin_fmaxf(__builtin_fmaxf(a, p0[r]), p0[r + 1]); b = __builtin_fmaxf(__builtin_fmaxf(b, p0[r + 2]), p0[r + 3]);
        a = __builtin_fmaxf(__builtin_fmaxf(a, p1[r]), p1[r + 1]); b = __builtin_fmaxf(__builtin_fmaxf(b, p1[r + 2]), p1[r + 3]); }
    const float mx = __builtin_fmaxf(a, b);
    auto rr = __builtin_amdgcn_permlane32_swap(__float_as_uint(mx), __float_as_uint(mx), false, false);
    return __builtin_fmaxf(__uint_as_float(rr[0]), __uint_as_float(rr[1]));
}
__device__ __forceinline__ void attn_phase(const Args& a, LAS unsigned char* lds, int tid, int lane, int wid) {
    asm volatile("" : "+v"(lane), "+v"(tid));
    unsigned char* ws = a.ws;
    const bf16_t* Q = (const bf16_t*)(ws + WS_Q); const char* Kf = (const char*)(ws + WS_KF); const char* Vt = (const char*)(ws + WS_VT); bf16_t* MIX = (bf16_t*)(ws + WS_A);
    constexpr int NS = 4, KSLOT = 13312, VBASE = NS * KSLOT, VSLOT = 8192, NT = NKEY / 64;
    constexpr float THR = 8.0f;
    const int q = lane & 31, hi = lane >> 5;
    const int xcd = blockIdx.x & 7, l = blockIdx.x >> 3;
    const unsigned lds0 = (unsigned)(size_t)lds;
    unsigned koff[2];
#pragma unroll
    for (int i = 0; i < 2; ++i) { const int p = 64 * (wid + 8 * i) + lane, row = p / 13, c = p % 13, r31 = row & 31;
        const int key = (row & 32) + ((r31 & 19) | ((r31 & 4) << 1) | ((r31 & 8) >> 1)); koff[i] = (unsigned)(key * 192 + (c < 12 ? c : 11) * 16); }
    const bool k2 = wid < 5;
    unsigned voffv; { const int d = 8 * wid + (lane >> 3), cp = lane & 7, c = cp ^ ((d >> 1) & 7); voffv = (unsigned)(d * (NKEY * 2) + c * 16); }
    const unsigned kdst0 = lds0 + (unsigned)wid * 1024u, kdst1 = lds0 + (unsigned)(wid + 8) * 1024u, vdst = lds0 + VBASE + (unsigned)wid * 1024u;
    const int kro = q * 208 + hi * 16;
    int vro[4];
#pragma unroll
    for (int s = 0; s < 4; ++s) vro[s] = VBASE + q * 128 + (((2 * s + hi) ^ ((q >> 1) & 7)) * 16);
#define DMA_K(tile, slot) do { const char* kb_ = Kh + (size_t)(tile) * (64 * 192); pg8::glds16s(kb_, koff[0], kdst0 + (slot) * KSLOT); if (k2) pg8::glds16s(kb_, koff[1], kdst1 + (slot) * KSLOT); } while (0)
#define DMA_V(tile, slot) pg8::glds16s(Vh + (size_t)(tile) * 128, voffv, vdst + (slot) * VSLOT)
#define SBAR() __builtin_amdgcn_sched_barrier(0)
#define EXP2(P, R) do { P[R] = __builtin_amdgcn_exp2f(P[R]); P[R + 1] = __builtin_amdgcn_exp2f(P[R + 1]); rs2 += (f32x2){P[R], P[R + 1]}; } while (0)
#define PKP(P, B) __builtin_bit_cast(bf16x8, (u32x4){cvt_pk_bf16(P[B], P[B + 1]), cvt_pk_bf16(P[B + 2], P[B + 3]), cvt_pk_bf16(P[B + 4], P[B + 5]), cvt_pk_bf16(P[B + 6], P[B + 7])})
    for (int it = 0; it < 2; ++it) {
        const int bh = 2 * xcd + it, b = bh >> 3, h = bh & 7, qb = l;
        const size_t qrow = (size_t)b * SEQ + qb * 256 + wid * 32 + q;
        const char* Kh = Kf + (size_t)bh * NKEY * 192; const char* Vh = Vt + (size_t)bh * 64 * NKEY * 2;
        DMA_K(0, 0); DMA_K(1, 1); DMA_V(0, 0); DMA_K(2, 2); DMA_V(1, 1); DMA_K(3, 3); DMA_V(2, 2);
        bf16x8 qf[6];
#pragma unroll
        for (int d0 = 0; d0 < 6; ++d0) qf[d0] = *(const bf16x8*)(Q + qrow * 768 + h * 96 + d0 * 16 + hi * 8);
        asm volatile("s_waitcnt vmcnt(0) lgkmcnt(0)\n\ts_barrier" ::: "memory");
        f32x16 pc0 = {}, pc1 = {};
#pragma unroll
        for (int d0 = 0; d0 < 6; ++d0) {
            const bf16x8 a0 = *(const LAS bf16x8*)(lds + kro + d0 * 32), a1 = *(const LAS bf16x8*)(lds + kro + 32 * 208 + d0 * 32);
            pc0 = __builtin_amdgcn_mfma_f32_32x32x16_bf16(a0, qf[d0], pc0, 0, 0, 0); pc1 = __builtin_amdgcn_mfma_f32_32x32x16_bf16(a1, qf[d0], pc1, 0, 0, 0);
        }
        float m = attn_rowmax(pc0, pc1), lsum = 0.f;
#pragma unroll
        for (int r = 0; r < 16; ++r) { pc0[r] -= m; pc1[r] -= m; }
        f32x16 o0 = {}, o1 = {};
        f32x2 rs2 = (f32x2){0.f, 0.f};
        f32x16 negm;
#pragma unroll
        for (int r = 0; r < 16; ++r) negm[r] = -m;
        asm volatile("" : "+v"(negm));
        asm volatile("s_waitcnt lgkmcnt(0)\n\ts_barrier" ::: "memory");
#define ATT_ITER(PC0, PC1, PN0, PN1, T) do { \
            { const int tk_ = ((T) + 4 < NT) ? (T) + 4 : NT - 1, tv_ = ((T) + 3 < NT) ? (T) + 3 : NT - 1; DMA_K(tk_, (T) & 3); DMA_V(tv_, ((T) + 3) & 3); } \
            const LAS unsigned char* kn = lds + (((T) + 1) & 3) * KSLOT + kro; \
            bf16x8 kfa[6], kfb[6]; \
            _Pragma("unroll") for (int d0 = 0; d0 < 3; ++d0) { kfa[2 * d0] = *(const LAS bf16x8*)(kn + d0 * 32); kfa[2 * d0 + 1] = *(const LAS bf16x8*)(kn + 32 * 208 + d0 * 32); } \
            SBAR(); \
            PN0 = __builtin_amdgcn_mfma_f32_32x32x16_bf16(kfa[0], qf[0], negm, 0, 0, 0); EXP2(PC0, 0); SBAR(); \
            _Pragma("unroll") for (int d0 = 3; d0 < 6; ++d0) { kfb[2 * (d0 - 3)] = *(const LAS bf16x8*)(kn + d0 * 32); kfb[2 * (d0 - 3) + 1] = *(const LAS bf16x8*)(kn + 32 * 208 + d0 * 32); } \
            SBAR(); \
            PN1 = __builtin_amdgcn_mfma_f32_32x32x16_bf16(kfa[1], qf[0], negm, 0, 0, 0); EXP2(PC0, 2); SBAR(); \
            PN0 = __builtin_amdgcn_mfma_f32_32x32x16_bf16(kfa[2], qf[1], PN0, 0, 0, 0); EXP2(PC0, 4); EXP2(PC0, 6); SBAR(); \
            PN1 = __builtin_amdgcn_mfma_f32_32x32x16_bf16(kfa[3], qf[1], PN1, 0, 0, 0); EXP2(PC0, 8); SBAR(); \
            PN0 = __builtin_amdgcn_mfma_f32_32x32x16_bf16(kfa[4], qf[2], PN0, 0, 0, 0); EXP2(PC0, 10); EXP2(PC0, 12); SBAR(); \
            PN1 = __builtin_amdgcn_mfma_f32_32x32x16_bf16(kfa[5], qf[2], PN1, 0, 0, 0); EXP2(PC0, 14); SBAR(); \
            const LAS unsigned char* vb = lds + ((T) & 3) * VSLOT; \
            bf16x8 va[8]; \
            _Pragma("unroll") for (int s = 0; s < 4; ++s) { va[2 * s] = *(const LAS bf16x8*)(vb + vro[s]); va[2 * s + 1] = *(const LAS bf16x8*)(vb + vro[s] + 32 * 128); } \
            SBAR(); \
            PN0 = __builtin_amdgcn_mfma_f32_32x32x16_bf16(kfb[0], qf[3], PN0, 0, 0, 0); EXP2(PC1, 0); EXP2(PC1, 2); SBAR(); \
            PN1 = __builtin_amdgcn_mfma_f32_32x32x16_bf16(kfb[1], qf[3], PN1, 0, 0, 0); EXP2(PC1, 4); SBAR(); \
            PN0 = __builtin_amdgcn_mfma_f32_32x32x16_bf16(kfb[2], qf[4], PN0, 0, 0, 0); EXP2(PC1, 6); EXP2(PC1, 8); SBAR(); \
            PN1 = __builtin_amdgcn_mfma_f32_32x32x16_bf16(kfb[3], qf[4], PN1, 0, 0, 0); EXP2(PC1, 10); SBAR(); \
            PN0 = __builtin_amdgcn_mfma_f32_32x32x16_bf16(kfb[4], qf[5], PN0, 0, 0, 0); EXP2(PC1, 12); SBAR(); \
            PN1 = __builtin_amdgcn_mfma_f32_32x32x16_bf16(kfb[5], qf[5], PN1, 0, 0, 0); EXP2(PC1, 14); SBAR(); \
            { const bf16x8 pb0 = PKP(PC0, 0); \
              o0 = __builtin_amdgcn_mfma_f32_32x32x16_bf16(va[0], pb0, o0, 0, 0, 0); o1 = __builtin_amdgcn_mfma_f32_32x32x16_bf16(va[1], pb0, o1, 0, 0, 0); \
              const bf16x8 pb1 = PKP(PC0, 8); \
              o0 = __builtin_amdgcn_mfma_f32_32x32x16_bf16(va[2], pb1, o0, 0, 0, 0); o1 = __builtin_amdgcn_mfma_f32_32x32x16_bf16(va[3], pb1, o1, 0, 0, 0); \
              const bf16x8 pb2 = PKP(PC1, 0); \
              o0 = __builtin_amdgcn_mfma_f32_32x32x16_bf16(va[4], pb2, o0, 0, 0, 0); o1 = __builtin_amdgcn_mfma_f32_32x32x16_bf16(va[5], pb2, o1, 0, 0, 0); \
              const bf16x8 pb3 = PKP(PC1, 8); \
              o0 = __builtin_amdgcn_mfma_f32_32x32x16_bf16(va[6], pb3, o0, 0, 0, 0); o1 = __builtin_amdgcn_mfma_f32_32x32x16_bf16(va[7], pb3, o1, 0, 0, 0); } \
            if (k2) asm volatile("s_waitcnt vmcnt(6) lgkmcnt(0)\n\ts_barrier" ::: "memory"); \
            else asm volatile("s_waitcnt vmcnt(4) lgkmcnt(0)\n\ts_barrier" ::: "memory"); \
        } while (0)
        f32x16 pd0, pd1;
        static_assert(NT % 2 == 0, "two tiles per loop trip");
        for (int t = 0; t < NT; t += 2) {
            ATT_ITER(pc0, pc1, pd0, pd1, t);
            ATT_ITER(pd0, pd1, pc0, pc1, t + 1);
        }
#undef ATT_ITER
        lsum += rs2.x + rs2.y;
        const float lt = lsum + __shfl_xor(lsum, 32); const float il = 1.0f / lt;
        bf16_t* op = MIX + qrow * 1024 + h * 64 + 4 * hi;
#pragma unroll
        for (int g = 0; g < 4; ++g) {
            u32x2 w0, w1; w0.x = cvt_pk_bf16(o0[4 * g] * il, o0[4 * g + 1] * il); w0.y = cvt_pk_bf16(o0[4 * g + 2] * il, o0[4 * g + 3] * il);
            w1.x = cvt_pk_bf16(o1[4 * g] * il, o1[4 * g + 1] * il); w1.y = cvt_pk_bf16(o1[4 * g + 2] * il, o1[4 * g + 3] * il);
            *(u32x2*)(op + 8 * g) = w0; *(u32x2*)(op + 32 + 8 * g) = w1;
        }
        asm volatile("s_waitcnt vmcnt(0) lgkmcnt(0)\n\ts_barrier" ::: "memory");
    }
#undef DMA_K
#undef DMA_V
#undef SBAR
#undef EXP2
#undef PKP
}

__global__ void __launch_bounds__(NTHR, 2) fwd_kernel(Args a) {
    extern __shared__ __attribute__((aligned(16))) unsigned char lds_raw[];
    LAS unsigned char* lds = (LAS unsigned char*)lds_raw;
    cg::grid_group grid = cg::this_grid();
    unsigned* barw = (unsigned*)a.ws;
    volatile LAS unsigned* bst = (volatile LAS unsigned*)(lds_raw + 131072 + 64);
    if (threadIdx.x < 2) bst[threadIdx.x] = 0u;
    __syncthreads();
    XcdBarrier xbar = xcd_barrier_post(barw, bst);
    if (a.out == nullptr) grid.sync();
#define GSYNC() do { for (int s_ = 0; s_ < PROBE_SYNC; ++s_) xcd_barrier(xbar); } while (0)
    const int tid = threadIdx.x, lane = tid & 63, wave = __builtin_amdgcn_readfirstlane(tid >> 6);
    const int G = gridDim.x, cu = blockIdx.x;
    unsigned char* ws = a.ws;
    const float* mod = (const float*)(ws + WS_MOD);
    bf16_t* XN = (bf16_t*)(ws + WS_A);
    bf16_t* XB = (bf16_t*)(ws + WS_XB);

    p0_prologue(a, lds, tid, lane, wave);
    GSYNC();
    norm_pass(a.in[0], ML, XN, a.in[6], mod, 0, -1, lane, wave);
    norm_pass(a.in[2], MC, XN + (size_t)ML * 1024, a.in[6], mod, 0, 2, lane, wave);
    GSYNC();
    { pg8::ProbStd p = pg8::make_std(XN, 1024, ws + WS_WIN, 1024, 1024); pg8::StaticOrder S; S.init(MT, NINP, G, cu);
      pg8::EpiBf16 E{(bf16_t*)(ws + WS_B), PLD, NIN}; pg8::gemm_phase<pg8::EpiBf16, pg8::ProbStd, true>(lds, p, S, E); }
    { pg8::ProbWc p{(const char*)(ws + WS_WF), (const char*)(ws + WS_D256), 256, 1024 * 2, 256 * 2, (size_t)128 * 1024 * 2, (size_t)128 * 256 * 2};
      pg8::StaticOrder S; S.init(2048, 1024, G, (cu + 32) & 255);
      pg8::EpiBf16 E{(bf16_t*)(ws + WS_WC), 1024, 1 << 30}; pg8::gemm_phase<pg8::EpiBf16, pg8::ProbWc, true>(lds, p, S, E); }
    GSYNC();
    { pg8::ProbStd p = pg8::make_std(ws + WS_B, PLD, ws + WS_WUQ, QR, QR); pg8::StaticOrder S; S.init(ML, 768, G, cu);
      pg8::EpiBf16 E{(bf16_t*)(ws + WS_Q), 768, 1 << 30}; pg8::gemm_phase<pg8::EpiBf16, pg8::ProbStd, true>(lds, p, S, E); }
    { pg8::ProbStd p = pg8::make_std(ws + WS_B + QR * 2, PLD, ws + WS_WUKV, KVR, KVR); pg8::StaticOrder S; S.init(MT, 1024, G, (cu + 64) & 255);
      pg8::EpiBf16 E{(bf16_t*)(ws + WS_KV), 1024, 1 << 30}; pg8::gemm_phase<pg8::EpiBf16, pg8::ProbStd, true>(lds, p, S, E); }
    GSYNC();
    prep2_pass(a, lds, tid, lane, wave);
    conv_pass(a, lane, wave);
    GSYNC();
    for (int p_ = 0; p_ < PROBE_ATTN; ++p_) attn_phase(a, lds, tid, lane, wave);
    GSYNC();
    { pg8::ProbStd p = pg8::make_std(ws + WS_A, 1024, ws + WS_WO, 1024, 1024); pg8::StaticOrder S; S.init(ML, 1024, G, cu);
      typedef pg8::EpiResid<float, bf16_t> EP; EP E{a.in[0], XB, mod + 2 * 1024, 6144}; pg8::gemm_phase<EP, pg8::ProbStd, true>(lds, p, S, E); }
    GSYNC();
#pragma unroll
    for (int layer = 0; layer < 2; ++layer) {
        const float* modl = mod + layer * 3 * 6144;
        if (layer == 1) {
            norm_pass_b(XB, ML, XN, a.in[6] + 1024, modl, 0, lane, wave);
            GSYNC();
            { pg8::ProbG1 p{(const char*)(ws + WS_WC), (const char*)XN, 1024, 1024 * 2, 64 * 2048, (size_t)128 * 1024 * 2, (size_t)2048};
              pg8::StaticOrder S; S.init(2048, 16384, G, cu);
              pg8::EpiG1 E{(bf16_t*)(ws + WS_Z1)}; pg8::gemm_phase<pg8::EpiG1, pg8::ProbG1, true>(lds, p, S, E); }
            GSYNC();
            { pg8::ProbStd p = pg8::make_std(ws + WS_W1D, 256, ws + WS_Z1, 256, 256); pg8::StaticOrder S; S.init(256, 131072, G, cu);
              pg8::EpiG2 E{(bf16_t*)(ws + WS_G2)}; pg8::gemm_phase<pg8::EpiG2, pg8::ProbStd, true>(lds, p, S, E); }
            GSYNC();
            { pg8::ProbG3 p{(const char*)(ws + WS_W2D), (const char*)(ws + WS_G2), 512, 512 * 2, 128 * 128 * 2, (size_t)128 * 512 * 2, (size_t)128 * 128 * 128 * 2};
              pg8::StaticOrder S; S.init(256, 65536, G, cu);
              pg8::EpiG3 E{XB, modl + 2 * 1024, 6144}; pg8::gemm_phase<pg8::EpiG3, pg8::ProbG3, true>(lds, p, S, E); }
            GSYNC();
        }
        norm_pass_b(XB, ML, XN, a.in[7] + layer * 1024, modl, 3, lane, wave);
        GSYNC();
        { pg8::ProbStd p = pg8::make_std(XN, 1024, ws + WS_W13 + layer * W13_BYTES, 1024, 1024); pg8::StaticOrder S; S.init(ML, 2 * DFF, G, cu);
          pg8::EpiSwiglu E{(bf16_t*)(ws + WS_H)}; for (int p_ = 0; p_ < PROBE_FFNUP; ++p_) pg8::gemm_phase<pg8::EpiSwiglu, pg8::ProbStd, true>(lds, p, S, E); }
        GSYNC();
        { pg8::ProbStd p = pg8::make_std(ws + WS_H, DFF, ws + WS_W2 + layer * W2_BYTES, DFF, DFF); pg8::StaticOrder S; S.init(ML, 1024, G, cu);
          if (layer == 0) { typedef pg8::EpiResid<bf16_t, bf16_t> EP; EP E{XB, XB, modl + 5 * 1024, 6144}; pg8::gemm_phase<EP, pg8::ProbStd, true>(lds, p, S, E); }
          else { typedef pg8::EpiResid<bf16_t, float> EP; EP E{XB, a.out, modl + 5 * 1024, 6144}; pg8::gemm_phase<EP, pg8::ProbStd, true>(lds, p, S, E); } }
        if (layer == 0) GSYNC();
    }
}

extern "C" void kernel_launch(void* const* d_in, const int* in_sizes, int n_in, void* d_out, int out_size, void* d_ws, size_t ws_size, hipStream_t stream) {
    static int grid = 0;
    if (grid == 0) {
        if (n_in != 21 || out_size != ML * DM || ws_size < WS_END) { fprintf(stderr, "kernel_launch: unexpected problem (n_in %d out %d ws %zu)\n", n_in, out_size, ws_size); grid = -1; return; }
        int dev = 0, cus = 0, per_cu = 0;
        (void)hipGetDevice(&dev);
        (void)hipDeviceGetAttribute(&cus, hipDeviceAttributeMultiprocessorCount, dev);
        (void)hipFuncSetAttribute((const void*)fwd_kernel, hipFuncAttributeMaxDynamicSharedMemorySize, LDS_BYTES);
        (void)hipOccupancyMaxActiveBlocksPerMultiprocessor(&per_cu, (const void*)fwd_kernel, NTHR, LDS_BYTES);
        (void)hipGetLastError();
        grid = 256;
        if (cus < 256 || per_cu < 1) fprintf(stderr, "kernel_launch: cus %d per_cu %d\n", cus, per_cu);
    }
    if (grid < 0) return;
    Args a{};
    for (int i = 0; i < 21; ++i) a.in[i] = (const float*)d_in[i];
    a.out = (float*)d_out; a.ws = (unsigned char*)d_ws;
    (void)hipMemsetAsync(d_ws, 0, 16384, stream);
    void* args[] = {&a};
    hipError_t e = hipLaunchCooperativeKernel((const void*)fwd_kernel, dim3(grid), dim3(NTHR), args, LDS_BYTES, stream);
    if (e != hipSuccess) fprintf(stderr, "cooperative launch failed: %s\n", hipGetErrorString(e));
}
```

```cpp
#include <hip/hip_runtime.h>
#include <hip/hip_cooperative_groups.h>
#include <cstdio>
#include <cstdint>
namespace cg = cooperative_groups;
#ifndef PROBE_SYNC
#define PROBE_SYNC 1
#endif
#ifndef PROBE_ATTN
#define PROBE_ATTN 1
#endif
#ifndef PROBE_FFNUP
#define PROBE_FFNUP 1
#endif

#define LAS __attribute__((address_space(3)))
typedef unsigned short bf16_t;
typedef short bf16x8 __attribute__((ext_vector_type(8)));
typedef short s16x4 __attribute__((ext_vector_type(4)));
typedef float f32x4 __attribute__((ext_vector_type(4)));
typedef float f32x16 __attribute__((ext_vector_type(16)));
typedef unsigned u32x4 __attribute__((ext_vector_type(4)));
typedef unsigned u32x2 __attribute__((ext_vector_type(2)));
typedef float f32x2 __attribute__((ext_vector_type(2)));

constexpr int DM = 1024, SEQ = 8192, ML = 16384, MC = 512, MT = ML + MC;
constexpr int NINP = 2304, NIN = 2208, QR = 384, KVR = 256, NH = 8, DQK = 96, DFF = 2816, NKEY = 8448;
constexpr float EPS = 1e-6f;
constexpr float QSC = 0.10206207261596575f * 1.4426950408889634f;

constexpr size_t MiB = 1u << 20;
constexpr size_t WS_MOD = 1 * MiB;
constexpr size_t WS_WIN = 2 * MiB;
constexpr size_t WS_WUQ = WS_WIN + (size_t)NINP * 1024 * 2;
constexpr size_t WS_WUKV = WS_WUQ + (size_t)768 * 384 * 2;
constexpr size_t WS_WO = WS_WUKV + (size_t)1024 * 256 * 2;
constexpr size_t WS_WF = WS_WO + 2 * MiB;
constexpr size_t WS_WC = WS_WF + 2 * MiB;
constexpr size_t WS_D256 = WS_WC + 4 * MiB;
constexpr size_t WS_W1D = WS_D256 + 262144;
constexpr size_t WS_W2D = WS_W1D + 131072;
constexpr size_t WS_W13 = WS_W2D + 262144;
constexpr size_t W13_BYTES = (size_t)2 * DFF * 1024 * 2;
constexpr size_t WS_W2 = WS_W13 + 2 * W13_BYTES;
constexpr size_t W2_BYTES = (size_t)1024 * DFF * 2;
constexpr size_t WS_WEND = WS_W2 + 2 * W2_BYTES;
static_assert(WS_WEND <= 52 * MiB, "weights");
constexpr size_t WS_A = 52 * MiB;
constexpr int PLD = 2208;
constexpr size_t WS_B = 85 * MiB;
constexpr size_t WS_Q = 157 * MiB;
constexpr size_t WS_KV = 181 * MiB;
constexpr size_t WS_KF = 214 * MiB;
constexpr size_t WS_VT = 239 * MiB;
constexpr size_t WS_H = WS_B;
constexpr size_t WS_Z1 = WS_B;
constexpr size_t WS_G2 = WS_B + 64 * MiB;
constexpr size_t WS_XB = 218 * MiB;
constexpr size_t WS_END = 256 * MiB;

__device__ __forceinline__ unsigned f2bf(float f) { unsigned u = __builtin_bit_cast(unsigned, f); return (u + 0x7fffu + ((u >> 16) & 1u)) >> 16; }
__device__ __forceinline__ unsigned pk2(float lo, float hi) { return f2bf(lo) | (f2bf(hi) << 16); }
__device__ __forceinline__ float bflo(unsigned w) { return __builtin_bit_cast(float, w << 16); }
__device__ __forceinline__ float bfhi(unsigned w) { return __builtin_bit_cast(float, w & 0xffff0000u); }
__device__ __forceinline__ float bf1(bf16_t h) { return __builtin_bit_cast(float, (unsigned)h << 16); }
__device__ __forceinline__ unsigned cvt_pk_bf16(float lo, float hi) { unsigned r; asm volatile("v_cvt_pk_bf16_f32 %0, %1, %2" : "=v"(r) : "v"(lo), "v"(hi)); return r; }
__device__ __forceinline__ float wave_sum(float v) {
#pragma unroll
    for (int o = 1; o < 64; o <<= 1) v += __shfl_xor(v, o);
    return v;
}
__device__ __forceinline__ float sin_rev(float r) { return __builtin_amdgcn_sinf(r); }
__device__ __forceinline__ float cos_rev(float r) { return __builtin_amdgcn_cosf(r); }
__device__ __forceinline__ float silu_f(float x) { return x * __builtin_amdgcn_rcpf(1.0f + __builtin_amdgcn_exp2f(-1.4426950408889634f * x)); }
#define LDS_WAIT() asm volatile("s_waitcnt lgkmcnt(0)" ::: "memory")

namespace pg8 {
constexpr int BM = 256, BK = 64, HALF = 128, HTB = HALF * BK * 2, STAGE_BYTES = 8 * HTB, NXCD = 8, WGM = 2;
__host__ __device__ __forceinline__ int lds_byte(int r, int c) { const int st = (r >> 4) * 2 + (c >> 5), rr = r & 15, cc = c & 31, ob = rr * 64 + cc * 2; return st * 1024 + (ob ^ (((ob >> 9) & 1) << 5)); }
__host__ __device__ __forceinline__ void stage_rc(int b, int& R, int& C) { const int st = b / 1024, sb = b % 1024, swz = sb ^ (((sb >> 9) & 1) << 5); R = (st >> 1) * 16 + swz / 64; C = (st & 1) * 32 + (swz % 64) / 2; }
__host__ __device__ __forceinline__ int perm32(int rho) { const int n = rho >> 4, i = rho & 15; return 8 * (i >> 2) + 4 * n + (i & 3); }

__device__ __forceinline__ void glds16s(const char* sbase, unsigned voff, unsigned lds_dst) { unsigned keep;
    asm volatile("s_mov_b32 %0, m0\n\ts_mov_b32 m0, %3\n\ts_nop 0\n\tglobal_load_lds_dwordx4 %1, %2\n\ts_mov_b32 m0, %0" : "=&s"(keep) : "v"(voff), "s"(sbase), "s"(lds_dst) : "memory"); }
struct Unit { int pm, pn; };
struct StaticOrder {
    int nM, nN, nwg, G, c;
    __device__ void init(int M, int N, int G_, int c_) { nM = M / BM; nN = N / BM; nwg = nM * nN; G = G_; c = c_; }
    __device__ bool next(int i, Unit& u) const {
        const long L = (long)i * G + c; if (L >= nwg) return false;
        int wgid = (int)L; { const int q = nwg / NXCD, r = nwg % NXCD, xcd = wgid % NXCD, off = wgid / NXCD; wgid = (xcd < r ? xcd * (q + 1) : r * (q + 1) + (xcd - r) * q) + off; }
        const int nig = WGM * nN, gid = wgid / nig, fm = gid * WGM, gsz = (nM - fm) < WGM ? (nM - fm) : WGM;
        u.pm = fm + ((wgid % nig) % gsz); u.pn = (wgid % nig) / gsz; return true;
    }
};
struct ProbStd {
    const char* A; const char* B; int K; unsigned rsA, rsB; size_t hsA, hsB, tsA, tsB;
    __device__ __forceinline__ const char* a_base(const Unit& u) const { return A + (size_t)u.pm * tsA; }
    __device__ __forceinline__ const char* b_base(const Unit& u) const { return B + (size_t)u.pn * tsB; }
};
__device__ __forceinline__ ProbStd make_std(const void* A, int lda, const void* B, int ldb, int K) {
    ProbStd p; p.A = (const char*)A; p.B = (const char*)B; p.K = K; p.rsA = lda * 2; p.rsB = ldb * 2;
    p.hsA = (size_t)128 * lda * 2; p.hsB = (size_t)128 * ldb * 2; p.tsA = 2 * p.hsA; p.tsB = 2 * p.hsB; return p;
}

template <class Epi, class Prob, bool ALIGN_EPI>
__device__ __forceinline__ void gemm_phase(LAS unsigned char* lds, const Prob& P, const StaticOrder& S, const Epi& E) {
    int tid = threadIdx.x; asm volatile("" : "+v"(tid));
    const int wid = __builtin_amdgcn_readfirstlane(tid >> 6), lane = tid & 63, wr = wid >> 2, wc = wid & 3, fr = lane & 15, fq = lane >> 4;
    const int nt = P.K / BK;
    unsigned voffA[2], voffB[2];
#pragma unroll
    for (int i = 0; i < 2; ++i) { int R, C; stage_rc(tid * 16 + i * 8192, R, C); const int Rb = (R & ~31) + perm32(R & 31);
        voffA[i] = (unsigned)R * P.rsA + (unsigned)C * 2u; voffB[i] = (unsigned)Rb * P.rsB + (unsigned)C * 2u; }
    const size_t kstep = (size_t)(BK * 2);
    const size_t hstepA = P.hsA, hstepB = P.hsB;
    const unsigned ldsw = (unsigned)wid * 1024u;
    const unsigned lds0 = (unsigned)(size_t)lds;
    const int aoff = lds_byte(wr * 64 + fr, fq * 8), boff = lds_byte(wc * 32 + fr, fq * 8);
#define PG8_SA(b, h) (((b) * 2 + (h)) * HTB)
#define PG8_SB(b, h) ((4 + (b) * 2 + (h)) * HTB)
#define PG8_STAGE(bufoff, gbase, voff) do { _Pragma("unroll") for (int _i = 0; _i < 2; ++_i) \
        glds16s((gbase), (voff)[_i], lds0 + (unsigned)(bufoff) + ldsw + _i * 8192u); } while (0)
#define PG8_LDA(dst, b, h) do { _Pragma("unroll") for (int m = 0; m < 4; ++m) _Pragma("unroll") for (int k = 0; k < 2; ++k) dst[m][k] = *(const LAS bf16x8*)(lds + PG8_SA(b, h) + aoff + m * 2048 + k * 1024); } while (0)
#define PG8_LDB(dst, b, h) do { _Pragma("unroll") for (int n = 0; n < 2; ++n) _Pragma("unroll") for (int k = 0; k < 2; ++k) dst[n][k] = *(const LAS bf16x8*)(lds + PG8_SB(b, h) + boff + n * 2048 + k * 1024); } while (0)
#define PG8_MMA(ai, bj, At, Bt) do { __builtin_amdgcn_s_setprio(1); _Pragma("unroll") for (int m = 0; m < 4; ++m) _Pragma("unroll") for (int n = 0; n < 2; ++n) _Pragma("unroll") for (int k = 0; k < 2; ++k) \
        acc[ai][bj][m][n] = __builtin_amdgcn_mfma_f32_16x16x32_bf16(Bt[n][k], At[m][k], acc[ai][bj][m][n], 0, 0, 0); __builtin_amdgcn_s_setprio(0); } while (0)
#define PG8_WAIT_V(n) asm volatile("s_waitcnt vmcnt(" #n ")" ::: "memory")
#define PG8_WAIT_L(n) asm volatile("s_waitcnt lgkmcnt(" #n ")" ::: "memory")
#define PG8_BAR __builtin_amdgcn_s_barrier()
#define PG8_SCHED __builtin_amdgcn_sched_barrier(0)
    Unit cur, nxt; int ui = 0;
    if (!S.next(0, cur)) return;
    f32x4 acc[2][2][4][2];
#pragma unroll
    for (int a = 0; a < 2; ++a)
#pragma unroll
        for (int b = 0; b < 2; ++b)
#pragma unroll
            for (int m = 0; m < 4; ++m)
#pragma unroll
                for (int n = 0; n < 2; ++n) acc[a][b][m][n] = (f32x4){0.f, 0.f, 0.f, 0.f};
    bf16x8 At[4][2], B0[2][2], B1[2][2];
    const char* cA = P.a_base(cur); const char* cB = P.b_base(cur);
    PG8_STAGE(PG8_SB(0, 0), cB, voffB); PG8_STAGE(PG8_SB(0, 1), cB + hstepB, voffB); PG8_STAGE(PG8_SA(0, 0), cA, voffA); PG8_STAGE(PG8_SA(0, 1), cA + hstepA, voffA);
    if (wr == 1) PG8_BAR;
    PG8_WAIT_V(2); PG8_BAR;
    PG8_STAGE(PG8_SB(1, 0), cB + kstep, voffB); PG8_STAGE(PG8_SA(1, 0), cA + kstep, voffA); PG8_STAGE(PG8_SB(1, 1), cB + hstepB + kstep, voffB);
    PG8_WAIT_V(6); PG8_BAR;
    for (;;) {
        const bool has_next = S.next(ui + 1, nxt);
        const char* nA = has_next ? P.a_base(nxt) : cA; const char* nB = has_next ? P.b_base(nxt) : cB;
        for (int t = 0; t < nt; t += 2) {
            const bool last = (t == nt - 2);
            const char* a1 = cA + (size_t)(t + 1) * kstep;
            const char* a2 = last ? nA : cA + (size_t)(t + 2) * kstep; const char* b2 = last ? nB : cB + (size_t)(t + 2) * kstep;
            const char* a3 = a2 + kstep; const char* b3 = b2 + kstep;
            PG8_LDB(B0, 0, 0); PG8_LDB(B1, 0, 1); PG8_SCHED; PG8_LDA(At, 0, 0); PG8_STAGE(PG8_SA(1, 1), a1 + hstepA, voffA);
            PG8_WAIT_V(8); PG8_WAIT_L(0); PG8_BAR; PG8_MMA(0, 0, At, B0); PG8_MMA(0, 1, At, B1); PG8_BAR; PG8_SCHED;
            PG8_LDA(At, 0, 1); PG8_STAGE(PG8_SB(0, 0), b2, voffB); PG8_STAGE(PG8_SB(0, 1), b2 + hstepB, voffB); PG8_STAGE(PG8_SA(0, 0), a2, voffA);
            PG8_WAIT_V(8); PG8_WAIT_L(0); PG8_BAR; PG8_MMA(1, 0, At, B0); PG8_MMA(1, 1, At, B1); PG8_BAR; PG8_SCHED;
            PG8_LDB(B0, 1, 0); PG8_LDB(B1, 1, 1); PG8_SCHED; PG8_LDA(At, 1, 0); PG8_STAGE(PG8_SA(0, 1), a2 + hstepA, voffA);
            PG8_WAIT_V(8); PG8_WAIT_L(0); PG8_BAR; PG8_MMA(0, 0, At, B0); PG8_MMA(0, 1, At, B1); PG8_BAR; PG8_SCHED;
            PG8_LDA(At, 1, 1); PG8_STAGE(PG8_SB(1, 0), b3, voffB); PG8_STAGE(PG8_SB(1, 1), b3 + hstepB, voffB); PG8_STAGE(PG8_SA(1, 0), a3, voffA);
            PG8_WAIT_V(8); PG8_WAIT_L(0); PG8_BAR; PG8_MMA(1, 0, At, B0); PG8_MMA(1, 1, At, B1); PG8_BAR; PG8_SCHED;
        }
        if constexpr (ALIGN_EPI) { if (wr == 0) PG8_BAR; }
        { int fr_ = fr, fq_ = fq; asm volatile("" : "+v"(fr_), "+v"(fq_)); E(acc, cur, wr, wc, fr_, fq_); }
        if (!has_next) break;
#pragma unroll
        for (int a = 0; a < 2; ++a)
#pragma unroll
            for (int b = 0; b < 2; ++b)
#pragma unroll
                for (int m = 0; m < 4; ++m)
#pragma unroll
                    for (int n = 0; n < 2; ++n) acc[a][b][m][n] = (f32x4){0.f, 0.f, 0.f, 0.f};
        cur = nxt; cA = nA; cB = nB; ++ui;
        if constexpr (ALIGN_EPI) { if (wr == 1) PG8_BAR; }
    }
    PG8_WAIT_V(0);
    if constexpr (!ALIGN_EPI) { if (wr == 0) PG8_BAR; }
    PG8_BAR;
#undef PG8_SA
#undef PG8_SB
#undef PG8_STAGE
#undef PG8_LDA
#undef PG8_LDB
#undef PG8_MMA
#undef PG8_WAIT_V
#undef PG8_WAIT_L
#undef PG8_BAR
#undef PG8_SCHED
}

typedef f32x4 Acc[2][2][4][2];
struct EpiBf16 {
    bf16_t* O; int ldc; int ncols;
    __device__ __forceinline__ void operator()(const Acc& acc, const Unit& u, int wr, int wc, int fr, int fq) const {
        const int row0 = u.pm * BM + wr * 64 + fr, col0 = u.pn * BM + wc * 32 + 8 * fq;
#pragma unroll
        for (int ai = 0; ai < 2; ++ai)
#pragma unroll
            for (int m = 0; m < 4; ++m) { bf16_t* rowp = O + (size_t)(row0 + ai * HALF + m * 16) * ldc + col0;
#pragma unroll
                for (int bj = 0; bj < 2; ++bj) { const f32x4 v0 = acc[ai][bj][m][0], v1 = acc[ai][bj][m][1];
                    u32x4 w; w.x = cvt_pk_bf16(v0[0], v0[1]); w.y = cvt_pk_bf16(v0[2], v0[3]); w.z = cvt_pk_bf16(v1[0], v1[1]); w.w = cvt_pk_bf16(v1[2], v1[3]);
                    if (col0 + bj * HALF < ncols) *(u32x4*)(rowp + bj * HALF) = w; } }
    }
};
__device__ __forceinline__ void ld8(const float* p, f32x4& a, f32x4& b) { a = *(const f32x4*)p; b = *(const f32x4*)(p + 4); }
__device__ __forceinline__ void ld8(const bf16_t* p, f32x4& a, f32x4& b) { const u32x4 w = *(const u32x4*)p; a = (f32x4){bflo(w.x), bfhi(w.x), bflo(w.y), bfhi(w.y)}; b = (f32x4){bflo(w.z), bfhi(w.z), bflo(w.w), bfhi(w.w)}; }
__device__ __forceinline__ void st8(float* p, const f32x4& a, const f32x4& b) { *(f32x4*)p = a; *(f32x4*)(p + 4) = b; }
__device__ __forceinline__ void st8(bf16_t* p, const f32x4& a, const f32x4& b) { u32x4 w; w.x = cvt_pk_bf16(a[0], a[1]); w.y = cvt_pk_bf16(a[2], a[3]); w.z = cvt_pk_bf16(b[0], b[1]); w.w = cvt_pk_bf16(b[2], b[3]); *(u32x4*)p = w; }
template <class TR, class TO> struct EpiResid {
    const TR* res; TO* out; const float* gate0; int gstride;
    __device__ __forceinline__ void operator()(const Acc& acc, const Unit& u, int wr, int wc, int fr, int fq) const {
        const int row0 = u.pm * BM + wr * 64 + fr, col0 = u.pn * BM + wc * 32 + 8 * fq;
        const float* gp = gate0 + (size_t)(u.pm >> 5) * gstride + col0;
        f32x4 g[2][2];
#pragma unroll
        for (int bj = 0; bj < 2; ++bj)
#pragma unroll
            for (int n = 0; n < 2; ++n) g[bj][n] = *(const f32x4*)(gp + bj * HALF + 4 * n);
#pragma unroll
        for (int ai = 0; ai < 2; ++ai)
#pragma unroll
            for (int m = 0; m < 4; ++m) { const size_t off = (size_t)(row0 + ai * HALF + m * 16) * 1024 + col0;
#pragma unroll
                for (int bj = 0; bj < 2; ++bj) { f32x4 r0, r1; ld8(res + off + bj * HALF, r0, r1);
                    st8(out + off + bj * HALF, r0 + g[bj][0] * acc[ai][bj][m][0], r1 + g[bj][1] * acc[ai][bj][m][1]); } }
    }
};
struct EpiSwiglu {
    bf16_t* H;
    __device__ __forceinline__ void operator()(const Acc& acc, const Unit& u, int wr, int wc, int fr, int fq) const {
        const int row0 = u.pm * BM + wr * 64 + fr, col0 = u.pn * HALF + wc * 32 + 8 * fq;
#pragma unroll
        for (int ai = 0; ai < 2; ++ai)
#pragma unroll
            for (int m = 0; m < 4; ++m) { bf16_t* rowp = H + (size_t)(row0 + ai * HALF + m * 16) * DFF + col0;
                f32x4 h0, h1;
#pragma unroll
                for (int j = 0; j < 4; ++j) { h0[j] = silu_f(acc[ai][0][m][0][j]) * acc[ai][1][m][0][j]; h1[j] = silu_f(acc[ai][0][m][1][j]) * acc[ai][1][m][1][j]; }
                u32x4 w; w.x = cvt_pk_bf16(h0[0], h0[1]); w.y = cvt_pk_bf16(h0[2], h0[3]); w.z = cvt_pk_bf16(h1[0], h1[1]); w.w = cvt_pk_bf16(h1[2], h1[3]);
                *(u32x4*)rowp = w; }
    }
};
struct EpiG1 {
    bf16_t* Z1;
    __device__ __forceinline__ void operator()(const Acc& acc, const Unit& u, int wr, int wc, int fr, int fq) const {
        const unsigned b = u.pn >> 5, q = u.pn & 31, ns0 = wc * 32 + 8 * fq;
        const unsigned j0 = u.pm * BM + wr * 64 + fr;
        const unsigned cs = j0 >> 10;
        bf16_t* base = Z1 + ((size_t)(b * 1024u) * 64u * 256u + (size_t)(2u * q) * 256u + cs * 128u + ns0);
#pragma unroll
        for (int ai = 0; ai < 2; ++ai)
#pragma unroll
            for (int m = 0; m < 4; ++m) { const unsigned ch = (j0 + ai * HALF + m * 16) & 1023u; bf16_t* rp = base + (size_t)ch * (64u * 256u);
#pragma unroll
                for (int bj = 0; bj < 2; ++bj) { const f32x4 v0 = acc[ai][bj][m][0], v1 = acc[ai][bj][m][1];
                    u32x4 w; w.x = cvt_pk_bf16(v0[0], v0[1]); w.y = cvt_pk_bf16(v0[2], v0[3]); w.z = cvt_pk_bf16(v1[0], v1[1]); w.w = cvt_pk_bf16(v1[2], v1[3]);
                    *(u32x4*)(rp + bj * 256) = w; }
                asm volatile("" ::: "memory"); }
    }
};
struct EpiG2 {
    bf16_t* G2;
    __device__ __forceinline__ void operator()(const Acc& acc, const Unit& u, int wr, int wc, int fr, int fq) const {
        const unsigned rho00 = u.pn * BM + wc * 32 + 8 * fq;
#pragma unroll
        for (int m = 0; m < 4; ++m) { const unsigned ka = wr * 64 + m * 16 + fr; const float kaf = (float)ka * (1.0f / 8192.0f);
#pragma unroll
            for (int bj = 0; bj < 2; ++bj) { const unsigned rho0 = rho00 + bj * HALF, bc = rho0 >> 6, nf0 = rho0 & 63u;
                bf16_t* dp = G2 + ((size_t)(bc * 128u + ka) * 128u + nf0);
                f32x4 o_r[2], o_i[2];
#pragma unroll
                for (int n = 0; n < 2; ++n) { const f32x4 gr = acc[0][bj][m][n], gi = acc[1][bj][m][n];
#pragma unroll
                    for (int j = 0; j < 4; ++j) { const float rev = (float)(nf0 + 4 * n + j) * kaf; const float c = cos_rev(rev), s = sin_rev(rev);
                        o_r[n][j] = gr[j] * c + gi[j] * s; o_i[n][j] = gi[j] * c - gr[j] * s; } }
                st8(dp, o_r[0], o_r[1]); st8(dp + 64, o_i[0], o_i[1]);
                asm volatile("" ::: "memory"); } }
    }
};
struct EpiG3 {
    bf16_t* out; const float* gate0; int gstride;
    __device__ __forceinline__ void operator()(const Acc& acc, const Unit& u, int wr, int wc, int fr, int fq) const {
        const int chblk = u.pn & 3, kag = (u.pn >> 2) & 31, b = u.pn >> 7, ch0 = chblk * 256 + wc * 32 + 8 * fq;
        const float* gp = gate0 + (size_t)b * gstride + ch0;
        f32x4 g[2][2];
#pragma unroll
        for (int bj = 0; bj < 2; ++bj)
#pragma unroll
            for (int n = 0; n < 2; ++n) g[bj][n] = *(const f32x4*)(gp + bj * HALF + 4 * n);
#pragma unroll
        for (int ai = 0; ai < 2; ++ai)
#pragma unroll
            for (int m = 0; m < 4; ++m) { const int r = ai * HALF + wr * 64 + m * 16 + fr, s = r >> 6, kb = r & 63;
                const size_t off = ((size_t)b * 8192 + 4 * kag + s + 128 * kb) * 1024 + ch0;
#pragma unroll
                for (int bj = 0; bj < 2; ++bj) { f32x4 r0, r1; ld8(out + off + bj * HALF, r0, r1);
                    st8(out + off + bj * HALF, r0 + g[bj][0] * acc[ai][bj][m][0], r1 + g[bj][1] * acc[ai][bj][m][1]); } }
    }
};
struct ProbWc {
    const char* WfT; const char* D; int K; unsigned rsA, rsB; size_t hsA, hsB;
    __device__ __forceinline__ const char* a_base(const Unit& u) const { return WfT + ((size_t)(u.pm & 3) * 256 * 1024 + (size_t)u.pn * 256) * 2; }
    __device__ __forceinline__ const char* b_base(const Unit& u) const { return D + (size_t)(u.pm >> 2) * 256 * 256 * 2; }
};
struct ProbG1 {
    const char* WcT; const char* XN; int K; unsigned rsA, rsB; size_t hsA, hsB;
    __device__ __forceinline__ const char* a_base(const Unit& u) const { return WcT + (size_t)u.pm * 256 * 1024 * 2; }
    __device__ __forceinline__ const char* b_base(const Unit& u) const { return XN + ((size_t)(u.pn >> 5) * 8192 + 2 * (u.pn & 31)) * 2048; }
};
struct ProbG3 {
    const char* W2d; const char* G2; int K; unsigned rsA, rsB; size_t hsA, hsB;
    __device__ __forceinline__ const char* a_base(const Unit&) const { return W2d; }
    __device__ __forceinline__ const char* b_base(const Unit& u) const { const int chblk = u.pn & 3, kag = (u.pn >> 2) & 31, b = u.pn >> 7;
        return G2 + (((size_t)(b * 1024 + chblk * 256) * 128 + 4 * kag) * 128) * 2; }
};
}

#define RLX_AGENT __ATOMIC_RELAXED, __HIP_MEMORY_SCOPE_AGENT
#define XB_TMO      128
#define XB_XCNT(j)  (256  + 64 * (j))
#define XB_XSUB(j)  (1280 + 64 * (j))
#define XB_XGEN(j)  (2304 + 64 * (j))
#define XB_TOP      3328
#define XB_TOPGEN   3392
#define XCD_BAR_WORDS 3456
#define XB_SPIN_CAP (1u << 18)

__device__ __forceinline__ unsigned xb_ld(unsigned* p)              { return __hip_atomic_load(p, __ATOMIC_RELAXED, __HIP_MEMORY_SCOPE_AGENT); }
__device__ __forceinline__ unsigned xb_add(unsigned* p, unsigned v) { return __hip_atomic_fetch_add(p, v, __ATOMIC_RELAXED, __HIP_MEMORY_SCOPE_AGENT); }
__device__ __forceinline__ unsigned xb_xcc_id() { return (unsigned)__builtin_amdgcn_s_getreg((3 << 11) | 20) & 0xFu; }
#define XB_SPIN(cond, bar) do { unsigned _sp = 0; while (cond) { __builtin_amdgcn_s_sleep(1); \
    if ((++_sp & 255u) == 0u) { if (xb_ld(&(bar)[XB_TMO])) break; if (_sp > XB_SPIN_CAP) { atomicAdd(&(bar)[XB_TMO], 1u); break; } } } } while (0)

struct XcdBarrier {
    unsigned* bar; unsigned x;
    volatile LAS unsigned* st;
};

__device__ __forceinline__ XcdBarrier xcd_barrier_post(unsigned* bar, volatile LAS unsigned* st) {
    XcdBarrier b; b.bar = bar; b.x = xb_xcc_id(); b.st = st;
    if (threadIdx.x == 0) (void)xb_add(&bar[XB_XCNT(b.x)], 1u);
    return b;
}
__device__ __forceinline__ void xcd_barrier_complete(unsigned* bar, unsigned x, unsigned& nloc, unsigned& nx) {
    const unsigned G = gridDim.x * gridDim.y * gridDim.z;
    unsigned sum, cnt, mine, sp = 0u;
    for (;;) {
        sum = 0u; cnt = 0u; mine = 0u;
#pragma unroll
        for (unsigned j = 0; j < 16; ++j) { const unsigned c = xb_ld(&bar[XB_XCNT(j)]); sum += c; cnt += (c > 0u) ? 1u : 0u; mine = (j == x) ? c : mine; }
        if (sum == G) break;
        __builtin_amdgcn_s_sleep(1);
        if ((++sp & 255u) == 0u) { if (xb_ld(&bar[XB_TMO])) break; if (sp > XB_SPIN_CAP) { atomicAdd(&bar[XB_TMO], 1u); break; } }
    }
    nloc = mine > 0u ? mine : 1u; nx = cnt > 0u ? cnt : 1u;
}

__device__ __forceinline__ void xcd_barrier(const XcdBarrier& b) {
    asm volatile("s_waitcnt vmcnt(0)" ::: "memory");
    __syncthreads();
    if (threadIdx.x == 0) {
        unsigned* bar = b.bar;
        __builtin_amdgcn_s_waitcnt(0);
        unsigned nloc = b.st[0], nx = b.st[1];
        if (nloc == 0u) { xcd_barrier_complete(bar, b.x, nloc, nx); b.st[0] = nloc; b.st[1] = nx; }
        const unsigned old = xb_add(&bar[XB_XSUB(b.x)], 1u);
        const unsigned gen = old / nloc;
        if (old + 1u == (gen + 1u) * nloc) {
            __builtin_amdgcn_fence(__ATOMIC_RELEASE, "agent");
            asm volatile("s_waitcnt vmcnt(0)" ::: "memory");
            const unsigned og = xb_add(&bar[XB_TOP], 1u);
            const unsigned tg = og / nx;
            if (og + 1u == (tg + 1u) * nx) xb_add(&bar[XB_TOPGEN], 1u);
            else XB_SPIN(xb_ld(&bar[XB_TOPGEN]) == tg, bar);
            __builtin_amdgcn_fence(__ATOMIC_ACQUIRE, "agent");
            xb_add(&bar[XB_XGEN(b.x)], 1u);
            asm volatile("s_waitcnt vmcnt(0)" ::: "memory");
        } else {
            XB_SPIN(xb_ld(&bar[XB_XGEN(b.x)]) == gen, bar);
            __builtin_amdgcn_fence(__ATOMIC_ACQUIRE, "agent");
            asm volatile("s_waitcnt vmcnt(0)" ::: "memory");
        }
    }
    __syncthreads();
}
struct Args {
    const float* in[21]; float* out; unsigned char* ws;
};
constexpr int NWAVES = 8, NTHR = 512;
constexpr int LDS_BYTES = 147456;

__device__ __forceinline__ void ada_item(const Args& a, int item, LAS unsigned char* lds, int tid, int lane, int wave) {
    const int layer = item / 96, n0 = (item % 96) * 64;
    LAS float* sil = (LAS float*)lds; LAS float* red = sil + 3072;
    const float* c = a.in[1]; const float* cc = a.in[3];
    for (int i = tid; i < 3072; i += NTHR) { const int v = i >> 10, k = i & 1023; const float cv = (v < 2) ? c[v * 1024 + k] : cc[k]; sil[i] = cv / (1.0f + __expf(-cv)); }
    __syncthreads();
    const float* W = a.in[4] + (size_t)layer * 1024 * 6144 + n0 + lane;
    float a0 = 0.f, a1 = 0.f, a2 = 0.f; const int k0 = wave * 128;
#pragma unroll 8
    for (int kk = 0; kk < 128; ++kk) { const int k = k0 + kk; const float w = W[(size_t)k * 6144]; a0 += sil[k] * w; a1 += sil[1024 + k] * w; a2 += sil[2048 + k] * w; }
    red[(wave * 3 + 0) * 64 + lane] = a0; red[(wave * 3 + 1) * 64 + lane] = a1; red[(wave * 3 + 2) * 64 + lane] = a2;
    __syncthreads();
    if (tid < 192) { const int v = tid >> 6, l = tid & 63; float s = a.in[5][layer * 6144 + n0 + l];
#pragma unroll
        for (int w = 0; w < 8; ++w) s += red[(w * 3 + v) * 64 + l];
        ((float*)(a.ws + WS_MOD))[(layer * 3 + v) * 6144 + n0 + l] = s; }
    __syncthreads();
}
__device__ __forceinline__ void transpose_item(const float* W, int N, bf16_t* WT, int ldk, int k0, int n0, int drow0, LAS float* scr, int lane, const float* kscale = nullptr) {
#pragma unroll 8
    for (int i = 0; i < 32; ++i) { const int kk = 2 * i + (lane >> 5); float w = W[(size_t)(k0 + kk) * N + n0 + (lane & 31)]; if (kscale) w *= kscale[k0 + kk]; scr[kk * 33 + (lane & 31)] = w; }
    LDS_WAIT(); asm volatile("" ::: "memory");
    const int c = lane & 7;
#pragma unroll
    for (int j = 0; j < 4; ++j) { const int n = (lane >> 3) + 8 * j; const LAS float* s = scr + (8 * c) * 33 + n;
        u32x4 o; o.x = pk2(s[0 * 33], s[1 * 33]); o.y = pk2(s[2 * 33], s[3 * 33]); o.z = pk2(s[4 * 33], s[5 * 33]); o.w = pk2(s[6 * 33], s[7 * 33]);
        *(u32x4*)(WT + (size_t)(drow0 + n) * ldk + k0 + 8 * c) = o; }
    LDS_WAIT(); asm volatile("" ::: "memory");
}
__device__ __forceinline__ void p0_prologue(const Args& a, LAS unsigned char* lds, int tid, int lane, int wave) {
    asm volatile("" : "+v"(lane), "+v"(tid));
    unsigned char* ws = a.ws;
    if (blockIdx.x < 192) ada_item(a, blockIdx.x, lds, tid, lane, wave);
    LAS float* scr = (LAS float*)(lds + wave * 16384);
    const int gw = blockIdx.x * NWAVES + wave, NGW = gridDim.x * NWAVES;
    constexpr int I_IN = 16 * 69, I_UQ = 6 * 24, I_UKV = 4 * 32, I_O = 512, I_F = 512, I_13 = 16 * 88, I_2 = 44 * 32;
    constexpr int NITEMS = I_IN + I_UQ + I_UKV + I_O + I_F + 2 * (2 * I_13 + I_2);
    for (int it = gw; it < NITEMS; it += NGW) {
        int r = it;
        if (r < I_IN) { const int kb = r / 69, nb = r % 69; transpose_item(a.in[8], NIN, (bf16_t*)(ws + WS_WIN), 1024, 64 * kb, 32 * nb, 32 * nb, scr, lane); continue; } r -= I_IN;
        if (r < I_UQ) { const int kb = r / 24, nb = r % 24; transpose_item(a.in[11], 768, (bf16_t*)(ws + WS_WUQ), 384, 64 * kb, 32 * nb, 32 * nb, scr, lane, a.in[9]); continue; } r -= I_UQ;
        if (r < I_UKV) { const int kb = r / 32, nb = r % 32; transpose_item(a.in[12], 1024, (bf16_t*)(ws + WS_WUKV), 256, 64 * kb, 32 * nb, 32 * nb, scr, lane, a.in[10]); continue; } r -= I_UKV;
        if (r < I_O) { const int kb = r / 32, nb = r % 32; transpose_item(a.in[16], 1024, (bf16_t*)(ws + WS_WO), 1024, 64 * kb, 32 * nb, 32 * nb, scr, lane); continue; } r -= I_O;
        if (r < I_F) { const int kb = r / 32, nb = r % 32; transpose_item(a.in[17], 1024, (bf16_t*)(ws + WS_WF), 1024, 64 * kb, 32 * nb, 32 * nb, scr, lane); continue; } r -= I_F;
        const int layer = r / (2 * I_13 + I_2); r -= layer * (2 * I_13 + I_2);
        if (r < 2 * I_13) { const int s = r / I_13; r -= s * I_13; const int kb = r / 88, nb = r % 88, n0 = 32 * nb;
            transpose_item(a.in[s ? 19 : 18] + (size_t)layer * 1024 * DFF, DFF, (bf16_t*)(ws + WS_W13 + layer * W13_BYTES), 1024, 64 * kb, n0, 256 * (n0 >> 7) + 128 * s + (n0 & 127), scr, lane); continue; }
        r -= 2 * I_13;
        { const int kb = r / 32, nb = r % 32; transpose_item(a.in[20] + (size_t)layer * DFF * 1024, 1024, (bf16_t*)(ws + WS_W2 + layer * W2_BYTES), DFF, 64 * kb, 32 * nb, 32 * nb, scr, lane); }
    }
    const int gt = blockIdx.x * NTHR + tid, NGT = gridDim.x * NTHR;
    { unsigned* z = (unsigned*)(ws + WS_WIN + (size_t)NIN * 1024 * 2); for (int i = gt; i < 96 * 1024 / 2; i += NGT) z[i] = 0u; }
    { bf16_t* d = (bf16_t*)(ws + WS_D256);
      for (int i = gt; i < 131072; i += NGT) { const int cs = i >> 16, c = (i >> 8) & 255, cp = i & 255; const float rev = (float)((c * cp) & 255) * (1.0f / 256.0f);
          const float v = cs ? -sin_rev(rev) : cos_rev(rev); d[i] = (bf16_t)f2bf(v * 0.0625f); } }
    { bf16_t* d = (bf16_t*)(ws + WS_W1D);
      for (int i = gt; i < 65536; i += NGT) { const int row = i >> 8, col = i & 255, ro = row >> 7, ka = row & 127, ri = col >> 7, n = col & 127; const float rev = (float)((n * ka) & 127) * (1.0f / 128.0f);
          const float c = cos_rev(rev), s = sin_rev(rev); const float v = (ro == 0) ? (ri == 0 ? c : s) : (ri == 0 ? -s : c); d[i] = (bf16_t)f2bf(v * 0.08838834764831845f); } }
    { bf16_t* d = (bf16_t*)(ws + WS_W2D);
      for (int i = gt; i < 256 * 512; i += NGT) { const int row = i >> 9, col = i & 511, s = row >> 6, kb = row & 63, sp = col >> 7, ri = (col >> 6) & 1, n2 = col & 63; float v = 0.f;
          if (s == sp) { const float rev = (float)((n2 * kb) & 63) * (1.0f / 64.0f); v = (ri == 0 ? cos_rev(rev) : sin_rev(rev)) * 0.125f; }
          d[i] = (bf16_t)f2bf(v); } }
}

__device__ __forceinline__ void norm_pass(const float* src, int nrows, bf16_t* dst, const float* g, const float* mod, int sh_chunk, int vfixed, int lane, int wave) {
    asm volatile("" : "+v"(lane));
    const int gw = blockIdx.x * NWAVES + wave, NGW = gridDim.x * NWAVES;
    const int nb = vfixed >= 0 ? 1 : 2;
#pragma unroll 1
    for (int b = 0; b < nb; ++b) {
        const int v = vfixed >= 0 ? vfixed : b; const float* mv = mod + v * 6144 + sh_chunk * 1024;
        f32x4 cg[4], cs[4];
#pragma unroll
        for (int j = 0; j < 4; ++j) { const int c = (j >> 1) * 512 + lane * 8 + (j & 1) * 4; const f32x4 gg = *(const f32x4*)(g + c), sc = *(const f32x4*)(mv + 1024 + c); cg[j] = gg * (sc + 1.0f); cs[j] = *(const f32x4*)(mv + c); }
        const int rlo = vfixed >= 0 ? 0 : b * 8192, rhi = vfixed >= 0 ? nrows : (b + 1) * 8192;
        for (int r = rlo + gw; r < rhi && r < nrows; r += NGW) {
            const float* xrow = src + (size_t)r * 1024; bf16_t* orow = dst + (size_t)r * 1024;
            f32x4 x[4]; pg8::ld8(xrow + lane * 8, x[0], x[1]); pg8::ld8(xrow + 512 + lane * 8, x[2], x[3]); float s = 0.f;
#pragma unroll
            for (int j = 0; j < 4; ++j) s += (x[j].x * x[j].x + x[j].y * x[j].y) + (x[j].z * x[j].z + x[j].w * x[j].w);
            const float rstd = rsqrtf(wave_sum(s) * (1.0f / 1024.0f) + EPS);
            pg8::st8(orow + lane * 8, x[0] * rstd * cg[0] + cs[0], x[1] * rstd * cg[1] + cs[1]);
            pg8::st8(orow + 512 + lane * 8, x[2] * rstd * cg[2] + cs[2], x[3] * rstd * cg[3] + cs[3]);
        }
    }
}
__device__ __forceinline__ void norm_pass_b(const bf16_t* src, int nrows, bf16_t* dst, const float* g, const float* mod, int sh_chunk, int lane, int wave) {
    asm volatile("" : "+v"(lane));
    const int gw = blockIdx.x * NWAVES + wave, NGW = gridDim.x * NWAVES;
#pragma unroll 1
    for (int b = 0; b < 2; ++b) {
        const float* mv = mod + b * 6144 + sh_chunk * 1024;
        f32x4 cg[4], cs[4];
#pragma unroll
        for (int j = 0; j < 4; ++j) { const int c = (j >> 1) * 512 + lane * 8 + (j & 1) * 4; const f32x4 gg = *(const f32x4*)(g + c), sc = *(const f32x4*)(mv + 1024 + c); cg[j] = gg * (sc + 1.0f); cs[j] = *(const f32x4*)(mv + c); }
        for (int r = b * 8192 + gw; r < (b + 1) * 8192 && r < nrows; r += NGW) {
            const bf16_t* xrow = src + (size_t)r * 1024; bf16_t* orow = dst + (size_t)r * 1024;
            f32x4 v[4]; pg8::ld8(xrow + lane * 8, v[0], v[1]); pg8::ld8(xrow + 512 + lane * 8, v[2], v[3]); float s = 0.f;
#pragma unroll
            for (int j = 0; j < 4; ++j) s += (v[j].x * v[j].x + v[j].y * v[j].y) + (v[j].z * v[j].z + v[j].w * v[j].w);
            const float rstd = rsqrtf(wave_sum(s) * (1.0f / 1024.0f) + EPS);
            pg8::st8(orow + lane * 8, v[0] * rstd * cg[0] + cs[0], v[1] * rstd * cg[1] + cs[1]);
            pg8::st8(orow + 512 + lane * 8, v[2] * rstd * cg[2] + cs[2], v[3] * rstd * cg[3] + cs[3]);
        }
    }
}

__device__ __forceinline__ float sumsq8(u32x4 c) { float s = 0.f;
#pragma unroll
    for (int i = 0; i < 4; ++i) { const float a = bflo(c[i]), b = bfhi(c[i]); s += a * a + b * b; } return s; }
__device__ __forceinline__ u32x4 scale8(u32x4 c, float r, const float* g) { const f32x4 g0 = *(const f32x4*)g, g1 = *(const f32x4*)(g + 4); u32x4 o;
    o.x = pk2(bflo(c.x) * r * g0.x, bfhi(c.x) * r * g0.y); o.y = pk2(bflo(c.y) * r * g0.z, bfhi(c.y) * r * g0.w);
    o.z = pk2(bflo(c.z) * r * g1.x, bfhi(c.z) * r * g1.y); o.w = pk2(bflo(c.w) * r * g1.z, bfhi(c.w) * r * g1.w); return o; }
__device__ __forceinline__ void conv_pass(const Args& a, int lane, int wave) {
    asm volatile("" : "+v"(lane));
    unsigned char* ws = a.ws;
    const bf16_t* P = (const bf16_t*)(ws + WS_B); bf16_t* MIX = (bf16_t*)(ws + WS_A);
    const float* cw = a.in[15];
    f32x4 w0[2], w1[2], w2[2];
#pragma unroll
    for (int i = 0; i < 2; ++i) { w0[i] = *(const f32x4*)(cw + 8 * lane + 4 * i); w1[i] = *(const f32x4*)(cw + 512 + 8 * lane + 4 * i); w2[i] = *(const f32x4*)(cw + 1024 + 8 * lane + 4 * i); }
    const int gw = blockIdx.x * NWAVES + wave, NGW = gridDim.x * NWAVES;
    for (int r = gw; r < ML; r += NGW) {
        const int t = r & (SEQ - 1);
        const bf16_t* cb = P + (size_t)r * PLD + 672 + 8 * lane;
        const u32x4 bg = *(const u32x4*)cb, cg0 = *(const u32x4*)(cb + 512), u0 = *(const u32x4*)(cb + 1024);
        u32x4 cgm = (u32x4){0u, 0u, 0u, 0u}, um = cgm, cgp = cgm, up = cgm;
        if (t > 0) { cgm = *(const u32x4*)(cb - PLD + 512); um = *(const u32x4*)(cb - PLD + 1024); }
        if (t < SEQ - 1) { cgp = *(const u32x4*)(cb + PLD + 512); up = *(const u32x4*)(cb + PLD + 1024); }
        u32x4 o;
#pragma unroll
        for (int i = 0; i < 4; ++i) {
            const float zl_m = bflo(cgm[i]) * bflo(um[i]), zh_m = bfhi(cgm[i]) * bfhi(um[i]);
            const float zl_0 = bflo(cg0[i]) * bflo(u0[i]), zh_0 = bfhi(cg0[i]) * bfhi(u0[i]);
            const float zl_p = bflo(cgp[i]) * bflo(up[i]), zh_p = bfhi(cgp[i]) * bfhi(up[i]);
            const int e = 2 * i;
            const float yl = zl_m * w0[e >> 2][e & 3] + zl_0 * w1[e >> 2][e & 3] + zl_p * w2[e >> 2][e & 3];
            const float yh = zh_m * w0[(e + 1) >> 2][(e + 1) & 3] + zh_0 * w1[(e + 1) >> 2][(e + 1) & 3] + zh_p * w2[(e + 1) >> 2][(e + 1) & 3];
            o[i] = pk2(bflo(bg[i]) * yl, bfhi(bg[i]) * yh);
        }
        *(u32x4*)(MIX + (size_t)r * 1024 + 512 + 8 * lane) = o;
    }
}

__device__ __forceinline__ void prep2_pass(const Args& a, LAS unsigned char* lds, int tid, int lane, int wave) {
    asm volatile("" : "+v"(lane), "+v"(tid));
    unsigned char* ws = a.ws;
    bf16_t* Q = (bf16_t*)(ws + WS_Q); const bf16_t* KV = (const bf16_t*)(ws + WS_KV); const bf16_t* P = (const bf16_t*)(ws + WS_B);
    LAS float* rkl = (LAS float*)(lds + 65536);
    bf16_t* Kf = (bf16_t*)(ws + WS_KF); bf16_t* Vt = (bf16_t*)(ws + WS_VT);
    const float* qgain = a.in[13]; const float* kgain = a.in[14];
    const int head = lane >> 3, sub = lane & 7;
    const float inv = __builtin_amdgcn_exp2f(-(float)sub * 1.6609640474436813f) * 0.15915494309189535f;
    float qgn[8], kgn[8], qgp[4], kgp[4];
#pragma unroll
    for (int e = 0; e < 8; ++e) { qgn[e] = qgain[8 * sub + e] * QSC; kgn[e] = kgain[8 * sub + e]; }
#pragma unroll
    for (int i = 0; i < 4; ++i) { qgp[i] = qgain[64 + sub + 8 * i] * QSC; kgp[i] = kgain[64 + sub + 8 * i]; }
    constexpr int PB = 16, RW = PB / 8;
    for (int blk = blockIdx.x; blk < MT / PB; blk += gridDim.x) {
        const int r0 = blk * PB; const bool latent = blk < ML / PB;
        const int b = latent ? (blk / (SEQ / PB)) : ((blk - ML / PB) / (256 / PB));
        const int key0 = latent ? ((blk % (SEQ / PB)) * PB) : (SEQ + ((blk - ML / PB) % (256 / PB)) * PB);
#pragma unroll
        for (int i = 0; i < PB / 8; ++i) { const int id = tid + 512 * i, row = id >> 6, cc = id & 63, h = cc >> 3, part = cc & 7;
            const u32x4 v = *(const u32x4*)(KV + (size_t)(r0 + row) * 1024 + h * 128 + 64 + part * 8);
            *(LAS u32x4*)(lds + row * 1024 + cc * 16) = v; }
        for (int i = 0; i < RW; ++i) {
            const int r = r0 + RW * wave + i, kl = RW * wave + i;
            float cr = 1.f, sr = 0.f, ccol = 1.f, scol = 0.f;
            if (latent) { const int t = r & (SEQ - 1); const float ar = (float)(t >> 6) * inv, ac = (float)(t & 63) * inv;
                cr = cos_rev(ar - floorf(ar)); sr = sin_rev(ar - floorf(ar)); ccol = cos_rev(ac - floorf(ac)); scol = sin_rev(ac - floorf(ac)); }
            const bf16_t* prow = P + (size_t)r * PLD; const bf16_t* kpe = prow + 640;
            float rq, rkv;
            { const u32x4 c1 = *(const u32x4*)(prow + lane * 8); u32x4 c2 = (u32x4){0u, 0u, 0u, 0u}; if (lane < 16) c2 = *(const u32x4*)(prow + 512 + lane * 8);
              const float ss1 = sumsq8(c1), ss2 = sumsq8(c2);
              const float sq = wave_sum(lane < 48 ? ss1 : 0.f), skv = wave_sum((lane >= 48 ? ss1 : 0.f) + ss2);
              rq = rsqrtf(sq * (1.0f / 384.0f) + EPS); rkv = rsqrtf(skv * (1.0f / 256.0f) + EPS); if (lane == 0) rkl[kl] = rkv; }
            if (latent) {
                bf16_t* qp = Q + (size_t)r * 768 + head * 96;
                const u32x4 nv = *(const u32x4*)(qp + 8 * sub);
                float pe[4];
#pragma unroll
                for (int j = 0; j < 4; ++j) pe[j] = bf1(qp[64 + sub + 8 * j]) * rq;
                float ss = sumsq8(nv) * (rq * rq) + (pe[0] * pe[0] + pe[1] * pe[1]) + (pe[2] * pe[2] + pe[3] * pe[3]);
                ss += __shfl_xor(ss, 1); ss += __shfl_xor(ss, 2); ss += __shfl_xor(ss, 4);
                const float rs0 = rsqrtf(ss * (1.0f / 96.0f) + EPS), rs = rs0 * rq;
                u32x4 o; o.x = pk2(bflo(nv.x) * rs * qgn[0], bfhi(nv.x) * rs * qgn[1]); o.y = pk2(bflo(nv.y) * rs * qgn[2], bfhi(nv.y) * rs * qgn[3]);
                o.z = pk2(bflo(nv.z) * rs * qgn[4], bfhi(nv.z) * rs * qgn[5]); o.w = pk2(bflo(nv.w) * rs * qgn[6], bfhi(nv.w) * rs * qgn[7]);
                *(u32x4*)(qp + 8 * sub) = o;
                const float p0 = pe[0] * rs0 * qgp[0], p1 = pe[1] * rs0 * qgp[1], p2 = pe[2] * rs0 * qgp[2], p3 = pe[3] * rs0 * qgp[3];
                qp[64 + sub] = (bf16_t)f2bf(p0 * cr - p1 * sr); qp[72 + sub] = (bf16_t)f2bf(p1 * cr + p0 * sr);
                qp[80 + sub] = (bf16_t)f2bf(p2 * ccol - p3 * scol); qp[88 + sub] = (bf16_t)f2bf(p3 * ccol + p2 * scol);
            }
            {
                const u32x4 nv = *(const u32x4*)(KV + (size_t)r * 1024 + head * 128 + 8 * sub);
                float pe[4];
#pragma unroll
                for (int j = 0; j < 4; ++j) pe[j] = bf1(kpe[sub + 8 * j]);
                float ss = sumsq8(nv) * (rkv * rkv) + (pe[0] * pe[0] + pe[1] * pe[1]) + (pe[2] * pe[2] + pe[3] * pe[3]);
                ss += __shfl_xor(ss, 1); ss += __shfl_xor(ss, 2); ss += __shfl_xor(ss, 4);
                const float rs0 = rsqrtf(ss * (1.0f / 96.0f) + EPS), rs = rs0 * rkv;
                bf16_t* kp = Kf + ((size_t)(b * NH + head) * NKEY + key0 + kl) * DQK;
                u32x4 o; o.x = pk2(bflo(nv.x) * rs * kgn[0], bfhi(nv.x) * rs * kgn[1]); o.y = pk2(bflo(nv.y) * rs * kgn[2], bfhi(nv.y) * rs * kgn[3]);
                o.z = pk2(bflo(nv.z) * rs * kgn[4], bfhi(nv.z) * rs * kgn[5]); o.w = pk2(bflo(nv.w) * rs * kgn[6], bfhi(nv.w) * rs * kgn[7]);
                *(u32x4*)(kp + 8 * sub) = o;
                const float p0 = pe[0] * rs0 * kgp[0], p1 = pe[1] * rs0 * kgp[1], p2 = pe[2] * rs0 * kgp[2], p3 = pe[3] * rs0 * kgp[3];
                kp[64 + sub] = (bf16_t)f2bf(p0 * cr - p1 * sr); kp[72 + sub] = (bf16_t)f2bf(p1 * cr + p0 * sr);
                kp[80 + sub] = (bf16_t)f2bf(p2 * ccol - p3 * scol); kp[88 + sub] = (bf16_t)f2bf(p3 * ccol + p2 * scol);
            }
        }
        __syncthreads();
        { const int h = tid >> 6, d = tid & 63; bf16_t* vp = Vt + ((size_t)(b * NH + h) * 64 + d) * NKEY + key0;
#pragma unroll
          for (int i = 0; i < PB / 8; ++i) { float e[8];
#pragma unroll
              for (int k = 0; k < 8; ++k) e[k] = bf1(*(const LAS unsigned short*)(lds + (8 * i + k) * 1024 + tid * 2)) * rkl[8 * i + k];
              u32x4 o; o.x = pk2(e[0], e[1]); o.y = pk2(e[2], e[3]); o.z = pk2(e[4], e[5]); o.w = pk2(e[6], e[7]);
              *(u32x4*)(vp + 8 * i) = o; } }
        __syncthreads();
    }
}

__device__ __forceinline__ float attn_rowmax(const f32x16& p0, const f32x16& p1) {
    float a = __builtin_fmaxf(__builtin_fmaxf(p0[0], p0[1]), p1[0]), b = __builtin_fmaxf(__builtin_fmaxf(p0[2], p0[3]), p1[1]);
    a = __builtin_fmaxf(__builtin_fmaxf(a, p1[2]), p1[3]);
#pragma unroll
    for (int r = 4; r < 16; r += 4) { a = __builtin_fmaxf(__builtin_fmaxf(a, p0[r]), p0[r + 1]); b = __builtin_fmaxf(__builtin_fmaxf(b, p0[r + 2]), p0[r + 3]);
        a = __builtin_fmaxf(__builtin_fmaxf(a, p1[r]), p1[r + 1]); b = __builtin_fmaxf(__builtin_fmaxf(b, p1[r + 2]), p1[r + 3]); }
    const float mx = __builtin_fmaxf(a, b);
    auto rr = __builtin_amdgcn_permlane32_swap(__float_as_uint(mx), __float_as_uint(mx), false, false);
    return __builtin_fmaxf(__uint_as_float(rr[0]), __uint_as_float(rr[1]));
}
__device__ __forceinline__ void attn_phase(const Args& a, LAS unsigned char* lds, int tid, int lane, int wid) {
    asm volatile("" : "+v"(lane), "+v"(tid));
    unsigned char* ws = a.ws;
    const bf16_t* Q = (const bf16_t*)(ws + WS_Q); const char* Kf = (const char*)(ws + WS_KF); const char* Vt = (const char*)(ws + WS_VT); bf16_t* MIX = (bf16_t*)(ws + WS_A);
    constexpr int NS = 4, KSLOT = 13312, VBASE = NS * KSLOT, VSLOT = 8192, NT = NKEY / 64;
    constexpr float THR = 8.0f;
    const int q = lane & 31, hi = lane >> 5;
    const int xcd = blockIdx.x & 7, l = blockIdx.x >> 3;
    const unsigned lds0 = (unsigned)(size_t)lds;
    unsigned koff[2];
#pragma unroll
    for (int i = 0; i < 2; ++i) { const int p = 64 * (wid + 8 * i) + lane, row = p / 13, c = p % 13, r31 = row & 31;
        const int key = (row & 32) + ((r31 & 19) | ((r31 & 4) << 1) | ((r31 & 8) >> 1)); koff[i] = (unsigned)(key * 192 + (c < 12 ? c : 11) * 16); }
    const bool k2 = wid < 5;
    unsigned voffv; { const int d = 8 * wid + (lane >> 3), cp = lane & 7, c = cp ^ ((d >> 1) & 7); voffv = (unsigned)(d * (NKEY * 2) + c * 16); }
    const unsigned kdst0 = lds0 + (unsigned)wid * 1024u, kdst1 = lds0 + (unsigned)(wid + 8) * 1024u, vdst = lds0 + VBASE + (unsigned)wid * 1024u;
    const int kro = q * 208 + hi * 16;
    int vro[4];
#pragma unroll
    for (int s = 0; s < 4; ++s) vro[s] = VBASE + q * 128 + (((2 * s + hi) ^ ((q >> 1) & 7)) * 16);
#define DMA_K(tile, slot) do { const char* kb_ = Kh + (size_t)(tile) * (64 * 192); pg8::glds16s(kb_, koff[0], kdst0 + (slot) * KSLOT); if (k2) pg8::glds16s(kb_, koff[1], kdst1 + (slot) * KSLOT); } while (0)
#define DMA_V(tile, slot) pg8::glds16s(Vh + (size_t)(tile) * 128, voffv, vdst + (slot) * VSLOT)
#define SBAR() do {} while (0)
#define EXP2(P, R) do { P[R] = __builtin_amdgcn_exp2f(P[R]); P[R + 1] = __builtin_amdgcn_exp2f(P[R + 1]); rs2 += (f32x2){P[R], P[R + 1]}; } while (0)
#define PKP(P, B) __builtin_bit_cast(bf16x8, (u32x4){cvt_pk_bf16(P[B], P[B + 1]), cvt_pk_bf16(P[B + 2], P[B + 3]), cvt_pk_bf16(P[B + 4], P[B + 5]), cvt_pk_bf16(P[B + 6], P[B + 7])})
    for (int it = 0; it < 2; ++it) {
        const int bh = 2 * xcd + it, b = bh >> 3, h = bh & 7, qb = l;
        const size_t qrow = (size_t)b * SEQ + qb * 256 + wid * 32 + q;
        const char* Kh = Kf + (size_t)bh * NKEY * 192; const char* Vh = Vt + (size_t)bh * 64 * NKEY * 2;
        DMA_K(0, 0); DMA_K(1, 1); DMA_V(0, 0); DMA_K(2, 2); DMA_V(1, 1); DMA_K(3, 3); DMA_V(2, 2);
        bf16x8 qf[6];
#pragma unroll
        for (int d0 = 0; d0 < 6; ++d0) qf[d0] = *(const bf16x8*)(Q + qrow * 768 + h * 96 + d0 * 16 + hi * 8);
        asm volatile("s_waitcnt vmcnt(0) lgkmcnt(0)\n\ts_barrier" ::: "memory");
        f32x16 pc0 = {}, pc1 = {};
#pragma unroll
        for (int d0 = 0; d0 < 6; ++d0) {
            const bf16x8 a0 = *(const LAS bf16x8*)(lds + kro + d0 * 32), a1 = *(const LAS bf16x8*)(lds + kro + 32 * 208 + d0 * 32);
            pc0 = __builtin_amdgcn_mfma_f32_32x32x16_bf16(a0, qf[d0], pc0, 0, 0, 0); pc1 = __builtin_amdgcn_mfma_f32_32x32x16_bf16(a1, qf[d0], pc1, 0, 0, 0);
        }
        float m = attn_rowmax(pc0, pc1), lsum = 0.f;
#pragma unroll
        for (int r = 0; r < 16; ++r) { pc0[r] -= m; pc1[r] -= m; }
        f32x16 o0 = {}, o1 = {};
        f32x2 rs2 = (f32x2){0.f, 0.f};
        f32x16 negm;
#pragma unroll
        for (int r = 0; r < 16; ++r) negm[r] = -m;
        asm volatile("" : "+v"(negm));
        asm volatile("s_waitcnt lgkmcnt(0)\n\ts_barrier" ::: "memory");
#define ATT_ITER(PC0, PC1, PN0, PN1, T) do { \
            { const int tk_ = ((T) + 4 < NT) ? (T) + 4 : NT - 1, tv_ = ((T) + 3 < NT) ? (T) + 3 : NT - 1; DMA_K(tk_, (T) & 3); DMA_V(tv_, ((T) + 3) & 3); } \
            const LAS unsigned char* kn = lds + (((T) + 1) & 3) * KSLOT + kro; \
            bf16x8 kfa[6], kfb[6]; \
            _Pragma("unroll") for (int d0 = 0; d0 < 3; ++d0) { kfa[2 * d0] = *(const LAS bf16x8*)(kn + d0 * 32); kfa[2 * d0 + 1] = *(const LAS bf16x8*)(kn + 32 * 208 + d0 * 32); } \
            SBAR(); \
            PN0 = __builtin_amdgcn_mfma_f32_32x32x16_bf16(kfa[0], qf[0], negm, 0, 0, 0); EXP2(PC0, 0); SBAR(); \
            _Pragma("unroll") for (int d0 = 3; d0 < 6; ++d0) { kfb[2 * (d0 - 3)] = *(const LAS bf16x8*)(kn + d0 * 32); kfb[2 * (d0 - 3) + 1] = *(const LAS bf16x8*)(kn + 32 * 208 + d0 * 32); } \
            SBAR(); \
            PN1 = __builtin_amdgcn_mfma_f32_32x32x16_bf16(kfa[1], qf[0], negm, 0, 0, 0); EXP2(PC0, 2); SBAR(); \
            PN0 = __builtin_amdgcn_mfma_f32_32x32x16_bf16(kfa[2], qf[1], PN0, 0, 0, 0); EXP2(PC0, 4); EXP2(PC0, 6); SBAR(); \
            PN1 = __builtin_amdgcn_mfma_f32_32x32x16_bf16(kfa[3], qf[1], PN1, 0, 0, 0); EXP2(PC0, 8); SBAR(); \
            PN0 = __builtin_amdgcn_mfma_f32_32x32x16_bf16(kfa[4], qf[2], PN0, 0, 0, 0); EXP2(PC0, 10); EXP2(PC0, 12); SBAR(); \
            PN1 = __builtin_amdgcn_mfma_f32_32x32x16_bf16(kfa[5], qf[2], PN1, 0, 0, 0); EXP2(PC0, 14); SBAR(); \
            const LAS unsigned char* vb = lds + ((T) & 3) * VSLOT; \
            bf16x8 va[8]; \
            _Pragma("unroll") for (int s = 0; s < 4; ++s) { va[2 * s] = *(const LAS bf16x8*)(vb + vro[s]); va[2 * s + 1] = *(const LAS bf16x8*)(vb + vro[s] + 32 * 128); } \
            SBAR(); \
            PN0 = __builtin_amdgcn_mfma_f32_32x32x16_bf16(kfb[0], qf[3], PN0, 0, 0, 0); EXP2(PC1, 0); EXP2(PC1, 2); SBAR(); \
            PN1 = __builtin_amdgcn_mfma_f32_32x32x16_bf16(kfb[1], qf[3], PN1, 0, 0, 0); EXP2(PC1, 4); SBAR(); \
            PN0 = __builtin_amdgcn_mfma_f32_32x32x16_bf16(kfb[2], qf[4], PN0, 0, 0, 0); EXP2(PC1, 6); EXP2(PC1, 8); SBAR(); \
            PN1 = __builtin_amdgcn_mfma_f32_32x32x16_bf16(kfb[3], qf[4], PN1, 0, 0, 0); EXP2(PC1, 10); SBAR(); \
            PN0 = __builtin_amdgcn_mfma_f32_32x32x16_bf16(kfb[4], qf[5], PN0, 0, 0, 0); EXP2(PC1, 12); SBAR(); \
            PN1 = __builtin_amdgcn_mfma_f32_32x32x16_bf16(kfb[5], qf[5], PN1, 0, 0, 0); EXP2(PC1, 14); SBAR(); \
            { const bf16x8 pb0 = PKP(PC0, 0); \
              o0 = __builtin_amdgcn_mfma_f32_32x32x16_bf16(va[0], pb0, o0, 0, 0, 0); o1 = __builtin_amdgcn_mfma_f32_32x32x16_bf16(va[1], pb0, o1, 0, 0, 0); \
              const bf16x8 pb1 = PKP(PC0, 8); \
              o0 = __builtin_amdgcn_mfma_f32_32x32x16_bf16(va[2], pb1, o0, 0, 0, 0); o1 = __builtin_amdgcn_mfma_f32_32x32x16_bf16(va[3], pb1, o1, 0, 0, 0); \
              const bf16x8 pb2 = PKP(PC1, 0); \
              o0 = __builtin_amdgcn_mfma_f32_32x32x16_bf16(va[4], pb2, o0, 0, 0, 0); o1 = __builtin_amdgcn_mfma_f32_32x32x16_bf16(va[5], pb2, o1, 0, 0, 0); \
              const bf16x8 pb3 = PKP(PC1, 8); \
              o0 = __builtin_amdgcn_mfma_f32_32x32x16_bf16(va[6], pb3, o0, 0, 0, 0); o1 = __builtin_amdgcn_mfma_f32_32x32x16_bf16(va[7], pb3, o1, 0, 0, 0); } \
            if (k2) asm volatile("s_waitcnt vmcnt(6) lgkmcnt(0)\n\ts_barrier" ::: "memory"); \
            else asm volatile("s_waitcnt vmcnt(4) lgkmcnt(0)\n\ts_barrier" ::: "memory"); \
        } while (0)
        f32x16 pd0, pd1;
        static_assert(NT % 2 == 0, "two tiles per loop trip");
        for (int t = 0; t < NT; t += 2) {
            ATT_ITER(pc0, pc1, pd0, pd1, t);
            ATT_ITER(pd0, pd1, pc0, pc1, t + 1);
        }
#undef ATT_ITER
        lsum += rs2.x + rs2.y;
        const float lt = lsum + __shfl_xor(lsum, 32); const float il = 1.0f / lt;
        bf16_t* op = MIX + qrow * 1024 + h * 64 + 4 * hi;
#pragma unroll
        for (int g = 0; g < 4; ++g) {
            u32x2 w0, w1; w0.x = cvt_pk_bf16(o0[4 * g] * il, o0[4 * g + 1] * il); w0.y = cvt_pk_bf16(o0[4 * g + 2] * il, o0[4 * g + 3] * il);
            w1.x = cvt_pk_bf16(o1[4 * g] * il, o1[4 * g + 1] * il); w1.y = cvt_pk_bf16(o1[4 * g + 2] * il, o1[4 * g + 3] * il);
            *(u32x2*)(op + 8 * g) = w0; *(u32x2*)(op + 32 + 8 * g) = w1;
        }
        asm volatile("s_waitcnt vmcnt(0) lgkmcnt(0)\n\ts_barrier" ::: "memory");
    }
#undef DMA_K
#undef DMA_V
#undef SBAR
#undef EXP2
#undef PKP
}

__global__ void __launch_bounds__(NTHR, 2) fwd_kernel(Args a) {
    extern __shared__ __attribute__((aligned(16))) unsigned char lds_raw[];
    LAS unsigned char* lds = (LAS unsigned char*)lds_raw;
    cg::grid_group grid = cg::this_grid();
    unsigned* barw = (unsigned*)a.ws;
    volatile LAS unsigned* bst = (volatile LAS unsigned*)(lds_raw + 131072 + 64);
    if (threadIdx.x < 2) bst[threadIdx.x] = 0u;
    __syncthreads();
    XcdBarrier xbar = xcd_barrier_post(barw, bst);
    if (a.out == nullptr) grid.sync();
#define GSYNC() do { for (int s_ = 0; s_ < PROBE_SYNC; ++s_) xcd_barrier(xbar); } while (0)
    const int tid = threadIdx.x, lane = tid & 63, wave = __builtin_amdgcn_readfirstlane(tid >> 6);
    const int G = gridDim.x, cu = blockIdx.x;
    unsigned char* ws = a.ws;
    const float* mod = (const float*)(ws + WS_MOD);
    bf16_t* XN = (bf16_t*)(ws + WS_A);
    bf16_t* XB = (bf16_t*)(ws + WS_XB);

    p0_prologue(a, lds, tid, lane, wave);
    GSYNC();
    norm_pass(a.in[0], ML, XN, a.in[6], mod, 0, -1, lane, wave);
    norm_pass(a.in[2], MC, XN + (size_t)ML * 1024, a.in[6], mod, 0, 2, lane, wave);
    GSYNC();
    { pg8::ProbStd p = pg8::make_std(XN, 1024, ws + WS_WIN, 1024, 1024); pg8::StaticOrder S; S.init(MT, NINP, G, cu);
      pg8::EpiBf16 E{(bf16_t*)(ws + WS_B), PLD, NIN}; pg8::gemm_phase<pg8::EpiBf16, pg8::ProbStd, true>(lds, p, S, E); }
    { pg8::ProbWc p{(const char*)(ws + WS_WF), (const char*)(ws + WS_D256), 256, 1024 * 2, 256 * 2, (size_t)128 * 1024 * 2, (size_t)128 * 256 * 2};
      pg8::StaticOrder S; S.init(2048, 1024, G, (cu + 32) & 255);
      pg8::EpiBf16 E{(bf16_t*)(ws + WS_WC), 1024, 1 << 30}; pg8::gemm_phase<pg8::EpiBf16, pg8::ProbWc, true>(lds, p, S, E); }
    GSYNC();
    { pg8::ProbStd p = pg8::make_std(ws + WS_B, PLD, ws + WS_WUQ, QR, QR); pg8::StaticOrder S; S.init(ML, 768, G, cu);
      pg8::EpiBf16 E{(bf16_t*)(ws + WS_Q), 768, 1 << 30}; pg8::gemm_phase<pg8::EpiBf16, pg8::ProbStd, true>(lds, p, S, E); }
    { pg8::ProbStd p = pg8::make_std(ws + WS_B + QR * 2, PLD, ws + WS_WUKV, KVR, KVR); pg8::StaticOrder S; S.init(MT, 1024, G, (cu + 64) & 255);
      pg8::EpiBf16 E{(bf16_t*)(ws + WS_KV), 1024, 1 << 30}; pg8::gemm_phase<pg8::EpiBf16, pg8::ProbStd, true>(lds, p, S, E); }
    GSYNC();
    prep2_pass(a, lds, tid, lane, wave);
    conv_pass(a, lane, wave);
    GSYNC();
    for (int p_ = 0; p_ < PROBE_ATTN; ++p_) attn_phase(a, lds, tid, lane, wave);
    GSYNC();
    { pg8::ProbStd p = pg8::make_std(ws + WS_A, 1024, ws + WS_WO, 1024, 1024); pg8::StaticOrder S; S.init(ML, 1024, G, cu);
      typedef pg8::EpiResid<float, bf16_t> EP; EP E{a.in[0], XB, mod + 2 * 1024, 6144}; pg8::gemm_phase<EP, pg8::ProbStd, true>(lds, p, S, E); }
    GSYNC();
#pragma unroll
    for (int layer = 0; layer < 2; ++layer) {
        const float* modl = mod + layer * 3 * 6144;
        if (layer == 1) {
            norm_pass_b(XB, ML, XN, a.in[6] + 1024, modl, 0, lane, wave);
            GSYNC();
            { pg8::ProbG1 p{(const char*)(ws + WS_WC), (const char*)XN, 1024, 1024 * 2, 64 * 2048, (size_t)128 * 1024 * 2, (size_t)2048};
              pg8::StaticOrder S; S.init(2048, 16384, G, cu);
              pg8::EpiG1 E{(bf16_t*)(ws + WS_Z1)}; pg8::gemm_phase<pg8::EpiG1, pg8::ProbG1, true>(lds, p, S, E); }
            GSYNC();
            { pg8::ProbStd p = pg8::make_std(ws + WS_W1D, 256, ws + WS_Z1, 256, 256); pg8::StaticOrder S; S.init(256, 131072, G, cu);
              pg8::EpiG2 E{(bf16_t*)(ws + WS_G2)}; pg8::gemm_phase<pg8::EpiG2, pg8::ProbStd, true>(lds, p, S, E); }
            GSYNC();
            { pg8::ProbG3 p{(const char*)(ws + WS_W2D), (const char*)(ws + WS_G2), 512, 512 * 2, 128 * 128 * 2, (size_t)128 * 512 * 2, (size_t)128 * 128 * 128 * 2};
              pg8::StaticOrder S; S.init(256, 65536, G, cu);
              pg8::EpiG3 E{XB, modl + 2 * 1024, 6144}; pg8::gemm_phase<pg8::EpiG3, pg8::ProbG3, true>(lds, p, S, E); }
            GSYNC();
        }
        norm_pass_b(XB, ML, XN, a.in[7] + layer * 1024, modl, 3, lane, wave);
        GSYNC();
        { pg8::ProbStd p = pg8::make_std(XN, 1024, ws + WS_W13 + layer * W13_BYTES, 1024, 1024); pg8::StaticOrder S; S.init(ML, 2 * DFF, G, cu);
          pg8::EpiSwiglu E{(bf16_t*)(ws + WS_H)}; for (int p_ = 0; p_ < PROBE_FFNUP; ++p_) pg8::gemm_phase<pg8::EpiSwiglu, pg8::ProbStd, true>(lds, p, S, E); }
        GSYNC();
        { pg8::ProbStd p = pg8::make_std(ws + WS_H, DFF, ws + WS_W2 + layer * W2_BYTES, DFF, DFF); pg8::StaticOrder S; S.init(ML, 1024, G, cu);
          if (layer == 0) { typedef pg8::EpiResid<bf16_t, bf16_t> EP; EP E{XB, XB, modl + 5 * 1024, 6144}; pg8::gemm_phase<EP, pg8::ProbStd, true>(lds, p, S, E); }
          else { typedef pg8::EpiResid<bf16_t, float> EP; EP E{XB, a.out, modl + 5 * 1024, 6144}; pg8::gemm_phase<EP, pg8::ProbStd, true>(lds, p, S, E); } }
        if (layer == 0) GSYNC();
    }
}

extern "C" void kernel_launch(void* const* d_in, const int* in_sizes, int n_in, void* d_out, int out_size, void* d_ws, size_t ws_size, hipStream_t stream) {
    static int grid = 0;
    if (grid == 0) {
        if (n_in != 21 || out_size != ML * DM || ws_size < WS_END) { fprintf(stderr, "kernel_launch: unexpected problem (n_in %d out %d ws %zu)\n", n_in, out_size, ws_size); grid = -1; return; }
        int dev = 0, cus = 0, per_cu = 0;
        (void)hipGetDevice(&dev);
        (void)hipDeviceGetAttribute(&cus, hipDeviceAttributeMultiprocessorCount, dev);
        (void)hipFuncSetAttribute((const void*)fwd_kernel, hipFuncAttributeMaxDynamicSharedMemorySize, LDS_BYTES);
        (void)hipOccupancyMaxActiveBlocksPerMultiprocessor(&per_cu, (const void*)fwd_kernel, NTHR, LDS_BYTES);
        (void)hipGetLastError();
        grid = 256;
        if (cus < 256 || per_cu < 1) fprintf(stderr, "kernel_launch: cus %d per_cu %d\n", cus, per_cu);
    }
    if (grid < 0) return;
    Args a{};
    for (int i = 0; i < 21; ++i) a.in[i] = (const float*)d_in[i];
    a.out = (float*)d_out; a.ws = (unsigned char*)d_ws;
    (void)hipMemsetAsync(d_ws, 0, 16384, stream);
    void* args[] = {&a};
    hipError_t e = hipLaunchCooperativeKernel((const void*)fwd_kernel, dim3(grid), dim3(NTHR), args, LDS_BYTES, stream);
    if (e != hipSuccess) fprintf(stderr, "cooperative launch failed: %s\n", hipGetErrorString(e));
}
```

```cpp
#include <hip/hip_runtime.h>
#include <hip/hip_cooperative_groups.h>
#include <cstdio>
#include <cstdint>
namespace cg = cooperative_groups;
#ifndef PROBE_SYNC
#define PROBE_SYNC 1
#endif
#ifndef PROBE_ATTN
#define PROBE_ATTN 1
#endif
#ifndef PROBE_FFNUP
#define PROBE_FFNUP 1
#endif

#define LAS __attribute__((address_space(3)))
typedef unsigned short bf16_t;
typedef short bf16x8 __attribute__((ext_vector_type(8)));
typedef short s16x4 __attribute__((ext_vector_type(4)));
typedef float f32x4 __attribute__((ext_vector_type(4)));
typedef float f32x16 __attribute__((ext_vector_type(16)));
typedef unsigned u32x4 __attribute__((ext_vector_type(4)));
typedef unsigned u32x2 __attribute__((ext_vector_type(2)));
typedef float f32x2 __attribute__((ext_vector_type(2)));

constexpr int DM = 1024, SEQ = 8192, ML = 16384, MC = 512, MT = ML + MC;
constexpr int NINP = 2304, NIN = 2208, QR = 384, KVR = 256, NH = 8, DQK = 96, DFF = 2816, NKEY = 8448;
constexpr float EPS = 1e-6f;
constexpr float QSC = 0.10206207261596575f * 1.4426950408889634f;

constexpr size_t MiB = 1u << 20;
constexpr size_t WS_MOD = 1 * MiB;
constexpr size_t WS_WIN = 2 * MiB;
constexpr size_t WS_WUQ = WS_WIN + (size_t)NINP * 1024 * 2;
constexpr size_t WS_WUKV = WS_WUQ + (size_t)768 * 384 * 2;
constexpr size_t WS_WO = WS_WUKV + (size_t)1024 * 256 * 2;
constexpr size_t WS_WF = WS_WO + 2 * MiB;
constexpr size_t WS_WC = WS_WF + 2 * MiB;
constexpr size_t WS_D256 = WS_WC + 4 * MiB;
constexpr size_t WS_W1D = WS_D256 + 262144;
constexpr size_t WS_W2D = WS_W1D + 131072;
constexpr size_t WS_W13 = WS_W2D + 262144;
constexpr size_t W13_BYTES = (size_t)2 * DFF * 1024 * 2;
constexpr size_t WS_W2 = WS_W13 + 2 * W13_BYTES;
constexpr size_t W2_BYTES = (size_t)1024 * DFF * 2;
constexpr size_t WS_WEND = WS_W2 + 2 * W2_BYTES;
static_assert(WS_WEND <= 52 * MiB, "weights");
constexpr size_t WS_A = 52 * MiB;
constexpr int PLD = 2208;
constexpr size_t WS_B = 85 * MiB;
constexpr size_t WS_Q = 157 * MiB;
constexpr size_t WS_KV = 181 * MiB;
constexpr size_t WS_KF = 214 * MiB;
constexpr size_t WS_VT = 239 * MiB;
constexpr size_t WS_H = WS_B;
constexpr size_t WS_Z1 = WS_B;
constexpr size_t WS_G2 = WS_B + 64 * MiB;
constexpr size_t WS_XB = 218 * MiB;
constexpr size_t WS_END = 256 * MiB;

__device__ __forceinline__ unsigned f2bf(float f) { unsigned u = __builtin_bit_cast(unsigned, f); return (u + 0x7fffu + ((u >> 16) & 1u)) >> 16; }
__device__ __forceinline__ unsigned pk2(float lo, float hi) { return f2bf(lo) | (f2bf(hi) << 16); }
__device__ __forceinline__ float bflo(unsigned w) { return __builtin_bit_cast(float, w << 16); }
__device__ __forceinline__ float bfhi(unsigned w) { return __builtin_bit_cast(float, w & 0xffff0000u); }
__device__ __forceinline__ float bf1(bf16_t h) { return __builtin_bit_cast(float, (unsigned)h << 16); }
__device__ __forceinline__ unsigned cvt_pk_bf16(float lo, float hi) { unsigned r; asm volatile("v_cvt_pk_bf16_f32 %0, %1, %2" : "=v"(r) : "v"(lo), "v"(hi)); return r; }
__device__ __forceinline__ float wave_sum(float v) {
#pragma unroll
    for (int o = 1; o < 64; o <<= 1) v += __shfl_xor(v, o);
    return v;
}
__device__ __forceinline__ float sin_rev(float r) { return __builtin_amdgcn_sinf(r); }
__device__ __forceinline__ float cos_rev(float r) { return __builtin_amdgcn_cosf(r); }
__device__ __forceinline__ float silu_f(float x) { return x * __builtin_amdgcn_rcpf(1.0f + __builtin_amdgcn_exp2f(-1.4426950408889634f * x)); }
#define LDS_WAIT() asm volatile("s_waitcnt lgkmcnt(0)" ::: "memory")

namespace pg8 {
constexpr int BM = 256, BK = 64, HALF = 128, HTB = HALF * BK * 2, STAGE_BYTES = 8 * HTB, NXCD = 8, WGM = 2;
__host__ __device__ __forceinline__ int lds_byte(int r, int c) { const int st = (r >> 4) * 2 + (c >> 5), rr = r & 15, cc = c & 31, ob = rr * 64 + cc * 2; return st * 1024 + (ob ^ (((ob >> 9) & 1) << 5)); }
__host__ __device__ __forceinline__ void stage_rc(int b, int& R, int& C) { const int st = b / 1024, sb = b % 1024, swz = sb ^ (((sb >> 9) & 1) << 5); R = (st >> 1) * 16 + swz / 64; C = (st & 1) * 32 + (swz % 64) / 2; }
__host__ __device__ __forceinline__ int perm32(int rho) { const int n = rho >> 4, i = rho & 15; return 8 * (i >> 2) + 4 * n + (i & 3); }

__device__ __forceinline__ void glds16s(const char* sbase, unsigned voff, unsigned lds_dst) { unsigned keep;
    asm volatile("s_mov_b32 %0, m0\n\ts_mov_b32 m0, %3\n\ts_nop 0\n\tglobal_load_lds_dwordx4 %1, %2\n\ts_mov_b32 m0, %0" : "=&s"(keep) : "v"(voff), "s"(sbase), "s"(lds_dst) : "memory"); }
struct Unit { int pm, pn; };
struct StaticOrder {
    int nM, nN, nwg, G, c;
    __device__ void init(int M, int N, int G_, int c_) { nM = M / BM; nN = N / BM; nwg = nM * nN; G = G_; c = c_; }
    __device__ bool next(int i, Unit& u) const {
        const long L = (long)i * G + c; if (L >= nwg) return false;
        int wgid = (int)L; { const int q = nwg / NXCD, r = nwg % NXCD, xcd = wgid % NXCD, off = wgid / NXCD; wgid = (xcd < r ? xcd * (q + 1) : r * (q + 1) + (xcd - r) * q) + off; }
        const int nig = WGM * nN, gid = wgid / nig, fm = gid * WGM, gsz = (nM - fm) < WGM ? (nM - fm) : WGM;
        u.pm = fm + ((wgid % nig) % gsz); u.pn = (wgid % nig) / gsz; return true;
    }
};
struct ProbStd {
    const char* A; const char* B; int K; unsigned rsA, rsB; size_t hsA, hsB, tsA, tsB;
    __device__ __forceinline__ const char* a_base(const Unit& u) const { return A + (size_t)u.pm * tsA; }
    __device__ __forceinline__ const char* b_base(const Unit& u) const { return B + (size_t)u.pn * tsB; }
};
__device__ __forceinline__ ProbStd make_std(const void* A, int lda, const void* B, int ldb, int K) {
    ProbStd p; p.A = (const char*)A; p.B = (const char*)B; p.K = K; p.rsA = lda * 2; p.rsB = ldb * 2;
    p.hsA = (size_t)128 * lda * 2; p.hsB = (size_t)128 * ldb * 2; p.tsA = 2 * p.hsA; p.tsB = 2 * p.hsB; return p;
}

template <class Epi, class Prob, bool ALIGN_EPI>
__device__ __forceinline__ void gemm_phase(LAS unsigned char* lds, const Prob& P, const StaticOrder& S, const Epi& E) {
    int tid = threadIdx.x; asm volatile("" : "+v"(tid));
    const int wid = __builtin_amdgcn_readfirstlane(tid >> 6), lane = tid & 63, wr = wid >> 2, wc = wid & 3, fr = lane & 15, fq = lane >> 4;
    const int nt = P.K / BK;
    unsigned voffA[2], voffB[2];
#pragma unroll
    for (int i = 0; i < 2; ++i) { int R, C; stage_rc(tid * 16 + i * 8192, R, C); const int Rb = (R & ~31) + perm32(R & 31);
        voffA[i] = (unsigned)R * P.rsA + (unsigned)C * 2u; voffB[i] = (unsigned)Rb * P.rsB + (unsigned)C * 2u; }
    const size_t kstep = (size_t)(BK * 2);
    const size_t hstepA = P.hsA, hstepB = P.hsB;
    const unsigned ldsw = (unsigned)wid * 1024u;
    const unsigned lds0 = (unsigned)(size_t)lds;
    const int aoff = lds_byte(wr * 64 + fr, fq * 8), boff = lds_byte(wc * 32 + fr, fq * 8);
#define PG8_SA(b, h) (((b) * 2 + (h)) * HTB)
#define PG8_SB(b, h) ((4 + (b) * 2 + (h)) * HTB)
#define PG8_STAGE(bufoff, gbase, voff) do { _Pragma("unroll") for (int _i = 0; _i < 2; ++_i) \
        glds16s((gbase), (voff)[_i], lds0 + (unsigned)(bufoff) + ldsw + _i * 8192u); } while (0)
#define PG8_LDA(dst, b, h) do { _Pragma("unroll") for (int m = 0; m < 4; ++m) _Pragma("unroll") for (int k = 0; k < 2; ++k) dst[m][k] = *(const LAS bf16x8*)(lds + PG8_SA(b, h) + aoff + m * 2048 + k * 1024); } while (0)
#define PG8_LDB(dst, b, h) do { _Pragma("unroll") for (int n = 0; n < 2; ++n) _Pragma("unroll") for (int k = 0; k < 2; ++k) dst[n][k] = *(const LAS bf16x8*)(lds + PG8_SB(b, h) + boff + n * 2048 + k * 1024); } while (0)
#define PG8_MMA(ai, bj, At, Bt) do { __builtin_amdgcn_s_setprio(1); _Pragma("unroll") for (int m = 0; m < 4; ++m) _Pragma("unroll") for (int n = 0; n < 2; ++n) _Pragma("unroll") for (int k = 0; k < 2; ++k) \
        acc[ai][bj][m][n] = __builtin_amdgcn_mfma_f32_16x16x32_bf16(Bt[n][k], At[m][k], acc[ai][bj][m][n], 0, 0, 0); __builtin_amdgcn_s_setprio(0); } while (0)
#define PG8_WAIT_V(n) asm volatile("s_waitcnt vmcnt(" #n ")" ::: "memory")
#define PG8_WAIT_L(n) asm volatile("s_waitcnt lgkmcnt(" #n ")" ::: "memory")
#define PG8_BAR __builtin_amdgcn_s_barrier()
#define PG8_SCHED __builtin_amdgcn_sched_barrier(0)
    Unit cur, nxt; int ui = 0;
    if (!S.next(0, cur)) return;
    f32x4 acc[2][2][4][2];
#pragma unroll
    for (int a = 0; a < 2; ++a)
#pragma unroll
        for (int b = 0; b < 2; ++b)
#pragma unroll
            for (int m = 0; m < 4; ++m)
#pragma unroll
                for (int n = 0; n < 2; ++n) acc[a][b][m][n] = (f32x4){0.f, 0.f, 0.f, 0.f};
    bf16x8 At[4][2], B0[2][2], B1[2][2];
    const char* cA = P.a_base(cur); const char* cB = P.b_base(cur);
    PG8_STAGE(PG8_SB(0, 0), cB, voffB); PG8_STAGE(PG8_SB(0, 1), cB + hstepB, voffB); PG8_STAGE(PG8_SA(0, 0), cA, voffA); PG8_STAGE(PG8_SA(0, 1), cA + hstepA, voffA);
    if (wr == 1) PG8_BAR;
    PG8_WAIT_V(2); PG8_BAR;
    PG8_STAGE(PG8_SB(1, 0), cB + kstep, voffB); PG8_STAGE(PG8_SA(1, 0), cA + kstep, voffA); PG8_STAGE(PG8_SB(1, 1), cB + hstepB + kstep, voffB);
    PG8_WAIT_V(6); PG8_BAR;
    for (;;) {
        const bool has_next = S.next(ui + 1, nxt);
        const char* nA = has_next ? P.a_base(nxt) : cA; const char* nB = has_next ? P.b_base(nxt) : cB;
        for (int t = 0; t < nt; t += 2) {
            const bool last = (t == nt - 2);
            const char* a1 = cA + (size_t)(t + 1) * kstep;
            const char* a2 = last ? nA : cA + (size_t)(t + 2) * kstep; const char* b2 = last ? nB : cB + (size_t)(t + 2) * kstep;
            const char* a3 = a2 + kstep; const char* b3 = b2 + kstep;
            PG8_LDB(B0, 0, 0); PG8_LDB(B1, 0, 1); PG8_SCHED; PG8_LDA(At, 0, 0); PG8_STAGE(PG8_SA(1, 1), a1 + hstepA, voffA);
            PG8_WAIT_V(8); PG8_WAIT_L(0); PG8_BAR; PG8_MMA(0, 0, At, B0); PG8_MMA(0, 1, At, B1); PG8_BAR; PG8_SCHED;
            PG8_LDA(At, 0, 1); PG8_STAGE(PG8_SB(0, 0), b2, voffB); PG8_STAGE(PG8_SB(0, 1), b2 + hstepB, voffB); PG8_STAGE(PG8_SA(0, 0), a2, voffA);
            PG8_WAIT_V(8); PG8_WAIT_L(0); PG8_BAR; PG8_MMA(1, 0, At, B0); PG8_MMA(1, 1, At, B1); PG8_BAR; PG8_SCHED;
            PG8_LDB(B0, 1, 0); PG8_LDB(B1, 1, 1); PG8_SCHED; PG8_LDA(At, 1, 0); PG8_STAGE(PG8_SA(0, 1), a2 + hstepA, voffA);
            PG8_WAIT_V(8); PG8_WAIT_L(0); PG8_BAR; PG8_MMA(0, 0, At, B0); PG8_MMA(0, 1, At, B1); PG8_BAR; PG8_SCHED;
            PG8_LDA(At, 1, 1); PG8_STAGE(PG8_SB(1, 0), b3, voffB); PG8_STAGE(PG8_SB(1, 1), b3 + hstepB, voffB); PG8_STAGE(PG8_SA(1, 0), a3, voffA);
            PG8_WAIT_V(8); PG8_WAIT_L(0); PG8_BAR; PG8_MMA(1, 0, At, B0); PG8_MMA(1, 1, At, B1); PG8_BAR; PG8_SCHED;
        }
        if constexpr (ALIGN_EPI) { if (wr == 0) PG8_BAR; }
        { int fr_ = fr, fq_ = fq; asm volatile("" : "+v"(fr_), "+v"(fq_)); E(acc, cur, wr, wc, fr_, fq_); }
        if (!has_next) break;
#pragma unroll
        for (int a = 0; a < 2; ++a)
#pragma unroll
            for (int b = 0; b < 2; ++b)
#pragma unroll
                for (int m = 0; m < 4; ++m)
#pragma unroll
                    for (int n = 0; n < 2; ++n) acc[a][b][m][n] = (f32x4){0.f, 0.f, 0.f, 0.f};
        cur = nxt; cA = nA; cB = nB; ++ui;
        if constexpr (ALIGN_EPI) { if (wr == 1) PG8_BAR; }
    }
    PG8_WAIT_V(0);
    if constexpr (!ALIGN_EPI) { if (wr == 0) PG8_BAR; }
    PG8_BAR;
#undef PG8_SA
#undef PG8_SB
#undef PG8_STAGE
#undef PG8_LDA
#undef PG8_LDB
#undef PG8_MMA
#undef PG8_WAIT_V
#undef PG8_WAIT_L
#undef PG8_BAR
#undef PG8_SCHED
}

typedef f32x4 Acc[2][2][4][2];
struct EpiBf16 {
    bf16_t* O; int ldc; int ncols;
    __device__ __forceinline__ void operator()(const Acc& acc, const Unit& u, int wr, int wc, int fr, int fq) const {
        const int row0 = u.pm * BM + wr * 64 + fr, col0 = u.pn * BM + wc * 32 + 8 * fq;
#pragma unroll
        for (int ai = 0; ai < 2; ++ai)
#pragma unroll
            for (int m = 0; m < 4; ++m) { bf16_t* rowp = O + (size_t)(row0 + ai * HALF + m * 16) * ldc + col0;
#pragma unroll
                for (int bj = 0; bj < 2; ++bj) { const f32x4 v0 = acc[ai][bj][m][0], v1 = acc[ai][bj][m][1];
                    u32x4 w; w.x = cvt_pk_bf16(v0[0], v0[1]); w.y = cvt_pk_bf16(v0[2], v0[3]); w.z = cvt_pk_bf16(v1[0], v1[1]); w.w = cvt_pk_bf16(v1[2], v1[3]);
                    if (col0 + bj * HALF < ncols) *(u32x4*)(rowp + bj * HALF) = w; } }
    }
};
__device__ __forceinline__ void ld8(const float* p, f32x4& a, f32x4& b) { a = __builtin_nontemporal_load((const f32x4*)p); b = __builtin_nontemporal_load((const f32x4*)(p + 4)); }
__device__ __forceinline__ void ld8(const bf16_t* p, f32x4& a, f32x4& b) { const u32x4 w = __builtin_nontemporal_load((const u32x4*)p); a = (f32x4){bflo(w.x), bfhi(w.x), bflo(w.y), bfhi(w.y)}; b = (f32x4){bflo(w.z), bfhi(w.z), bflo(w.w), bfhi(w.w)}; }
__device__ __forceinline__ void st8(float* p, const f32x4& a, const f32x4& b) { *(f32x4*)p = a; *(f32x4*)(p + 4) = b; }
__device__ __forceinline__ void st8(bf16_t* p, const f32x4& a, const f32x4& b) { u32x4 w; w.x = cvt_pk_bf16(a[0], a[1]); w.y = cvt_pk_bf16(a[2], a[3]); w.z = cvt_pk_bf16(b[0], b[1]); w.w = cvt_pk_bf16(b[2], b[3]); *(u32x4*)p = w; }
template <class TR, class TO> struct EpiResid {
    const TR* res; TO* out; const float* gate0; int gstride;
    __device__ __forceinline__ void operator()(const Acc& acc, const Unit& u, int wr, int wc, int fr, int fq) const {
        const int row0 = u.pm * BM + wr * 64 + fr, col0 = u.pn * BM + wc * 32 + 8 * fq;
        const float* gp = gate0 + (size_t)(u.pm >> 5) * gstride + col0;
        f32x4 g[2][2];
#pragma unroll
        for (int bj = 0; bj < 2; ++bj)
#pragma unroll
            for (int n = 0; n < 2; ++n) g[bj][n] = *(const f32x4*)(gp + bj * HALF + 4 * n);
#pragma unroll
        for (int ai = 0; ai < 2; ++ai)
#pragma unroll
            for (int m = 0; m < 4; ++m) { const size_t off = (size_t)(row0 + ai * HALF + m * 16) * 1024 + col0;
#pragma unroll
                for (int bj = 0; bj < 2; ++bj) { f32x4 r0, r1; ld8(res + off + bj * HALF, r0, r1);
                    st8(out + off + bj * HALF, r0 + g[bj][0] * acc[ai][bj][m][0], r1 + g[bj][1] * acc[ai][bj][m][1]); } }
    }
};
struct EpiSwiglu {
    bf16_t* H;
    __device__ __forceinline__ void operator()(const Acc& acc, const Unit& u, int wr, int wc, int fr, int fq) const {
        const int row0 = u.pm * BM + wr * 64 + fr, col0 = u.pn * HALF + wc * 32 + 8 * fq;
#pragma unroll
        for (int ai = 0; ai < 2; ++ai)
#pragma unroll
            for (int m = 0; m < 4; ++m) { bf16_t* rowp = H + (size_t)(row0 + ai * HALF + m * 16) * DFF + col0;
                f32x4 h0, h1;
#pragma unroll
                for (int j = 0; j < 4; ++j) { h0[j] = silu_f(acc[ai][0][m][0][j]) * acc[ai][1][m][0][j]; h1[j] = silu_f(acc[ai][0][m][1][j]) * acc[ai][1][m][1][j]; }
                u32x4 w; w.x = cvt_pk_bf16(h0[0], h0[1]); w.y = cvt_pk_bf16(h0[2], h0[3]); w.z = cvt_pk_bf16(h1[0], h1[1]); w.w = cvt_pk_bf16(h1[2], h1[3]);
                *(u32x4*)rowp = w; }
    }
};
struct EpiG1 {
    bf16_t* Z1;
    __device__ __forceinline__ void operator()(const Acc& acc, const Unit& u, int wr, int wc, int fr, int fq) const {
        const unsigned b = u.pn >> 5, q = u.pn & 31, ns0 = wc * 32 + 8 * fq;
        const unsigned j0 = u.pm * BM + wr * 64 + fr;
        const unsigned cs = j0 >> 10;
        bf16_t* base = Z1 + ((size_t)(b * 1024u) * 64u * 256u + (size_t)(2u * q) * 256u + cs * 128u + ns0);
#pragma unroll
        for (int ai = 0; ai < 2; ++ai)
#pragma unroll
            for (int m = 0; m < 4; ++m) { const unsigned ch = (j0 + ai * HALF + m * 16) & 1023u; bf16_t* rp = base + (size_t)ch * (64u * 256u);
#pragma unroll
                for (int bj = 0; bj < 2; ++bj) { const f32x4 v0 = acc[ai][bj][m][0], v1 = acc[ai][bj][m][1];
                    u32x4 w; w.x = cvt_pk_bf16(v0[0], v0[1]); w.y = cvt_pk_bf16(v0[2], v0[3]); w.z = cvt_pk_bf16(v1[0], v1[1]); w.w = cvt_pk_bf16(v1[2], v1[3]);
                    *(u32x4*)(rp + bj * 256) = w; }
                asm volatile("" ::: "memory"); }
    }
};
struct EpiG2 {
    bf16_t* G2;
    __device__ __forceinline__ void operator()(const Acc& acc, const Unit& u, int wr, int wc, int fr, int fq) const {
        const unsigned rho00 = u.pn * BM + wc * 32 + 8 * fq;
#pragma unroll
        for (int m = 0; m < 4; ++m) { const unsigned ka = wr * 64 + m * 16 + fr; const float kaf = (float)ka * (1.0f / 8192.0f);
#pragma unroll
            for (int bj = 0; bj < 2; ++bj) { const unsigned rho0 = rho00 + bj * HALF, bc = rho0 >> 6, nf0 = rho0 & 63u;
                bf16_t* dp = G2 + ((size_t)(bc * 128u + ka) * 128u + nf0);
                f32x4 o_r[2], o_i[2];
#pragma unroll
                for (int n = 0; n < 2; ++n) { const f32x4 gr = acc[0][bj][m][n], gi = acc[1][bj][m][n];
#pragma unroll
                    for (int j = 0; j < 4; ++j) { const float rev = (float)(nf0 + 4 * n + j) * kaf; const float c = cos_rev(rev), s = sin_rev(rev);
                        o_r[n][j] = gr[j] * c + gi[j] * s; o_i[n][j] = gi[j] * c - gr[j] * s; } }
                st8(dp, o_r[0], o_r[1]); st8(dp + 64, o_i[0], o_i[1]);
                asm volatile("" ::: "memory"); } }
    }
};
struct EpiG3 {
    bf16_t* out; const float* gate0; int gstride;
    __device__ __forceinline__ void operator()(const Acc& acc, const Unit& u, int wr, int wc, int fr, int fq) const {
        const int chblk = u.pn & 3, kag = (u.pn >> 2) & 31, b = u.pn >> 7, ch0 = chblk * 256 + wc * 32 + 8 * fq;
        const float* gp = gate0 + (size_t)b * gstride + ch0;
        f32x4 g[2][2];
#pragma unroll
        for (int bj = 0; bj < 2; ++bj)
#pragma unroll
            for (int n = 0; n < 2; ++n) g[bj][n] = *(const f32x4*)(gp + bj * HALF + 4 * n);
#pragma unroll
        for (int ai = 0; ai < 2; ++ai)
#pragma unroll
            for (int m = 0; m < 4; ++m) { const int r = ai * HALF + wr * 64 + m * 16 + fr, s = r >> 6, kb = r & 63;
                const size_t off = ((size_t)b * 8192 + 4 * kag + s + 128 * kb) * 1024 + ch0;
#pragma unroll
                for (int bj = 0; bj < 2; ++bj) { f32x4 r0, r1; ld8(out + off + bj * HALF, r0, r1);
                    st8(out + off + bj * HALF, r0 + g[bj][0] * acc[ai][bj][m][0], r1 + g[bj][1] * acc[ai][bj][m][1]); } }
    }
};
struct ProbWc {
    const char* WfT; const char* D; int K; unsigned rsA, rsB; size_t hsA, hsB;
    __device__ __forceinline__ const char* a_base(const Unit& u) const { return WfT + ((size_t)(u.pm & 3) * 256 * 1024 + (size_t)u.pn * 256) * 2; }
    __device__ __forceinline__ const char* b_base(const Unit& u) const { return D + (size_t)(u.pm >> 2) * 256 * 256 * 2; }
};
struct ProbG1 {
    const char* WcT; const char* XN; int K; unsigned rsA, rsB; size_t hsA, hsB;
    __device__ __forceinline__ const char* a_base(const Unit& u) const { return WcT + (size_t)u.pm * 256 * 1024 * 2; }
    __device__ __forceinline__ const char* b_base(const Unit& u) const { return XN + ((size_t)(u.pn >> 5) * 8192 + 2 * (u.pn & 31)) * 2048; }
};
struct ProbG3 {
    const char* W2d; const char* G2; int K; unsigned rsA, rsB; size_t hsA, hsB;
    __device__ __forceinline__ const char* a_base(const Unit&) const { return W2d; }
    __device__ __forceinline__ const char* b_base(const Unit& u) const { const int chblk = u.pn & 3, kag = (u.pn >> 2) & 31, b = u.pn >> 7;
        return G2 + (((size_t)(b * 1024 + chblk * 256) * 128 + 4 * kag) * 128) * 2; }
};
}

#define RLX_AGENT __ATOMIC_RELAXED, __HIP_MEMORY_SCOPE_AGENT
#define XB_TMO      128
#define XB_XCNT(j)  (256  + 64 * (j))
#define XB_XSUB(j)  (1280 + 64 * (j))
#define XB_XGEN(j)  (2304 + 64 * (j))
#define XB_TOP      3328
#define XB_TOPGEN   3392
#define XCD_BAR_WORDS 3456
#define XB_SPIN_CAP (1u << 18)

__device__ __forceinline__ unsigned xb_ld(unsigned* p)              { return __hip_atomic_load(p, __ATOMIC_RELAXED, __HIP_MEMORY_SCOPE_AGENT); }
__device__ __forceinline__ unsigned xb_add(unsigned* p, unsigned v) { return __hip_atomic_fetch_add(p, v, __ATOMIC_RELAXED, __HIP_MEMORY_SCOPE_AGENT); }
__device__ __forceinline__ unsigned xb_xcc_id() { return (unsigned)__builtin_amdgcn_s_getreg((3 << 11) | 20) & 0xFu; }
#define XB_SPIN(cond, bar) do { unsigned _sp = 0; while (cond) { __builtin_amdgcn_s_sleep(1); \
    if ((++_sp & 255u) == 0u) { if (xb_ld(&(bar)[XB_TMO])) break; if (_sp > XB_SPIN_CAP) { atomicAdd(&(bar)[XB_TMO], 1u); break; } } } } while (0)

struct XcdBarrier {
    unsigned* bar; unsigned x;
    volatile LAS unsigned* st;
};

__device__ __forceinline__ XcdBarrier xcd_barrier_post(unsigned* bar, volatile LAS unsigned* st) {
    XcdBarrier b; b.bar = bar; b.x = xb_xcc_id(); b.st = st;
    if (threadIdx.x == 0) (void)xb_add(&bar[XB_XCNT(b.x)], 1u);
    return b;
}
__device__ __forceinline__ void xcd_barrier_complete(unsigned* bar, unsigned x, unsigned& nloc, unsigned& nx) {
    const unsigned G = gridDim.x * gridDim.y * gridDim.z;
    unsigned sum, cnt, mine, sp = 0u;
    for (;;) {
        sum = 0u; cnt = 0u; mine = 0u;
#pragma unroll
        for (unsigned j = 0; j < 16; ++j) { const unsigned c = xb_ld(&bar[XB_XCNT(j)]); sum += c; cnt += (c > 0u) ? 1u : 0u; mine = (j == x) ? c : mine; }
        if (sum == G) break;
        __builtin_amdgcn_s_sleep(1);
        if ((++sp & 255u) == 0u) { if (xb_ld(&bar[XB_TMO])) break; if (sp > XB_SPIN_CAP) { atomicAdd(&bar[XB_TMO], 1u); break; } }
    }
    nloc = mine > 0u ? mine : 1u; nx = cnt > 0u ? cnt : 1u;
}

__device__ __forceinline__ void xcd_barrier(const XcdBarrier& b) {
    asm volatile("s_waitcnt vmcnt(0)" ::: "memory");
    __syncthreads();
    if (threadIdx.x == 0) {
        unsigned* bar = b.bar;
        __builtin_amdgcn_s_waitcnt(0);
        unsigned nloc = b.st[0], nx = b.st[1];
        if (nloc == 0u) { xcd_barrier_complete(bar, b.x, nloc, nx); b.st[0] = nloc; b.st[1] = nx; }
        const unsigned old = xb_add(&bar[XB_XSUB(b.x)], 1u);
        const unsigned gen = old / nloc;
        if (old + 1u == (gen + 1u) * nloc) {
            __builtin_amdgcn_fence(__ATOMIC_RELEASE, "agent");
            asm volatile("s_waitcnt vmcnt(0)" ::: "memory");
            const unsigned og = xb_add(&bar[XB_TOP], 1u);
            const unsigned tg = og / nx;
            if (og + 1u == (tg + 1u) * nx) xb_add(&bar[XB_TOPGEN], 1u);
            else XB_SPIN(xb_ld(&bar[XB_TOPGEN]) == tg, bar);
            __builtin_amdgcn_fence(__ATOMIC_ACQUIRE, "agent");
            xb_add(&bar[XB_XGEN(b.x)], 1u);
            asm volatile("s_waitcnt vmcnt(0)" ::: "memory");
        } else {
            XB_SPIN(xb_ld(&bar[XB_XGEN(b.x)]) == gen, bar);
            __builtin_amdgcn_fence(__ATOMIC_ACQUIRE, "agent");
            asm volatile("s_waitcnt vmcnt(0)" ::: "memory");
        }
    }
    __syncthreads();
}
struct Args {
    const float* in[21]; float* out; unsigned char* ws;
};
constexpr int NWAVES = 8, NTHR = 512;
constexpr int LDS_BYTES = 147456;

__device__ __forceinline__ void ada_item(const Args& a, int item, LAS unsigned char* lds, int tid, int lane, int wave) {
    const int layer = item / 96, n0 = (item % 96) * 64;
    LAS float* sil = (LAS float*)lds; LAS float* red = sil + 3072;
    const float* c = a.in[1]; const float* cc = a.in[3];
    for (int i = tid; i < 3072; i += NTHR) { const int v = i >> 10, k = i & 1023; const float cv = (v < 2) ? c[v * 1024 + k] : cc[k]; sil[i] = cv / (1.0f + __expf(-cv)); }
    __syncthreads();
    const float* W = a.in[4] + (size_t)layer * 1024 * 6144 + n0 + lane;
    float a0 = 0.f, a1 = 0.f, a2 = 0.f; const int k0 = wave * 128;
#pragma unroll 8
    for (int kk = 0; kk < 128; ++kk) { const int k = k0 + kk; const float w = __builtin_nontemporal_load(W + (size_t)k * 6144); a0 += sil[k] * w; a1 += sil[1024 + k] * w; a2 += sil[2048 + k] * w; }
    red[(wave * 3 + 0) * 64 + lane] = a0; red[(wave * 3 + 1) * 64 + lane] = a1; red[(wave * 3 + 2) * 64 + lane] = a2;
    __syncthreads();
    if (tid < 192) { const int v = tid >> 6, l = tid & 63; float s = a.in[5][layer * 6144 + n0 + l];
#pragma unroll
        for (int w = 0; w < 8; ++w) s += red[(w * 3 + v) * 64 + l];
        ((float*)(a.ws + WS_MOD))[(layer * 3 + v) * 6144 + n0 + l] = s; }
    __syncthreads();
}
__device__ __forceinline__ void transpose_item(const float* W, int N, bf16_t* WT, int ldk, int k0, int n0, int drow0, LAS float* scr, int lane, const float* kscale = nullptr) {
#pragma unroll 8
    for (int i = 0; i < 32; ++i) { const int kk = 2 * i + (lane >> 5); float w = __builtin_nontemporal_load(W + (size_t)(k0 + kk) * N + n0 + (lane & 31)); if (kscale) w *= kscale[k0 + kk]; scr[kk * 33 + (lane & 31)] = w; }
    LDS_WAIT(); asm volatile("" ::: "memory");
    const int c = lane & 7;
#pragma unroll
    for (int j = 0; j < 4; ++j) { const int n = (lane >> 3) + 8 * j; const LAS float* s = scr + (8 * c) * 33 + n;
        u32x4 o; o.x = pk2(s[0 * 33], s[1 * 33]); o.y = pk2(s[2 * 33], s[3 * 33]); o.z = pk2(s[4 * 33], s[5 * 33]); o.w = pk2(s[6 * 33], s[7 * 33]);
        *(u32x4*)(WT + (size_t)(drow0 + n) * ldk + k0 + 8 * c) = o; }
    LDS_WAIT(); asm volatile("" ::: "memory");
}
__device__ __forceinline__ void p0_prologue(const Args& a, LAS unsigned char* lds, int tid, int lane, int wave) {
    asm volatile("" : "+v"(lane), "+v"(tid));
    unsigned char* ws = a.ws;
    if (blockIdx.x < 192) ada_item(a, blockIdx.x, lds, tid, lane, wave);
    LAS float* scr = (LAS float*)(lds + wave * 16384);
    const int gw = blockIdx.x * NWAVES + wave, NGW = gridDim.x * NWAVES;
    constexpr int I_IN = 16 * 69, I_UQ = 6 * 24, I_UKV = 4 * 32, I_O = 512, I_F = 512, I_13 = 16 * 88, I_2 = 44 * 32;
    constexpr int NITEMS = I_IN + I_UQ + I_UKV + I_O + I_F + 2 * (2 * I_13 + I_2);
    for (int it = gw; it < NITEMS; it += NGW) {
        int r = it;
        if (r < I_IN) { const int kb = r / 69, nb = r % 69; transpose_item(a.in[8], NIN, (bf16_t*)(ws + WS_WIN), 1024, 64 * kb, 32 * nb, 32 * nb, scr, lane); continue; } r -= I_IN;
        if (r < I_UQ) { const int kb = r / 24, nb = r % 24; transpose_item(a.in[11], 768, (bf16_t*)(ws + WS_WUQ), 384, 64 * kb, 32 * nb, 32 * nb, scr, lane, a.in[9]); continue; } r -= I_UQ;
        if (r < I_UKV) { const int kb = r / 32, nb = r % 32; transpose_item(a.in[12], 1024, (bf16_t*)(ws + WS_WUKV), 256, 64 * kb, 32 * nb, 32 * nb, scr, lane, a.in[10]); continue; } r -= I_UKV;
        if (r < I_O) { const int kb = r / 32, nb = r % 32; transpose_item(a.in[16], 1024, (bf16_t*)(ws + WS_WO), 1024, 64 * kb, 32 * nb, 32 * nb, scr, lane); continue; } r -= I_O;
        if (r < I_F) { const int kb = r / 32, nb = r % 32; transpose_item(a.in[17], 1024, (bf16_t*)(ws + WS_WF), 1024, 64 * kb, 32 * nb, 32 * nb, scr, lane); continue; } r -= I_F;
        const int layer = r / (2 * I_13 + I_2); r -= layer * (2 * I_13 + I_2);
        if (r < 2 * I_13) { const int s = r / I_13; r -= s * I_13; const int kb = r / 88, nb = r % 88, n0 = 32 * nb;
            transpose_item(a.in[s ? 19 : 18] + (size_t)layer * 1024 * DFF, DFF, (bf16_t*)(ws + WS_W13 + layer * W13_BYTES), 1024, 64 * kb, n0, 256 * (n0 >> 7) + 128 * s + (n0 & 127), scr, lane); continue; }
        r -= 2 * I_13;
        { const int kb = r / 32, nb = r % 32; transpose_item(a.in[20] + (size_t)layer * DFF * 1024, 1024, (bf16_t*)(ws + WS_W2 + layer * W2_BYTES), DFF, 64 * kb, 32 * nb, 32 * nb, scr, lane); }
    }
    const int gt = blockIdx.x * NTHR + tid, NGT = gridDim.x * NTHR;
    { unsigned* z = (unsigned*)(ws + WS_WIN + (size_t)NIN * 1024 * 2); for (int i = gt; i < 96 * 1024 / 2; i += NGT) z[i] = 0u; }
    { bf16_t* d = (bf16_t*)(ws + WS_D256);
      for (int i = gt; i < 131072; i += NGT) { const int cs = i >> 16, c = (i >> 8) & 255, cp = i & 255; const float rev = (float)((c * cp) & 255) * (1.0f / 256.0f);
          const float v = cs ? -sin_rev(rev) : cos_rev(rev); d[i] = (bf16_t)f2bf(v * 0.0625f); } }
    { bf16_t* d = (bf16_t*)(ws + WS_W1D);
      for (int i = gt; i < 65536; i += NGT) { const int row = i >> 8, col = i & 255, ro = row >> 7, ka = row & 127, ri = col >> 7, n = col & 127; const float rev = (float)((n * ka) & 127) * (1.0f / 128.0f);
          const float c = cos_rev(rev), s = sin_rev(rev); const float v = (ro == 0) ? (ri == 0 ? c : s) : (ri == 0 ? -s : c); d[i] = (bf16_t)f2bf(v * 0.08838834764831845f); } }
    { bf16_t* d = (bf16_t*)(ws + WS_W2D);
      for (int i = gt; i < 256 * 512; i += NGT) { const int row = i >> 9, col = i & 511, s = row >> 6, kb = row & 63, sp = col >> 7, ri = (col >> 6) & 1, n2 = col & 63; float v = 0.f;
          if (s == sp) { const float rev = (float)((n2 * kb) & 63) * (1.0f / 64.0f); v = (ri == 0 ? cos_rev(rev) : sin_rev(rev)) * 0.125f; }
          d[i] = (bf16_t)f2bf(v); } }
}

__device__ __forceinline__ void norm_pass(const float* src, int nrows, bf16_t* dst, const float* g, const float* mod, int sh_chunk, int vfixed, int lane, int wave) {
    asm volatile("" : "+v"(lane));
    const int gw = blockIdx.x * NWAVES + wave, NGW = gridDim.x * NWAVES;
    const int nb = vfixed >= 0 ? 1 : 2;
#pragma unroll 1
    for (int b = 0; b < nb; ++b) {
        const int v = vfixed >= 0 ? vfixed : b; const float* mv = mod + v * 6144 + sh_chunk * 1024;
        f32x4 cg[4], cs[4];
#pragma unroll
        for (int j = 0; j < 4; ++j) { const int c = (j >> 1) * 512 + lane * 8 + (j & 1) * 4; const f32x4 gg = *(const f32x4*)(g + c), sc = *(const f32x4*)(mv + 1024 + c); cg[j] = gg * (sc + 1.0f); cs[j] = *(const f32x4*)(mv + c); }
        const int rlo = vfixed >= 0 ? 0 : b * 8192, rhi = vfixed >= 0 ? nrows : (b + 1) * 8192;
        for (int r = rlo + gw; r < rhi && r < nrows; r += NGW) {
            const float* xrow = src + (size_t)r * 1024; bf16_t* orow = dst + (size_t)r * 1024;
            f32x4 x[4]; pg8::ld8(xrow + lane * 8, x[0], x[1]); pg8::ld8(xrow + 512 + lane * 8, x[2], x[3]); float s = 0.f;
#pragma unroll
            for (int j = 0; j < 4; ++j) s += (x[j].x * x[j].x + x[j].y * x[j].y) + (x[j].z * x[j].z + x[j].w * x[j].w);
            const float rstd = rsqrtf(wave_sum(s) * (1.0f / 1024.0f) + EPS);
            pg8::st8(orow + lane * 8, x[0] * rstd * cg[0] + cs[0], x[1] * rstd * cg[1] + cs[1]);
            pg8::st8(orow + 512 + lane * 8, x[2] * rstd * cg[2] + cs[2], x[3] * rstd * cg[3] + cs[3]);
        }
    }
}
__device__ __forceinline__ void norm_pass_b(const bf16_t* src, int nrows, bf16_t* dst, const float* g, const float* mod, int sh_chunk, int lane, int wave) {
    asm volatile("" : "+v"(lane));
    const int gw = blockIdx.x * NWAVES + wave, NGW = gridDim.x * NWAVES;
#pragma unroll 1
    for (int b = 0; b < 2; ++b) {
        const float* mv = mod + b * 6144 + sh_chunk * 1024;
        f32x4 cg[4], cs[4];
#pragma unroll
        for (int j = 0; j < 4; ++j) { const int c = (j >> 1) * 512 + lane * 8 + (j & 1) * 4; const f32x4 gg = *(const f32x4*)(g + c), sc = *(const f32x4*)(mv + 1024 + c); cg[j] = gg * (sc + 1.0f); cs[j] = *(const f32x4*)(mv + c); }
        for (int r = b * 8192 + gw; r < (b + 1) * 8192 && r < nrows; r += NGW) {
            const bf16_t* xrow = src + (size_t)r * 1024; bf16_t* orow = dst + (size_t)r * 1024;
            f32x4 v[4]; pg8::ld8(xrow + lane * 8, v[0], v[1]); pg8::ld8(xrow + 512 + lane * 8, v[2], v[3]); float s = 0.f;
#pragma unroll
            for (int j = 0; j < 4; ++j) s += (v[j].x * v[j].x + v[j].y * v[j].y) + (v[j].z * v[j].z + v[j].w * v[j].w);
            const float rstd = rsqrtf(wave_sum(s) * (1.0f / 1024.0f) + EPS);
            pg8::st8(orow + lane * 8, v[0] * rstd * cg[0] + cs[0], v[1] * rstd * cg[1] + cs[1]);
            pg8::st8(orow + 512 + lane * 8, v[2] * rstd * cg[2] + cs[2], v[3] * rstd * cg[3] + cs[3]);
        }
    }
}

__device__ __forceinline__ float sumsq8(u32x4 c) { float s = 0.f;
#pragma unroll
    for (int i = 0; i < 4; ++i) { const float a = bflo(c[i]), b = bfhi(c[i]); s += a * a + b * b; } return s; }
__device__ __forceinline__ u32x4 scale8(u32x4 c, float r, const float* g) { const f32x4 g0 = *(const f32x4*)g, g1 = *(const f32x4*)(g + 4); u32x4 o;
    o.x = pk2(bflo(c.x) * r * g0.x, bfhi(c.x) * r * g0.y); o.y = pk2(bflo(c.y) * r * g0.z, bfhi(c.y) * r * g0.w);
    o.z = pk2(bflo(c.z) * r * g1.x, bfhi(c.z) * r * g1.y); o.w = pk2(bflo(c.w) * r * g1.z, bfhi(c.w) * r * g1.w); return o; }
__device__ __forceinline__ void conv_pass(const Args& a, int lane, int wave) {
    asm volatile("" : "+v"(lane));
    unsigned char* ws = a.ws;
    const bf16_t* P = (const bf16_t*)(ws + WS_B); bf16_t* MIX = (bf16_t*)(ws + WS_A);
    const float* cw = a.in[15];
    f32x4 w0[2], w1[2], w2[2];
#pragma unroll
    for (int i = 0; i < 2; ++i) { w0[i] = *(const f32x4*)(cw + 8 * lane + 4 * i); w1[i] = *(const f32x4*)(cw + 512 + 8 * lane + 4 * i); w2[i] = *(const f32x4*)(cw + 1024 + 8 * lane + 4 * i); }
    const int gw = blockIdx.x * NWAVES + wave, NGW = gridDim.x * NWAVES;
    for (int r = gw; r < ML; r += NGW) {
        const int t = r & (SEQ - 1);
        const bf16_t* cb = P + (size_t)r * PLD + 672 + 8 * lane;
        const u32x4 bg = *(const u32x4*)cb, cg0 = *(const u32x4*)(cb + 512), u0 = *(const u32x4*)(cb + 1024);
        u32x4 cgm = (u32x4){0u, 0u, 0u, 0u}, um = cgm, cgp = cgm, up = cgm;
        if (t > 0) { cgm = *(const u32x4*)(cb - PLD + 512); um = *(const u32x4*)(cb - PLD + 1024); }
        if (t < SEQ - 1) { cgp = *(const u32x4*)(cb + PLD + 512); up = *(const u32x4*)(cb + PLD + 1024); }
        u32x4 o;
#pragma unroll
        for (int i = 0; i < 4; ++i) {
            const float zl_m = bflo(cgm[i]) * bflo(um[i]), zh_m = bfhi(cgm[i]) * bfhi(um[i]);
            const float zl_0 = bflo(cg0[i]) * bflo(u0[i]), zh_0 = bfhi(cg0[i]) * bfhi(u0[i]);
            const float zl_p = bflo(cgp[i]) * bflo(up[i]), zh_p = bfhi(cgp[i]) * bfhi(up[i]);
            const int e = 2 * i;
            const float yl = zl_m * w0[e >> 2][e & 3] + zl_0 * w1[e >> 2][e & 3] + zl_p * w2[e >> 2][e & 3];
            const float yh = zh_m * w0[(e + 1) >> 2][(e + 1) & 3] + zh_0 * w1[(e + 1) >> 2][(e + 1) & 3] + zh_p * w2[(e + 1) >> 2][(e + 1) & 3];
            o[i] = pk2(bflo(bg[i]) * yl, bfhi(bg[i]) * yh);
        }
        *(u32x4*)(MIX + (size_t)r * 1024 + 512 + 8 * lane) = o;
    }
}

__device__ __forceinline__ void prep2_pass(const Args& a, LAS unsigned char* lds, int tid, int lane, int wave) {
    asm volatile("" : "+v"(lane), "+v"(tid));
    unsigned char* ws = a.ws;
    bf16_t* Q = (bf16_t*)(ws + WS_Q); const bf16_t* KV = (const bf16_t*)(ws + WS_KV); const bf16_t* P = (const bf16_t*)(ws + WS_B);
    LAS float* rkl = (LAS float*)(lds + 65536);
    bf16_t* Kf = (bf16_t*)(ws + WS_KF); bf16_t* Vt = (bf16_t*)(ws + WS_VT);
    const float* qgain = a.in[13]; const float* kgain = a.in[14];
    const int head = lane >> 3, sub = lane & 7;
    const float inv = __builtin_amdgcn_exp2f(-(float)sub * 1.6609640474436813f) * 0.15915494309189535f;
    float qgn[8], kgn[8], qgp[4], kgp[4];
#pragma unroll
    for (int e = 0; e < 8; ++e) { qgn[e] = qgain[8 * sub + e] * QSC; kgn[e] = kgain[8 * sub + e]; }
#pragma unroll
    for (int i = 0; i < 4; ++i) { qgp[i] = qgain[64 + sub + 8 * i] * QSC; kgp[i] = kgain[64 + sub + 8 * i]; }
    constexpr int PB = 16, RW = PB / 8;
    for (int blk = blockIdx.x; blk < MT / PB; blk += gridDim.x) {
        const int r0 = blk * PB; const bool latent = blk < ML / PB;
        const int b = latent ? (blk / (SEQ / PB)) : ((blk - ML / PB) / (256 / PB));
        const int key0 = latent ? ((blk % (SEQ / PB)) * PB) : (SEQ + ((blk - ML / PB) % (256 / PB)) * PB);
#pragma unroll
        for (int i = 0; i < PB / 8; ++i) { const int id = tid + 512 * i, row = id >> 6, cc = id & 63, h = cc >> 3, part = cc & 7;
            const u32x4 v = *(const u32x4*)(KV + (size_t)(r0 + row) * 1024 + h * 128 + 64 + part * 8);
            *(LAS u32x4*)(lds + row * 1024 + cc * 16) = v; }
        for (int i = 0; i < RW; ++i) {
            const int r = r0 + RW * wave + i, kl = RW * wave + i;
            float cr = 1.f, sr = 0.f, ccol = 1.f, scol = 0.f;
            if (latent) { const int t = r & (SEQ - 1); const float ar = (float)(t >> 6) * inv, ac = (float)(t & 63) * inv;
                cr = cos_rev(ar - floorf(ar)); sr = sin_rev(ar - floorf(ar)); ccol = cos_rev(ac - floorf(ac)); scol = sin_rev(ac - floorf(ac)); }
            const bf16_t* prow = P + (size_t)r * PLD; const bf16_t* kpe = prow + 640;
            float rq, rkv;
            { const u32x4 c1 = *(const u32x4*)(prow + lane * 8); u32x4 c2 = (u32x4){0u, 0u, 0u, 0u}; if (lane < 16) c2 = *(const u32x4*)(prow + 512 + lane * 8);
              const float ss1 = sumsq8(c1), ss2 = sumsq8(c2);
              const float sq = wave_sum(lane < 48 ? ss1 : 0.f), skv = wave_sum((lane >= 48 ? ss1 : 0.f) + ss2);
              rq = rsqrtf(sq * (1.0f / 384.0f) + EPS); rkv = rsqrtf(skv * (1.0f / 256.0f) + EPS); if (lane == 0) rkl[kl] = rkv; }
            if (latent) {
                bf16_t* qp = Q + (size_t)r * 768 + head * 96;
                const u32x4 nv = *(const u32x4*)(qp + 8 * sub);
                float pe[4];
#pragma unroll
                for (int j = 0; j < 4; ++j) pe[j] = bf1(qp[64 + sub + 8 * j]) * rq;
                float ss = sumsq8(nv) * (rq * rq) + (pe[0] * pe[0] + pe[1] * pe[1]) + (pe[2] * pe[2] + pe[3] * pe[3]);
                ss += __shfl_xor(ss, 1); ss += __shfl_xor(ss, 2); ss += __shfl_xor(ss, 4);
                const float rs0 = rsqrtf(ss * (1.0f / 96.0f) + EPS), rs = rs0 * rq;
                u32x4 o; o.x = pk2(bflo(nv.x) * rs * qgn[0], bfhi(nv.x) * rs * qgn[1]); o.y = pk2(bflo(nv.y) * rs * qgn[2], bfhi(nv.y) * rs * qgn[3]);
                o.z = pk2(bflo(nv.z) * rs * qgn[4], bfhi(nv.z) * rs * qgn[5]); o.w = pk2(bflo(nv.w) * rs * qgn[6], bfhi(nv.w) * rs * qgn[7]);
                *(u32x4*)(qp + 8 * sub) = o;
                const float p0 = pe[0] * rs0 * qgp[0], p1 = pe[1] * rs0 * qgp[1], p2 = pe[2] * rs0 * qgp[2], p3 = pe[3] * rs0 * qgp[3];
                qp[64 + sub] = (bf16_t)f2bf(p0 * cr - p1 * sr); qp[72 + sub] = (bf16_t)f2bf(p1 * cr + p0 * sr);
                qp[80 + sub] = (bf16_t)f2bf(p2 * ccol - p3 * scol); qp[88 + sub] = (bf16_t)f2bf(p3 * ccol + p2 * scol);
            }
            {
                const u32x4 nv = *(const u32x4*)(KV + (size_t)r * 1024 + head * 128 + 8 * sub);
                float pe[4];
#pragma unroll
                for (int j = 0; j < 4; ++j) pe[j] = bf1(kpe[sub + 8 * j]);
                float ss = sumsq8(nv) * (rkv * rkv) + (pe[0] * pe[0] + pe[1] * pe[1]) + (pe[2] * pe[2] + pe[3] * pe[3]);
                ss += __shfl_xor(ss, 1); ss += __shfl_xor(ss, 2); ss += __shfl_xor(ss, 4);
                const float rs0 = rsqrtf(ss * (1.0f / 96.0f) + EPS), rs = rs0 * rkv;
                bf16_t* kp = Kf + ((size_t)(b * NH + head) * NKEY + key0 + kl) * DQK;
                u32x4 o; o.x = pk2(bflo(nv.x) * rs * kgn[0], bfhi(nv.x) * rs * kgn[1]); o.y = pk2(bflo(nv.y) * rs * kgn[2], bfhi(nv.y) * rs * kgn[3]);
                o.z = pk2(bflo(nv.z) * rs * kgn[4], bfhi(nv.z) * rs * kgn[5]); o.w = pk2(bflo(nv.w) * rs * kgn[6], bfhi(nv.w) * rs * kgn[7]);
                *(u32x4*)(kp + 8 * sub) = o;
                const float p0 = pe[0] * rs0 * kgp[0], p1 = pe[1] * rs0 * kgp[1], p2 = pe[2] * rs0 * kgp[2], p3 = pe[3] * rs0 * kgp[3];
                kp[64 + sub] = (bf16_t)f2bf(p0 * cr - p1 * sr); kp[72 + sub] = (bf16_t)f2bf(p1 * cr + p0 * sr);
                kp[80 + sub] = (bf16_t)f2bf(p2 * ccol - p3 * scol); kp[88 + sub] = (bf16_t)f2bf(p3 * ccol + p2 * scol);
            }
        }
        __syncthreads();
        { const int h = tid >> 6, d = tid & 63; bf16_t* vp = Vt + ((size_t)(b * NH + h) * 64 + d) * NKEY + key0;
#pragma unroll
          for (int i = 0; i < PB / 8; ++i) { float e[8];
#pragma unroll
              for (int k = 0; k < 8; ++k) e[k] = bf1(*(const LAS unsigned short*)(lds + (8 * i + k) * 1024 + tid * 2)) * rkl[8 * i + k];
              u32x4 o; o.x = pk2(e[0], e[1]); o.y = pk2(e[2], e[3]); o.z = pk2(e[4], e[5]); o.w = pk2(e[6], e[7]);
              *(u32x4*)(vp + 8 * i) = o; } }
        __syncthreads();
    }
}

__device__ __forceinline__ float attn_rowmax(const f32x16& p0, const f32x16& p1) {
    float a = __builtin_fmaxf(__builtin_fmaxf(p0[0], p0[1]), p1[0]), b = __builtin_fmaxf(__builtin_fmaxf(p0[2], p0[3]), p1[1]);
    a = __builtin_fmaxf(__builtin_fmaxf(a, p1[2]), p1[3]);
#pragma unroll
    for (int r = 4; r < 16; r += 4) { a = __builtin_fmaxf(__builtin_fmaxf(a, p0[r]), p0[r + 1]); b = __builtin_fmaxf(__builtin_fmaxf(b, p0[r + 2]), p0[r + 3]);
        a = __builtin_fmaxf(__builtin_fmaxf(a, p1[r]), p1[r + 1]); b = __builtin_fmaxf(__builtin_fmaxf(b, p1[r + 2]), p1[r + 3]); }
    const float mx = __builtin_fmaxf(a, b);
    auto rr = __builtin_amdgcn_permlane32_swap(__float_as_uint(mx), __float_as_uint(mx), false, false);
    return __builtin_fmaxf(__uint_as_float(rr[0]), __uint_as_float(rr[1]));
}
__device__ __forceinline__ void attn_phase(const Args& a, LAS unsigned char* lds, int tid, int lane, int wid) {
    asm volatile("" : "+v"(lane), "+v"(tid));
    unsigned char* ws = a.ws;
    const bf16_t* Q = (const bf16_t*)(ws + WS_Q); const char* Kf = (const char*)(ws + WS_KF); const char* Vt = (const char*)(ws + WS_VT); bf16_t* MIX = (bf16_t*)(ws + WS_A);
    constexpr int NS = 4, KSLOT = 13312, VBASE = NS * KSLOT, VSLOT = 8192, NT = NKEY / 64;
    constexpr float THR = 8.0f;
    const int q = lane & 31, hi = lane >> 5;
    const int xcd = blockIdx.x & 7, l = blockIdx.x >> 3;
    const unsigned lds0 = (unsigned)(size_t)lds;
    unsigned koff[2];
#pragma unroll
    for (int i = 0; i < 2; ++i) { const int p = 64 * (wid + 8 * i) + lane, row = p / 13, c = p % 13, r31 = row & 31;
        const int key = (row & 32) + ((r31 & 19) | ((r31 & 4) << 1) | ((r31 & 8) >> 1)); koff[i] = (unsigned)(key * 192 + (c < 12 ? c : 11) * 16); }
    const bool k2 = wid < 5;
    unsigned voffv; { const int d = 8 * wid + (lane >> 3), cp = lane & 7, c = cp ^ ((d >> 1) & 7); voffv = (unsigned)(d * (NKEY * 2) + c * 16); }
    const unsigned kdst0 = lds0 + (unsigned)wid * 1024u, kdst1 = lds0 + (unsigned)(wid + 8) * 1024u, vdst = lds0 + VBASE + (unsigned)wid * 1024u;
    const int kro = q * 208 + hi * 16;
    int vro[4];
#pragma unroll
    for (int s = 0; s < 4; ++s) vro[s] = VBASE + q * 128 + (((2 * s + hi) ^ ((q >> 1) & 7)) * 16);
#define DMA_K(tile, slot) do { const char* kb_ = Kh + (size_t)(tile) * (64 * 192); pg8::glds16s(kb_, koff[0], kdst0 + (slot) * KSLOT); if (k2) pg8::glds16s(kb_, koff[1], kdst1 + (slot) * KSLOT); } while (0)
#define DMA_V(tile, slot) pg8::glds16s(Vh + (size_t)(tile) * 128, voffv, vdst + (slot) * VSLOT)
#define SBAR() do {} while (0)
#define EXP2(P, R) do { P[R] = __builtin_amdgcn_exp2f(P[R]); P[R + 1] = __builtin_amdgcn_exp2f(P[R + 1]); rs2 += (f32x2){P[R], P[R + 1]}; } while (0)
#define PKP(P, B) __builtin_bit_cast(bf16x8, (u32x4){cvt_pk_bf16(P[B], P[B + 1]), cvt_pk_bf16(P[B + 2], P[B + 3]), cvt_pk_bf16(P[B + 4], P[B + 5]), cvt_pk_bf16(P[B + 6], P[B + 7])})
    for (int it = 0; it < 2; ++it) {
        const int bh = 2 * xcd + it, b = bh >> 3, h = bh & 7, qb = l;
        const size_t qrow = (size_t)b * SEQ + qb * 256 + wid * 32 + q;
        const char* Kh = Kf + (size_t)bh * NKEY * 192; const char* Vh = Vt + (size_t)bh * 64 * NKEY * 2;
        DMA_K(0, 0); DMA_K(1, 1); DMA_V(0, 0); DMA_K(2, 2); DMA_V(1, 1); DMA_K(3, 3); DMA_V(2, 2);
        bf16x8 qf[6];
#pragma unroll
        for (int d0 = 0; d0 < 6; ++d0) qf[d0] = *(const bf16x8*)(Q + qrow * 768 + h * 96 + d0 * 16 + hi * 8);
        asm volatile("s_waitcnt vmcnt(0) lgkmcnt(0)\n\ts_barrier" ::: "memory");
        f32x16 pc0 = {}, pc1 = {};
#pragma unroll
        for (int d0 = 0; d0 < 6; ++d0) {
            const bf16x8 a0 = *(const LAS bf16x8*)(lds + kro + d0 * 32), a1 = *(const LAS bf16x8*)(lds + kro + 32 * 208 + d0 * 32);
            pc0 = __builtin_amdgcn_mfma_f32_32x32x16_bf16(a0, qf[d0], pc0, 0, 0, 0); pc1 = __builtin_amdgcn_mfma_f32_32x32x16_bf16(a1, qf[d0], pc1, 0, 0, 0);
        }
        float m = attn_rowmax(pc0, pc1), lsum = 0.f;
#pragma unroll
        for (int r = 0; r < 16; ++r) { pc0[r] -= m; pc1[r] -= m; }
        f32x16 o0 = {}, o1 = {};
        f32x2 rs2 = (f32x2){0.f, 0.f};
        f32x16 negm;
#pragma unroll
        for (int r = 0; r < 16; ++r) negm[r] = -m;
        asm volatile("" : "+v"(negm));
        asm volatile("s_waitcnt lgkmcnt(0)\n\ts_barrier" ::: "memory");
#define ATT_ITER(PC0, PC1, PN0, PN1, T) do { \
            { const int tk_ = ((T) + 4 < NT) ? (T) + 4 : NT - 1, tv_ = ((T) + 3 < NT) ? (T) + 3 : NT - 1; DMA_K(tk_, (T) & 3); DMA_V(tv_, ((T) + 3) & 3); } \
            const LAS unsigned char* kn = lds + (((T) + 1) & 3) * KSLOT + kro; \
            bf16x8 kfa[6], kfb[6]; \
            _Pragma("unroll") for (int d0 = 0; d0 < 3; ++d0) { kfa[2 * d0] = *(const LAS bf16x8*)(kn + d0 * 32); kfa[2 * d0 + 1] = *(const LAS bf16x8*)(kn + 32 * 208 + d0 * 32); } \
            SBAR(); \
            PN0 = __builtin_amdgcn_mfma_f32_32x32x16_bf16(kfa[0], qf[0], negm, 0, 0, 0); EXP2(PC0, 0); SBAR(); \
            _Pragma("unroll") for (int d0 = 3; d0 < 6; ++d0) { kfb[2 * (d0 - 3)] = *(const LAS bf16x8*)(kn + d0 * 32); kfb[2 * (d0 - 3) + 1] = *(const LAS bf16x8*)(kn + 32 * 208 + d0 * 32); } \
            SBAR(); \
            PN1 = __builtin_amdgcn_mfma_f32_32x32x16_bf16(kfa[1], qf[0], negm, 0, 0, 0); EXP2(PC0, 2); SBAR(); \
            PN0 = __builtin_amdgcn_mfma_f32_32x32x16_bf16(kfa[2], qf[1], PN0, 0, 0, 0); EXP2(PC0, 4); EXP2(PC0, 6); SBAR(); \
            PN1 = __builtin_amdgcn_mfma_f32_32x32x16_bf16(kfa[3], qf[1], PN1, 0, 0, 0); EXP2(PC0, 8); SBAR(); \
            PN0 = __builtin_amdgcn_mfma_f32_32x32x16_bf16(kfa[4], qf[2], PN0, 0, 0, 0); EXP2(PC0, 10); EXP2(PC0, 12); SBAR(); \
            PN1 = __builtin_amdgcn_mfma_f32_32x32x16_bf16(kfa[5], qf[2], PN1, 0, 0, 0); EXP2(PC0, 14); SBAR(); \
            const LAS unsigned char* vb = lds + ((T) & 3) * VSLOT; \
            bf16x8 va[8]; \
            _Pragma("unroll") for (int s = 0; s < 4; ++s) { va[2 * s] = *(const LAS bf16x8*)(vb + vro[s]); va[2 * s + 1] = *(const LAS bf16x8*)(vb + vro[s] + 32 * 128); } \
            SBAR(); \
            PN0 = __builtin_amdgcn_mfma_f32_32x32x16_bf16(kfb[0], qf[3], PN0, 0, 0, 0); EXP2(PC1, 0); EXP2(PC1, 2); SBAR(); \
            PN1 = __builtin_amdgcn_mfma_f32_32x32x16_bf16(kfb[1], qf[3], PN1, 0, 0, 0); EXP2(PC1, 4); SBAR(); \
            PN0 = __builtin_amdgcn_mfma_f32_32x32x16_bf16(kfb[2], qf[4], PN0, 0, 0, 0); EXP2(PC1, 6); EXP2(PC1, 8); SBAR(); \
            PN1 = __builtin_amdgcn_mfma_f32_32x32x16_bf16(kfb[3], qf[4], PN1, 0, 0, 0); EXP2(PC1, 10); SBAR(); \
            PN0 = __builtin_amdgcn_mfma_f32_32x32x16_bf16(kfb[4], qf[5], PN0, 0, 0, 0); EXP2(PC1, 12); SBAR(); \
            PN1 = __builtin_amdgcn_mfma_f32_32x32x16_bf16(kfb[5], qf[5], PN1, 0, 0, 0); EXP2(PC1, 14); SBAR(); \
            { const bf16x8 pb0 = PKP(PC0, 0); \
              o0 = __builtin_amdgcn_mfma_f32_32x32x16_bf16(va[0], pb0, o0, 0, 0, 0); o1 = __builtin_amdgcn_mfma_f32_32x32x16_bf16(va[1], pb0, o1, 0, 0, 0); \
              const bf16x8 pb1 = PKP(PC0, 8); \
              o0 = __builtin_amdgcn_mfma_f32_32x32x16_bf16(va[2], pb1, o0, 0, 0, 0); o1 = __builtin_amdgcn_mfma_f32_32x32x16_bf16(va[3], pb1, o1, 0, 0, 0); \
              const bf16x8 pb2 = PKP(PC1, 0); \
              o0 = __builtin_amdgcn_mfma_f32_32x32x16_bf16(va[4], pb2, o0, 0, 0, 0); o1 = __builtin_amdgcn_mfma_f32_32x32x16_bf16(va[5], pb2, o1, 0, 0, 0); \
              const bf16x8 pb3 = PKP(PC1, 8); \
              o0 = __builtin_amdgcn_mfma_f32_32x32x16_bf16(va[6], pb3, o0, 0, 0, 0); o1 = __builtin_amdgcn_mfma_f32_32x32x16_bf16(va[7], pb3, o1, 0, 0, 0); } \
            if (k2) asm volatile("s_waitcnt vmcnt(6) lgkmcnt(0)\n\ts_barrier" ::: "memory"); \
            else asm volatile("s_waitcnt vmcnt(4) lgkmcnt(0)\n\ts_barrier" ::: "memory"); \
        } while (0)
        f32x16 pd0, pd1;
        static_assert(NT % 2 == 0, "two tiles per loop trip");
        for (int t = 0; t < NT; t += 2) {
            ATT_ITER(pc0, pc1, pd0, pd1, t);
            ATT_ITER(pd0, pd1, pc0, pc1, t + 1);
        }
#undef ATT_ITER
        lsum += rs2.x + rs2.y;
        const float lt = lsum + __shfl_xor(lsum, 32); const float il = 1.0f / lt;
        bf16_t* op = MIX + qrow * 1024 + h * 64 + 4 * hi;
#pragma unroll
        for (int g = 0; g < 4; ++g) {
            u32x2 w0, w1; w0.x = cvt_pk_bf16(o0[4 * g] * il, o0[4 * g + 1] * il); w0.y = cvt_pk_bf16(o0[4 * g + 2] * il, o0[4 * g + 3] * il);
            w1.x = cvt_pk_bf16(o1[4 * g] * il, o1[4 * g + 1] * il); w1.y = cvt_pk_bf16(o1[4 * g + 2] * il, o1[4 * g + 3] * il);
            *(u32x2*)(op + 8 * g) = w0; *(u32x2*)(op + 32 + 8 * g) = w1;
        }
        asm volatile("s_waitcnt vmcnt(0) lgkmcnt(0)\n\ts_barrier" ::: "memory");
    }
#undef DMA_K
#undef DMA_V
#undef SBAR
#undef EXP2
#undef PKP
}

__global__ void __launch_bounds__(NTHR, 2) fwd_kernel(Args a) {
    extern __shared__ __attribute__((aligned(16))) unsigned char lds_raw[];
    LAS unsigned char* lds = (LAS unsigned char*)lds_raw;
    cg::grid_group grid = cg::this_grid();
    unsigned* barw = (unsigned*)a.ws;
    volatile LAS unsigned* bst = (volatile LAS unsigned*)(lds_raw + 131072 + 64);
    if (threadIdx.x < 2) bst[threadIdx.x] = 0u;
    __syncthreads();
    XcdBarrier xbar = xcd_barrier_post(barw, bst);
    if (a.out == nullptr) grid.sync();
#define GSYNC() do { for (int s_ = 0; s_ < PROBE_SYNC; ++s_) xcd_barrier(xbar); } while (0)
    const int tid = threadIdx.x, lane = tid & 63, wave = __builtin_amdgcn_readfirstlane(tid >> 6);
    const int G = gridDim.x, cu = blockIdx.x;
    unsigned char* ws = a.ws;
    const float* mod = (const float*)(ws + WS_MOD);
    bf16_t* XN = (bf16_t*)(ws + WS_A);
    bf16_t* XB = (bf16_t*)(ws + WS_XB);

    p0_prologue(a, lds, tid, lane, wave);
    GSYNC();
    norm_pass(a.in[0], ML, XN, a.in[6], mod, 0, -1, lane, wave);
    norm_pass(a.in[2], MC, XN + (size_t)ML * 1024, a.in[6], mod, 0, 2, lane, wave);
    GSYNC();
    { pg8::ProbStd p = pg8::make_std(XN, 1024, ws + WS_WIN, 1024, 1024); pg8::StaticOrder S; S.init(MT, NINP, G, cu);
      pg8::EpiBf16 E{(bf16_t*)(ws + WS_B), PLD, NIN}; pg8::gemm_phase<pg8::EpiBf16, pg8::ProbStd, true>(lds, p, S, E); }
    { pg8::ProbWc p{(const char*)(ws + WS_WF), (const char*)(ws + WS_D256), 256, 1024 * 2, 256 * 2, (size_t)128 * 1024 * 2, (size_t)128 * 256 * 2};
      pg8::StaticOrder S; S.init(2048, 1024, G, (cu + 32) & 255);
      pg8::EpiBf16 E{(bf16_t*)(ws + WS_WC), 1024, 1 << 30}; pg8::gemm_phase<pg8::EpiBf16, pg8::ProbWc, true>(lds, p, S, E); }
    GSYNC();
    { pg8::ProbStd p = pg8::make_std(ws + WS_B, PLD, ws + WS_WUQ, QR, QR); pg8::StaticOrder S; S.init(ML, 768, G, cu);
      pg8::EpiBf16 E{(bf16_t*)(ws + WS_Q), 768, 1 << 30}; pg8::gemm_phase<pg8::EpiBf16, pg8::ProbStd, true>(lds, p, S, E); }
    { pg8::ProbStd p = pg8::make_std(ws + WS_B + QR * 2, PLD, ws + WS_WUKV, KVR, KVR); pg8::StaticOrder S; S.init(MT, 1024, G, (cu + 64) & 255);
      pg8::EpiBf16 E{(bf16_t*)(ws + WS_KV), 1024, 1 << 30}; pg8::gemm_phase<pg8::EpiBf16, pg8::ProbStd, true>(lds, p, S, E); }
    GSYNC();
    prep2_pass(a, lds, tid, lane, wave);
    conv_pass(a, lane, wave);
    GSYNC();
    for (int p_ = 0; p_ < PROBE_ATTN; ++p_) attn_phase(a, lds, tid, lane, wave);
    GSYNC();
    { pg8::ProbStd p = pg8::make_std(ws + WS_A, 1024, ws + WS_WO, 1024, 1024); pg8::StaticOrder S; S.init(ML, 1024, G, cu);
      typedef pg8::EpiResid<float, bf16_t> EP; EP E{a.in[0], XB, mod + 2 * 1024, 6144}; pg8::gemm_phase<EP, pg8::ProbStd, true>(lds, p, S, E); }
    GSYNC();
#pragma unroll
    for (int layer = 0; layer < 2; ++layer) {
        const float* modl = mod + layer * 3 * 6144;
        if (layer == 1) {
            norm_pass_b(XB, ML, XN, a.in[6] + 1024, modl, 0, lane, wave);
            GSYNC();
            { pg8::ProbG1 p{(const char*)(ws + WS_WC), (const char*)XN, 1024, 1024 * 2, 64 * 2048, (size_t)128 * 1024 * 2, (size_t)2048};
              pg8::StaticOrder S; S.init(2048, 16384, G, cu);
              pg8::EpiG1 E{(bf16_t*)(ws + WS_Z1)}; pg8::gemm_phase<pg8::EpiG1, pg8::ProbG1, true>(lds, p, S, E); }
            GSYNC();
            { pg8::ProbStd p = pg8::make_std(ws + WS_W1D, 256, ws + WS_Z1, 256, 256); pg8::StaticOrder S; S.init(256, 131072, G, cu);
              pg8::EpiG2 E{(bf16_t*)(ws + WS_G2)}; pg8::gemm_phase<pg8::EpiG2, pg8::ProbStd, true>(lds, p, S, E); }
            GSYNC();
            { pg8::ProbG3 p{(const char*)(ws + WS_W2D), (const char*)(ws + WS_G2), 512, 512 * 2, 128 * 128 * 2, (size_t)128 * 512 * 2, (size_t)128 * 128 * 128 * 2};
              pg8::StaticOrder S; S.init(256, 65536, G, cu);
              pg8::EpiG3 E{XB, modl + 2 * 1024, 6144}; pg8::gemm_phase<pg8::EpiG3, pg8::ProbG3, true>(lds, p, S, E); }
            GSYNC();
        }
        norm_pass_b(XB, ML, XN, a.in[7] + layer * 1024, modl, 3, lane, wave);
        GSYNC();
        { pg8::ProbStd p = pg8::make_std(XN, 1024, ws + WS_W13 + layer * W13_BYTES, 1024, 1024); pg8::StaticOrder S; S.init(ML, 2 * DFF, G, cu);
          pg8::EpiSwiglu E{(bf16_t*)(ws + WS_H)}; for (int p_ = 0; p_ < PROBE_FFNUP; ++p_) pg8::gemm_phase<pg8::EpiSwiglu, pg8::ProbStd, true>(lds, p, S, E); }
        GSYNC();
        { pg8::ProbStd p = pg8::make_std(ws + WS_H, DFF, ws + WS_W2 + layer * W2_BYTES, DFF, DFF); pg8::StaticOrder S; S.init(ML, 1024, G, cu);
          if (layer == 0) { typedef pg8::EpiResid<bf16_t, bf16_t> EP; EP E{XB, XB, modl + 5 * 1024, 6144}; pg8::gemm_phase<EP, pg8::ProbStd, true>(lds, p, S, E); }
          else { typedef pg8::EpiResid<bf16_t, float> EP; EP E{XB, a.out, modl + 5 * 1024, 6144}; pg8::gemm_phase<EP, pg8::ProbStd, true>(lds, p, S, E); } }
        if (layer == 0) GSYNC();
    }
}

extern "C" void kernel_launch(void* const* d_in, const int* in_sizes, int n_in, void* d_out, int out_size, void* d_ws, size_t ws_size, hipStream_t stream) {
    static int grid = 0;
    if (grid == 0) {
        if (n_in != 21 || out_size != ML * DM || ws_size < WS_END) { fprintf(stderr, "kernel_launch: unexpected problem (n_in %d out %d ws %zu)\n", n_in, out_size, ws_size); grid = -1; return; }
        int dev = 0, cus = 0, per_cu = 0;
        (void)hipGetDevice(&dev);
        (void)hipDeviceGetAttribute(&cus, hipDeviceAttributeMultiprocessorCount, dev);
        (void)hipFuncSetAttribute((const void*)fwd_kernel, hipFuncAttributeMaxDynamicSharedMemorySize, LDS_BYTES);
        (void)hipOccupancyMaxActiveBlocksPerMultiprocessor(&per_cu, (const void*)fwd_kernel, NTHR, LDS_BYTES);
        (void)hipGetLastError();
        grid = 256;
        if (cus < 256 || per_cu < 1) fprintf(stderr, "kernel_launch: cus %d per_cu %d\n", cus, per_cu);
    }
    if (grid < 0) return;
    Args a{};
    for (int i = 0; i < 21; ++i) a.in[i] = (const float*)d_in[i];
    a.out = (float*)d_out; a.ws = (unsigned char*)d_ws;
    (void)hipMemsetAsync(d_ws, 0, 16384, stream);
    void* args[] = {&a};
    hipError_t e = hipLaunchCooperativeKernel((const void*)fwd_kernel, dim3(grid), dim3(NTHR), args, LDS_BYTES, stream);
    if (e != hipSuccess) fprintf(stderr, "cooperative launch failed: %s\n", hipGetErrorString(e));
}
```

```cpp
#include <hip/hip_runtime.h>
#include <hip/hip_cooperative_groups.h>
#include <cstdio>
#include <cstdint>
namespace cg = cooperative_groups;
#ifndef PROBE_SYNC
#define PROBE_SYNC 1
#endif
#ifndef PROBE_ATTN
#define PROBE_ATTN 1
#endif
#ifndef PROBE_FFNUP
#define PROBE_FFNUP 1
#endif

#define LAS __attribute__((address_space(3)))
typedef unsigned short bf16_t;
typedef short bf16x8 __attribute__((ext_vector_type(8)));
typedef short s16x4 __attribute__((ext_vector_type(4)));
typedef float f32x4 __attribute__((ext_vector_type(4)));
typedef float f32x16 __attribute__((ext_vector_type(16)));
typedef unsigned u32x4 __attribute__((ext_vector_type(4)));
typedef unsigned u32x2 __attribute__((ext_vector_type(2)));
typedef float f32x2 __attribute__((ext_vector_type(2)));

constexpr int DM = 1024, SEQ = 8192, ML = 16384, MC = 512, MT = ML + MC;
constexpr int NINP = 2304, NIN = 2208, QR = 384, KVR = 256, NH = 8, DQK = 96, DFF = 2816, NKEY = 8448;
constexpr float EPS = 1e-6f;
constexpr float QSC = 0.10206207261596575f * 1.4426950408889634f;

constexpr size_t MiB = 1u << 20;
constexpr size_t WS_MOD = 1 * MiB;
constexpr size_t WS_WIN = 2 * MiB;
constexpr size_t WS_WUQ = WS_WIN + (size_t)NINP * 1024 * 2;
constexpr size_t WS_WUKV = WS_WUQ + (size_t)768 * 384 * 2;
constexpr size_t WS_WO = WS_WUKV + (size_t)1024 * 256 * 2;
constexpr size_t WS_WF = WS_WO + 2 * MiB;
constexpr size_t WS_WC = WS_WF + 2 * MiB;
constexpr size_t WS_D256 = WS_WC + 4 * MiB;
constexpr size_t WS_W1D = WS_D256 + 262144;
constexpr size_t WS_W2D = WS_W1D + 131072;
constexpr size_t WS_W13 = WS_W2D + 262144;
constexpr size_t W13_BYTES = (size_t)2 * DFF * 1024 * 2;
constexpr size_t WS_W2 = WS_W13 + 2 * W13_BYTES;
constexpr size_t W2_BYTES = (size_t)1024 * DFF * 2;
constexpr size_t WS_WEND = WS_W2 + 2 * W2_BYTES;
static_assert(WS_WEND <= 52 * MiB, "weights");
constexpr size_t WS_A = 52 * MiB;
constexpr int PLD = 2208;
constexpr size_t WS_B = 85 * MiB;
constexpr size_t WS_Q = 157 * MiB;
constexpr size_t WS_KV = 181 * MiB;
constexpr size_t WS_KF = 214 * MiB;
constexpr size_t WS_VT = 239 * MiB;
constexpr size_t WS_H = WS_B;
constexpr size_t WS_Z1 = WS_B;
constexpr size_t WS_G2 = WS_B + 64 * MiB;
constexpr size_t WS_XB = 218 * MiB;
constexpr size_t WS_END = 256 * MiB;

__device__ __forceinline__ unsigned f2bf(float f) { unsigned u = __builtin_bit_cast(unsigned, f); return (u + 0x7fffu + ((u >> 16) & 1u)) >> 16; }
__device__ __forceinline__ unsigned pk2(float lo, float hi) { return f2bf(lo) | (f2bf(hi) << 16); }
__device__ __forceinline__ float bflo(unsigned w) { return __builtin_bit_cast(float, w << 16); }
__device__ __forceinline__ float bfhi(unsigned w) { return __builtin_bit_cast(float, w & 0xffff0000u); }
__device__ __forceinline__ float bf1(bf16_t h) { return __builtin_bit_cast(float, (unsigned)h << 16); }
__device__ __forceinline__ unsigned cvt_pk_bf16(float lo, float hi) { unsigned r; asm volatile("v_cvt_pk_bf16_f32 %0, %1, %2" : "=v"(r) : "v"(lo), "v"(hi)); return r; }
__device__ __forceinline__ float wave_sum(float v) {
#pragma unroll
    for (int o = 1; o < 64; o <<= 1) v += __shfl_xor(v, o);
    return v;
}
__device__ __forceinline__ float sin_rev(float r) { return __builtin_amdgcn_sinf(r); }
__device__ __forceinline__ float cos_rev(float r) { return __builtin_amdgcn_cosf(r); }
__device__ __forceinline__ float silu_f(float x) { return x * __builtin_amdgcn_rcpf(1.0f + __builtin_amdgcn_exp2f(-1.4426950408889634f * x)); }
#define LDS_WAIT() asm volatile("s_waitcnt lgkmcnt(0)" ::: "memory")

namespace pg8 {
constexpr int BM = 256, BK = 64, HALF = 128, HTB = HALF * BK * 2, STAGE_BYTES = 8 * HTB, NXCD = 8, WGM = 2;
__host__ __device__ __forceinline__ int lds_byte(int r, int c) { const int st = (r >> 4) * 2 + (c >> 5), rr = r & 15, cc = c & 31, ob = rr * 64 + cc * 2; return st * 1024 + (ob ^ (((ob >> 9) & 1) << 5)); }
__host__ __device__ __forceinline__ void stage_rc(int b, int& R, int& C) { const int st = b / 1024, sb = b % 1024, swz = sb ^ (((sb >> 9) & 1) << 5); R = (st >> 1) * 16 + swz / 64; C = (st & 1) * 32 + (swz % 64) / 2; }
__host__ __device__ __forceinline__ int perm32(int rho) { const int n = rho >> 4, i = rho & 15; return 8 * (i >> 2) + 4 * n + (i & 3); }

__device__ __forceinline__ void glds16s(const char* sbase, unsigned voff, unsigned lds_dst) { unsigned keep;
    asm volatile("s_mov_b32 %0, m0\n\ts_mov_b32 m0, %3\n\ts_nop 0\n\tglobal_load_lds_dwordx4 %1, %2\n\ts_mov_b32 m0, %0" : "=&s"(keep) : "v"(voff), "s"(sbase), "s"(lds_dst) : "memory"); }
struct Unit { int pm, pn; };
struct StaticOrder {
    int nM, nN, nwg, G, c;
    __device__ void init(int M, int N, int G_, int c_) { nM = M / BM; nN = N / BM; nwg = nM * nN; G = G_; c = c_; }
    __device__ bool next(int i, Unit& u) const {
        const long L = (long)i * G + c; if (L >= nwg) return false;
        int wgid = (int)L; { const int q = nwg / NXCD, r = nwg % NXCD, xcd = wgid % NXCD, off = wgid / NXCD; wgid = (xcd < r ? xcd * (q + 1) : r * (q + 1) + (xcd - r) * q) + off; }
        const int nig = WGM * nN, gid = wgid / nig, fm = gid * WGM, gsz = (nM - fm) < WGM ? (nM - fm) : WGM;
        u.pm = fm + ((wgid % nig) % gsz); u.pn = (wgid % nig) / gsz; return true;
    }
};
struct ProbStd {
    const char* A; const char* B; int K; unsigned rsA, rsB; size_t hsA, hsB, tsA, tsB;
    __device__ __forceinline__ const char* a_base(const Unit& u) const { return A + (size_t)u.pm * tsA; }
    __device__ __forceinline__ const char* b_base(const Unit& u) const { return B + (size_t)u.pn * tsB; }
};
__device__ __forceinline__ ProbStd make_std(const void* A, int lda, const void* B, int ldb, int K) {
    ProbStd p; p.A = (const char*)A; p.B = (const char*)B; p.K = K; p.rsA = lda * 2; p.rsB = ldb * 2;
    p.hsA = (size_t)128 * lda * 2; p.hsB = (size_t)128 * ldb * 2; p.tsA = 2 * p.hsA; p.tsB = 2 * p.hsB; return p;
}

template <class Epi, class Prob, bool ALIGN_EPI>
__device__ __forceinline__ void gemm_phase(LAS unsigned char* lds, const Prob& P, const StaticOrder& S, const Epi& E) {
    int tid = threadIdx.x; asm volatile("" : "+v"(tid));
    const int wid = __builtin_amdgcn_readfirstlane(tid >> 6), lane = tid & 63, wr = wid >> 2, wc = wid & 3, fr = lane & 15, fq = lane >> 4;
    const int nt = P.K / BK;
    unsigned voffA[2], voffB[2];
#pragma unroll
    for (int i = 0; i < 2; ++i) { int R, C; stage_rc(tid * 16 + i * 8192, R, C); const int Rb = (R & ~31) + perm32(R & 31);
        voffA[i] = (unsigned)R * P.rsA + (unsigned)C * 2u; voffB[i] = (unsigned)Rb * P.rsB + (unsigned)C * 2u; }
    const size_t kstep = (size_t)(BK * 2);
    const size_t hstepA = P.hsA, hstepB = P.hsB;
    const unsigned ldsw = (unsigned)wid * 1024u;
    const unsigned lds0 = (unsigned)(size_t)lds;
    const int aoff = lds_byte(wr * 64 + fr, fq * 8), boff = lds_byte(wc * 32 + fr, fq * 8);
#define PG8_SA(b, h) (((b) * 2 + (h)) * HTB)
#define PG8_SB(b, h) ((4 + (b) * 2 + (h)) * HTB)
#define PG8_STAGE(bufoff, gbase, voff) do { _Pragma("unroll") for (int _i = 0; _i < 2; ++_i) \
        glds16s((gbase), (voff)[_i], lds0 + (unsigned)(bufoff) + ldsw + _i * 8192u); } while (0)
#define PG8_LDA(dst, b, h) do { _Pragma("unroll") for (int m = 0; m < 4; ++m) _Pragma("unroll") for (int k = 0; k < 2; ++k) dst[m][k] = *(const LAS bf16x8*)(lds + PG8_SA(b, h) + aoff + m * 2048 + k * 1024); } while (0)
#define PG8_LDB(dst, b, h) do { _Pragma("unroll") for (int n = 0; n < 2; ++n) _Pragma("unroll") for (int k = 0; k < 2; ++k) dst[n][k] = *(const LAS bf16x8*)(lds + PG8_SB(b, h) + boff + n * 2048 + k * 1024); } while (0)
#define PG8_MMA(ai, bj, At, Bt) do { __builtin_amdgcn_s_setprio(1); _Pragma("unroll") for (int m = 0; m < 4; ++m) _Pragma("unroll") for (int n = 0; n < 2; ++n) _Pragma("unroll") for (int k = 0; k < 2; ++k) \
        acc[ai][bj][m][n] = __builtin_amdgcn_mfma_f32_16x16x32_bf16(Bt[n][k], At[m][k], acc[ai][bj][m][n], 0, 0, 0); __builtin_amdgcn_s_setprio(0); } while (0)
#define PG8_WAIT_V(n) asm volatile("s_waitcnt vmcnt(" #n ")" ::: "memory")
#define PG8_WAIT_L(n) asm volatile("s_waitcnt lgkmcnt(" #n ")" ::: "memory")
#define PG8_BAR __builtin_amdgcn_s_barrier()
#define PG8_SCHED __builtin_amdgcn_sched_barrier(0)
    Unit cur, nxt; int ui = 0;
    if (!S.next(0, cur)) return;
    f32x4 acc[2][2][4][2];
#pragma unroll
    for (int a = 0; a < 2; ++a)
#pragma unroll
        for (int b = 0; b < 2; ++b)
#pragma unroll
            for (int m = 0; m < 4; ++m)
#pragma unroll
                for (int n = 0; n < 2; ++n) acc[a][b][m][n] = (f32x4){0.f, 0.f, 0.f, 0.f};
    bf16x8 At[4][2], B0[2][2], B1[2][2];
    const char* cA = P.a_base(cur); const char* cB = P.b_base(cur);
    PG8_STAGE(PG8_SB(0, 0), cB, voffB); PG8_STAGE(PG8_SB(0, 1), cB + hstepB, voffB); PG8_STAGE(PG8_SA(0, 0), cA, voffA); PG8_STAGE(PG8_SA(0, 1), cA + hstepA, voffA);
    if (wr == 1) PG8_BAR;
    PG8_WAIT_V(2); PG8_BAR;
    PG8_STAGE(PG8_SB(1, 0), cB + kstep, voffB); PG8_STAGE(PG8_SA(1, 0), cA + kstep, voffA); PG8_STAGE(PG8_SB(1, 1), cB + hstepB + kstep, voffB);
    PG8_WAIT_V(6); PG8_BAR;
    for (;;) {
        const bool has_next = S.next(ui + 1, nxt);
        const char* nA = has_next ? P.a_base(nxt) : cA; const char* nB = has_next ? P.b_base(nxt) : cB;
        for (int t = 0; t < nt; t += 2) {
            const bool last = (t == nt - 2);
            const char* a1 = cA + (size_t)(t + 1) * kstep;
            const char* a2 = last ? nA : cA + (size_t)(t + 2) * kstep; const char* b2 = last ? nB : cB + (size_t)(t + 2) * kstep;
            const char* a3 = a2 + kstep; const char* b3 = b2 + kstep;
            PG8_LDB(B0, 0, 0); PG8_LDB(B1, 0, 1); PG8_SCHED; PG8_LDA(At, 0, 0); PG8_STAGE(PG8_SA(1, 1), a1 + hstepA, voffA);
            PG8_WAIT_V(8); PG8_WAIT_L(0); PG8_BAR; PG8_MMA(0, 0, At, B0); PG8_MMA(0, 1, At, B1); PG8_BAR; PG8_SCHED;
            PG8_LDA(At, 0, 1); PG8_STAGE(PG8_SB(0, 0), b2, voffB); PG8_STAGE(PG8_SB(0, 1), b2 + hstepB, voffB); PG8_STAGE(PG8_SA(0, 0), a2, voffA);
            PG8_WAIT_V(8); PG8_WAIT_L(0); PG8_BAR; PG8_MMA(1, 0, At, B0); PG8_MMA(1, 1, At, B1); PG8_BAR; PG8_SCHED;
            PG8_LDB(B0, 1, 0); PG8_LDB(B1, 1, 1); PG8_SCHED; PG8_LDA(At, 1, 0); PG8_STAGE(PG8_SA(0, 1), a2 + hstepA, voffA);
            PG8_WAIT_V(8); PG8_WAIT_L(0); PG8_BAR; PG8_MMA(0, 0, At, B0); PG8_MMA(0, 1, At, B1); PG8_BAR; PG8_SCHED;
            PG8_LDA(At, 1, 1); PG8_STAGE(PG8_SB(1, 0), b3, voffB); PG8_STAGE(PG8_SB(1, 1), b3 + hstepB, voffB); PG8_STAGE(PG8_SA(1, 0), a3, voffA);
            PG8_WAIT_V(8); PG8_WAIT_L(0); PG8_BAR; PG8_MMA(1, 0, At, B0); PG8_MMA(1, 1, At, B1); PG8_BAR; PG8_SCHED;
        }
        if constexpr (ALIGN_EPI) { if (wr == 0) PG8_BAR; }
        { int fr_ = fr, fq_ = fq; asm volatile("" : "+v"(fr_), "+v"(fq_)); E(acc, cur, wr, wc, fr_, fq_); }
        if (!has_next) break;
#pragma unroll
        for (int a = 0; a < 2; ++a)
#pragma unroll
            for (int b = 0; b < 2; ++b)
#pragma unroll
                for (int m = 0; m < 4; ++m)
#pragma unroll
                    for (int n = 0; n < 2; ++n) acc[a][b][m][n] = (f32x4){0.f, 0.f, 0.f, 0.f};
        cur = nxt; cA = nA; cB = nB; ++ui;
        if constexpr (ALIGN_EPI) { if (wr == 1) PG8_BAR; }
    }
    PG8_WAIT_V(0);
    if constexpr (!ALIGN_EPI) { if (wr == 0) PG8_BAR; }
    PG8_BAR;
#undef PG8_SA
#undef PG8_SB
#undef PG8_STAGE
#undef PG8_LDA
#undef PG8_LDB
#undef PG8_MMA
#undef PG8_WAIT_V
#undef PG8_WAIT_L
#undef PG8_BAR
#undef PG8_SCHED
}

typedef f32x4 Acc[2][2][4][2];
struct EpiBf16 {
    bf16_t* O; int ldc; int ncols;
    __device__ __forceinline__ void operator()(const Acc& acc, const Unit& u, int wr, int wc, int fr, int fq) const {
        const int row0 = u.pm * BM + wr * 64 + fr, col0 = u.pn * BM + wc * 32 + 8 * fq;
#pragma unroll
        for (int ai = 0; ai < 2; ++ai)
#pragma unroll
            for (int m = 0; m < 4; ++m) { bf16_t* rowp = O + (size_t)(row0 + ai * HALF + m * 16) * ldc + col0;
#pragma unroll
                for (int bj = 0; bj < 2; ++bj) { const f32x4 v0 = acc[ai][bj][m][0], v1 = acc[ai][bj][m][1];
                    u32x4 w; w.x = cvt_pk_bf16(v0[0], v0[1]); w.y = cvt_pk_bf16(v0[2], v0[3]); w.z = cvt_pk_bf16(v1[0], v1[1]); w.w = cvt_pk_bf16(v1[2], v1[3]);
                    if (col0 + bj * HALF < ncols) *(u32x4*)(rowp + bj * HALF) = w; } }
    }
};
__device__ __forceinline__ void ld8(const float* p, f32x4& a, f32x4& b) { a = __builtin_nontemporal_load((const f32x4*)p); b = __builtin_nontemporal_load((const f32x4*)(p + 4)); }
__device__ __forceinline__ void ld8(const bf16_t* p, f32x4& a, f32x4& b) { const u32x4 w = __builtin_nontemporal_load((const u32x4*)p); a = (f32x4){bflo(w.x), bfhi(w.x), bflo(w.y), bfhi(w.y)}; b = (f32x4){bflo(w.z), bfhi(w.z), bflo(w.w), bfhi(w.w)}; }
__device__ __forceinline__ void st8(float* p, const f32x4& a, const f32x4& b) { *(f32x4*)p = a; *(f32x4*)(p + 4) = b; }
__device__ __forceinline__ void st8(bf16_t* p, const f32x4& a, const f32x4& b) { u32x4 w; w.x = cvt_pk_bf16(a[0], a[1]); w.y = cvt_pk_bf16(a[2], a[3]); w.z = cvt_pk_bf16(b[0], b[1]); w.w = cvt_pk_bf16(b[2], b[3]); *(u32x4*)p = w; }
template <class TR, class TO> struct EpiResid {
    const TR* res; TO* out; const float* gate0; int gstride;
    __device__ __forceinline__ void operator()(const Acc& acc, const Unit& u, int wr, int wc, int fr, int fq) const {
        const int row0 = u.pm * BM + wr * 64 + fr, col0 = u.pn * BM + wc * 32 + 8 * fq;
        const float* gp = gate0 + (size_t)(u.pm >> 5) * gstride + col0;
        f32x4 g[2][2];
#pragma unroll
        for (int bj = 0; bj < 2; ++bj)
#pragma unroll
            for (int n = 0; n < 2; ++n) g[bj][n] = *(const f32x4*)(gp + bj * HALF + 4 * n);
#pragma unroll
        for (int ai = 0; ai < 2; ++ai)
#pragma unroll
            for (int m = 0; m < 4; ++m) { const size_t off = (size_t)(row0 + ai * HALF + m * 16) * 1024 + col0;
#pragma unroll
                for (int bj = 0; bj < 2; ++bj) { f32x4 r0, r1; ld8(res + off + bj * HALF, r0, r1);
                    st8(out + off + bj * HALF, r0 + g[bj][0] * acc[ai][bj][m][0], r1 + g[bj][1] * acc[ai][bj][m][1]); } }
    }
};
struct EpiSwiglu {
    bf16_t* H;
    __device__ __forceinline__ void operator()(const Acc& acc, const Unit& u, int wr, int wc, int fr, int fq) const {
        const int row0 = u.pm * BM + wr * 64 + fr, col0 = u.pn * HALF + wc * 32 + 8 * fq;
#pragma unroll
        for (int ai = 0; ai < 2; ++ai)
#pragma unroll
            for (int m = 0; m < 4; ++m) { bf16_t* rowp = H + (size_t)(row0 + ai * HALF + m * 16) * DFF + col0;
                f32x4 h0, h1;
#pragma unroll
                for (int j = 0; j < 4; ++j) { h0[j] = silu_f(acc[ai][0][m][0][j]) * acc[ai][1][m][0][j]; h1[j] = silu_f(acc[ai][0][m][1][j]) * acc[ai][1][m][1][j]; }
                u32x4 w; w.x = cvt_pk_bf16(h0[0], h0[1]); w.y = cvt_pk_bf16(h0[2], h0[3]); w.z = cvt_pk_bf16(h1[0], h1[1]); w.w = cvt_pk_bf16(h1[2], h1[3]);
                *(u32x4*)rowp = w; }
    }
};
struct EpiG1 {
    bf16_t* Z1;
    __device__ __forceinline__ void operator()(const Acc& acc, const Unit& u, int wr, int wc, int fr, int fq) const {
        const unsigned b = u.pn >> 5, q = u.pn & 31, ns0 = wc * 32 + 8 * fq;
        const unsigned j0 = u.pm * BM + wr * 64 + fr;
        const unsigned cs = j0 >> 10;
        bf16_t* base = Z1 + ((size_t)(b * 1024u) * 64u * 256u + (size_t)(2u * q) * 256u + cs * 128u + ns0);
#pragma unroll
        for (int ai = 0; ai < 2; ++ai)
#pragma unroll
            for (int m = 0; m < 4; ++m) { const unsigned ch = (j0 + ai * HALF + m * 16) & 1023u; bf16_t* rp = base + (size_t)ch * (64u * 256u);
#pragma unroll
                for (int bj = 0; bj < 2; ++bj) { const f32x4 v0 = acc[ai][bj][m][0], v1 = acc[ai][bj][m][1];
                    u32x4 w; w.x = cvt_pk_bf16(v0[0], v0[1]); w.y = cvt_pk_bf16(v0[2], v0[3]); w.z = cvt_pk_bf16(v1[0], v1[1]); w.w = cvt_pk_bf16(v1[2], v1[3]);
                    *(u32x4*)(rp + bj * 256) = w; }
                asm volatile("" ::: "memory"); }
    }
};
struct EpiG2 {
    bf16_t* G2;
    __device__ __forceinline__ void operator()(const Acc& acc, const Unit& u, int wr, int wc, int fr, int fq) const {
        const unsigned rho00 = u.pn * BM + wc * 32 + 8 * fq;
#pragma unroll
        for (int m = 0; m < 4; ++m) { const unsigned ka = wr * 64 + m * 16 + fr; const float kaf = (float)ka * (1.0f / 8192.0f);
#pragma unroll
            for (int bj = 0; bj < 2; ++bj) { const unsigned rho0 = rho00 + bj * HALF, bc = rho0 >> 6, nf0 = rho0 & 63u;
                bf16_t* dp = G2 + ((size_t)(bc * 128u + ka) * 128u + nf0);
                f32x4 o_r[2], o_i[2];
#pragma unroll
                for (int n = 0; n < 2; ++n) { const f32x4 gr = acc[0][bj][m][n], gi = acc[1][bj][m][n];
#pragma unroll
                    for (int j = 0; j < 4; ++j) { const float rev = (float)(nf0 + 4 * n + j) * kaf; const float c = cos_rev(rev), s = sin_rev(rev);
                        o_r[n][j] = gr[j] * c + gi[j] * s; o_i[n][j] = gi[j] * c - gr[j] * s; } }
                st8(dp, o_r[0], o_r[1]); st8(dp + 64, o_i[0], o_i[1]);
                asm volatile("" ::: "memory"); } }
    }
};
struct EpiG3 {
    bf16_t* out; const float* gate0; int gstride;
    __device__ __forceinline__ void operator()(const Acc& acc, const Unit& u, int wr, int wc, int fr, int fq) const {
        const int chblk = u.pn & 3, kag = (u.pn >> 2) & 31, b = u.pn >> 7, ch0 = chblk * 256 + wc * 32 + 8 * fq;
        const float* gp = gate0 + (size_t)b * gstride + ch0;
        f32x4 g[2][2];
#pragma unroll
        for (int bj = 0; bj < 2; ++bj)
#pragma unroll
            for (int n = 0; n < 2; ++n) g[bj][n] = *(const f32x4*)(gp + bj * HALF + 4 * n);
#pragma unroll
        for (int ai = 0; ai < 2; ++ai)
#pragma unroll
            for (int m = 0; m < 4; ++m) { const int r = ai * HALF + wr * 64 + m * 16 + fr, s = r >> 6, kb = r & 63;
                const size_t off = ((size_t)b * 8192 + 4 * kag + s + 128 * kb) * 1024 + ch0;
#pragma unroll
                for (int bj = 0; bj < 2; ++bj) { f32x4 r0, r1; ld8(out + off + bj * HALF, r0, r1);
                    st8(out + off + bj * HALF, r0 + g[bj][0] * acc[ai][bj][m][0], r1 + g[bj][1] * acc[ai][bj][m][1]); } }
    }
};
struct ProbWc {
    const char* WfT; const char* D; int K; unsigned rsA, rsB; size_t hsA, hsB;
    __device__ __forceinline__ const char* a_base(const Unit& u) const { return WfT + ((size_t)(u.pm & 3) * 256 * 1024 + (size_t)u.pn * 256) * 2; }
    __device__ __forceinline__ const char* b_base(const Unit& u) const { return D + (size_t)(u.pm >> 2) * 256 * 256 * 2; }
};
struct ProbG1 {
    const char* WcT; const char* XN; int K; unsigned rsA, rsB; size_t hsA, hsB;
    __device__ __forceinline__ const char* a_base(const Unit& u) const { return WcT + (size_t)u.pm * 256 * 1024 * 2; }
    __device__ __forceinline__ const char* b_base(const Unit& u) const { return XN + ((size_t)(u.pn >> 5) * 8192 + 2 * (u.pn & 31)) * 2048; }
};
struct ProbG3 {
    const char* W2d; const char* G2; int K; unsigned rsA, rsB; size_t hsA, hsB;
    __device__ __forceinline__ const char* a_base(const Unit&) const { return W2d; }
    __device__ __forceinline__ const char* b_base(const Unit& u) const { const int chblk = u.pn & 3, kag = (u.pn >> 2) & 31, b = u.pn >> 7;
        return G2 + (((size_t)(b * 1024 + chblk * 256) * 128 + 4 * kag) * 128) * 2; }
};
}

#define RLX_AGENT __ATOMIC_RELAXED, __HIP_MEMORY_SCOPE_AGENT
#define XB_TMO      128
#define XB_XCNT(j)  (256  + 64 * (j))
#define XB_XSUB(j)  (1280 + 64 * (j))
#define XB_XGEN(j)  (2304 + 64 * (j))
#define XB_TOP      3328
#define XB_TOPGEN   3392
#define XCD_BAR_WORDS 3456
#define XB_SPIN_CAP (1u << 18)

__device__ __forceinline__ unsigned xb_ld(unsigned* p)              { return __hip_atomic_load(p, __ATOMIC_RELAXED, __HIP_MEMORY_SCOPE_AGENT); }
__device__ __forceinline__ unsigned xb_add(unsigned* p, unsigned v) { return __hip_atomic_fetch_add(p, v, __ATOMIC_RELAXED, __HIP_MEMORY_SCOPE_AGENT); }
__device__ __forceinline__ unsigned xb_xcc_id() { return (unsigned)__builtin_amdgcn_s_getreg((3 << 11) | 20) & 0xFu; }
#define XB_SPIN(cond, bar) do { unsigned _sp = 0; while (cond) { __builtin_amdgcn_s_sleep(1); \
    if ((++_sp & 255u) == 0u) { if (xb_ld(&(bar)[XB_TMO])) break; if (_sp > XB_SPIN_CAP) { atomicAdd(&(bar)[XB_TMO], 1u); break; } } } } while (0)

struct XcdBarrier {
    unsigned* bar; unsigned x;
    volatile LAS unsigned* st;
};

__device__ __forceinline__ XcdBarrier xcd_barrier_post(unsigned* bar, volatile LAS unsigned* st) {
    XcdBarrier b; b.bar = bar; b.x = xb_xcc_id(); b.st = st;
    if (threadIdx.x == 0) (void)xb_add(&bar[XB_XCNT(b.x)], 1u);
    return b;
}
__device__ __forceinline__ void xcd_barrier_complete(unsigned* bar, unsigned x, unsigned& nloc, unsigned& nx) {
    const unsigned G = gridDim.x * gridDim.y * gridDim.z;
    unsigned sum, cnt, mine, sp = 0u;
    for (;;) {
        sum = 0u; cnt = 0u; mine = 0u;
#pragma unroll
        for (unsigned j = 0; j < 16; ++j) { const unsigned c = xb_ld(&bar[XB_XCNT(j)]); sum += c; cnt += (c > 0u) ? 1u : 0u; mine = (j == x) ? c : mine; }
        if (sum == G) break;
        __builtin_amdgcn_s_sleep(1);
        if ((++sp & 255u) == 0u) { if (xb_ld(&bar[XB_TMO])) break; if (sp > XB_SPIN_CAP) { atomicAdd(&bar[XB_TMO], 1u); break; } }
    }
    nloc = mine > 0u ? mine : 1u; nx = cnt > 0u ? cnt : 1u;
}

__device__ __forceinline__ void xcd_barrier(const XcdBarrier& b) {
    asm volatile("s_waitcnt vmcnt(0)" ::: "memory");
    __syncthreads();
    if (threadIdx.x == 0) {
        unsigned* bar = b.bar;
        __builtin_amdgcn_s_waitcnt(0);
        unsigned nloc = b.st[0], nx = b.st[1];
        if (nloc == 0u) { xcd_barrier_complete(bar, b.x, nloc, nx); b.st[0] = nloc; b.st[1] = nx; }
        const unsigned old = xb_add(&bar[XB_XSUB(b.x)], 1u);
        const unsigned gen = old / nloc;
        if (old + 1u == (gen + 1u) * nloc) {
            __builtin_amdgcn_fence(__ATOMIC_RELEASE, "agent");
            asm volatile("s_waitcnt vmcnt(0)" ::: "memory");
            const unsigned og = xb_add(&bar[XB_TOP], 1u);
            const unsigned tg = og / nx;
            if (og + 1u == (tg + 1u) * nx) xb_add(&bar[XB_TOPGEN], 1u);
            else XB_SPIN(xb_ld(&bar[XB_TOPGEN]) == tg, bar);
            __builtin_amdgcn_fence(__ATOMIC_ACQUIRE, "agent");
            xb_add(&bar[XB_XGEN(b.x)], 1u);
            asm volatile("s_waitcnt vmcnt(0)" ::: "memory");
        } else {
            XB_SPIN(xb_ld(&bar[XB_XGEN(b.x)]) == gen, bar);
            __builtin_amdgcn_fence(__ATOMIC_ACQUIRE, "agent");
            asm volatile("s_waitcnt vmcnt(0)" ::: "memory");
        }
    }
    __syncthreads();
}
struct Args {
    const float* in[21]; float* out; unsigned char* ws;
};
constexpr int NWAVES = 8, NTHR = 512;
constexpr int LDS_BYTES = 147456;

__device__ __forceinline__ void ada_item(const Args& a, int item, LAS unsigned char* lds, int tid, int lane, int wave) {
    const int layer = item / 96, n0 = (item % 96) * 64;
    LAS float* sil = (LAS float*)lds; LAS float* red = sil + 3072;
    const float* c = a.in[1]; const float* cc = a.in[3];
    for (int i = tid; i < 3072; i += NTHR) { const int v = i >> 10, k = i & 1023; const float cv = (v < 2) ? c[v * 1024 + k] : cc[k]; sil[i] = cv / (1.0f + __expf(-cv)); }
    __syncthreads();
    const float* W = a.in[4] + (size_t)layer * 1024 * 6144 + n0 + lane;
    float a0 = 0.f, a1 = 0.f, a2 = 0.f; const int k0 = wave * 128;
#pragma unroll 8
    for (int kk = 0; kk < 128; ++kk) { const int k = k0 + kk; const float w = __builtin_nontemporal_load(W + (size_t)k * 6144); a0 += sil[k] * w; a1 += sil[1024 + k] * w; a2 += sil[2048 + k] * w; }
    red[(wave * 3 + 0) * 64 + lane] = a0; red[(wave * 3 + 1) * 64 + lane] = a1; red[(wave * 3 + 2) * 64 + lane] = a2;
    __syncthreads();
    if (tid < 192) { const int v = tid >> 6, l = tid & 63; float s = a.in[5][layer * 6144 + n0 + l];
#pragma unroll
        for (int w = 0; w < 8; ++w) s += red[(w * 3 + v) * 64 + l];
        ((float*)(a.ws + WS_MOD))[(layer * 3 + v) * 6144 + n0 + l] = s; }
    __syncthreads();
}
__device__ __forceinline__ void transpose_item(const float* W, int N, bf16_t* WT, int ldk, int k0, int n0, int drow0, LAS float* scr, int lane, const float* kscale = nullptr) {
#pragma unroll 8
    for (int i = 0; i < 32; ++i) { const int kk = 2 * i + (lane >> 5); float w = __builtin_nontemporal_load(W + (size_t)(k0 + kk) * N + n0 + (lane & 31)); if (kscale) w *= kscale[k0 + kk]; scr[kk * 33 + (lane & 31)] = w; }
    LDS_WAIT(); asm volatile("" ::: "memory");
    const int c = lane & 7;
#pragma unroll
    for (int j = 0; j < 4; ++j) { const int n = (lane >> 3) + 8 * j; const LAS float* s = scr + (8 * c) * 33 + n;
        u32x4 o; o.x = pk2(s[0 * 33], s[1 * 33]); o.y = pk2(s[2 * 33], s[3 * 33]); o.z = pk2(s[4 * 33], s[5 * 33]); o.w = pk2(s[6 * 33], s[7 * 33]);
        *(u32x4*)(WT + (size_t)(drow0 + n) * ldk + k0 + 8 * c) = o; }
    LDS_WAIT(); asm volatile("" ::: "memory");
}
__device__ __forceinline__ void p0_prologue(const Args& a, LAS unsigned char* lds, int tid, int lane, int wave) {
    asm volatile("" : "+v"(lane), "+v"(tid));
    unsigned char* ws = a.ws;
    if (blockIdx.x < 192) ada_item(a, blockIdx.x, lds, tid, lane, wave);
    LAS float* scr = (LAS float*)(lds + wave * 16384);
    const int gw = blockIdx.x * NWAVES + wave, NGW = gridDim.x * NWAVES;
    constexpr int I_IN = 16 * 69, I_UQ = 6 * 24, I_UKV = 4 * 32, I_O = 512, I_F = 512, I_13 = 16 * 88, I_2 = 44 * 32;
    constexpr int NITEMS = I_IN + I_UQ + I_UKV + I_O + I_F + 2 * (2 * I_13 + I_2);
    for (int it = gw; it < NITEMS; it += NGW) {
        int r = it;
        if (r < I_IN) { const int kb = r / 69, nb = r % 69; transpose_item(a.in[8], NIN, (bf16_t*)(ws + WS_WIN), 1024, 64 * kb, 32 * nb, 32 * nb, scr, lane); continue; } r -= I_IN;
        if (r < I_UQ) { const int kb = r / 24, nb = r % 24; transpose_item(a.in[11], 768, (bf16_t*)(ws + WS_WUQ), 384, 64 * kb, 32 * nb, 32 * nb, scr, lane, a.in[9]); continue; } r -= I_UQ;
        if (r < I_UKV) { const int kb = r / 32, nb = r % 32; transpose_item(a.in[12], 1024, (bf16_t*)(ws + WS_WUKV), 256, 64 * kb, 32 * nb, 32 * nb, scr, lane, a.in[10]); continue; } r -= I_UKV;
        if (r < I_O) { const int kb = r / 32, nb = r % 32; transpose_item(a.in[16], 1024, (bf16_t*)(ws + WS_WO), 1024, 64 * kb, 32 * nb, 32 * nb, scr, lane); continue; } r -= I_O;
        if (r < I_F) { const int kb = r / 32, nb = r % 32; transpose_item(a.in[17], 1024, (bf16_t*)(ws + WS_WF), 1024, 64 * kb, 32 * nb, 32 * nb, scr, lane); continue; } r -= I_F;
        const int layer = r / (2 * I_13 + I_2); r -= layer * (2 * I_13 + I_2);
        if (r < 2 * I_13) { const int s = r / I_13; r -= s * I_13; const int kb = r / 88, nb = r % 88, n0 = 32 * nb;
            transpose_item(a.in[s ? 19 : 18] + (size_t)layer * 1024 * DFF, DFF, (bf16_t*)(ws + WS_W13 + layer * W13_BYTES), 1024, 64 * kb, n0, 256 * (n0 >> 7) + 128 * s + (n0 & 127), scr, lane); continue; }
        r -= 2 * I_13;
        { const int kb = r / 32, nb = r % 32; transpose_item(a.in[20] + (size_t)layer * DFF * 1024, 1024, (bf16_t*)(ws + WS_W2 + layer * W2_BYTES), DFF, 64 * kb, 32 * nb, 32 * nb, scr, lane); }
    }
    const int gt = blockIdx.x * NTHR + tid, NGT = gridDim.x * NTHR;
    { unsigned* z = (unsigned*)(ws + WS_WIN + (size_t)NIN * 1024 * 2); for (int i = gt; i < 96 * 1024 / 2; i += NGT) z[i] = 0u; }
    { bf16_t* d = (bf16_t*)(ws + WS_D256);
      for (int i = gt; i < 131072; i += NGT) { const int cs = i >> 16, c = (i >> 8) & 255, cp = i & 255; const float rev = (float)((c * cp) & 255) * (1.0f / 256.0f);
          const float v = cs ? -sin_rev(rev) : cos_rev(rev); d[i] = (bf16_t)f2bf(v * 0.0625f); } }
    { bf16_t* d = (bf16_t*)(ws + WS_W1D);
      for (int i = gt; i < 65536; i += NGT) { const int row = i >> 8, col = i & 255, ro = row >> 7, ka = row & 127, ri = col >> 7, n = col & 127; const float rev = (float)((n * ka) & 127) * (1.0f / 128.0f);
          const float c = cos_rev(rev), s = sin_rev(rev); const float v = (ro == 0) ? (ri == 0 ? c : s) : (ri == 0 ? -s : c); d[i] = (bf16_t)f2bf(v * 0.08838834764831845f); } }
    { bf16_t* d = (bf16_t*)(ws + WS_W2D);
      for (int i = gt; i < 256 * 512; i += NGT) { const int row = i >> 9, col = i & 511, s = row >> 6, kb = row & 63, sp = col >> 7, ri = (col >> 6) & 1, n2 = col & 63; float v = 0.f;
          if (s == sp) { const float rev = (float)((n2 * kb) & 63) * (1.0f / 64.0f); v = (ri == 0 ? cos_rev(rev) : sin_rev(rev)) * 0.125f; }
          d[i] = (bf16_t)f2bf(v); } }
}

__device__ __forceinline__ void norm_pass(const float* src, int nrows, bf16_t* dst, const float* g, const float* mod, int sh_chunk, int vfixed, int lane, int wave) {
    asm volatile("" : "+v"(lane));
    const int gw = blockIdx.x * NWAVES + wave, NGW = gridDim.x * NWAVES;
    const int nb = vfixed >= 0 ? 1 : 2;
#pragma unroll 1
    for (int b = 0; b < nb; ++b) {
        const int v = vfixed >= 0 ? vfixed : b; const float* mv = mod + v * 6144 + sh_chunk * 1024;
        f32x4 cg[4], cs[4];
#pragma unroll
        for (int j = 0; j < 4; ++j) { const int c = (j >> 1) * 512 + lane * 8 + (j & 1) * 4; const f32x4 gg = *(const f32x4*)(g + c), sc = *(const f32x4*)(mv + 1024 + c); cg[j] = gg * (sc + 1.0f); cs[j] = *(const f32x4*)(mv + c); }
        const int rlo = vfixed >= 0 ? 0 : b * 8192, rhi = vfixed >= 0 ? nrows : (b + 1) * 8192;
        for (int r = rlo + gw; r < rhi && r < nrows; r += NGW) {
            const float* xrow = src + (size_t)r * 1024; bf16_t* orow = dst + (size_t)r * 1024;
            f32x4 x[4]; pg8::ld8(xrow + lane * 8, x[0], x[1]); pg8::ld8(xrow + 512 + lane * 8, x[2], x[3]); float s = 0.f;
#pragma unroll
            for (int j = 0; j < 4; ++j) s += (x[j].x * x[j].x + x[j].y * x[j].y) + (x[j].z * x[j].z + x[j].w * x[j].w);
            const float rstd = rsqrtf(wave_sum(s) * (1.0f / 1024.0f) + EPS);
            pg8::st8(orow + lane * 8, x[0] * rstd * cg[0] + cs[0], x[1] * rstd * cg[1] + cs[1]);
            pg8::st8(orow + 512 + lane * 8, x[2] * rstd * cg[2] + cs[2], x[3] * rstd * cg[3] + cs[3]);
        }
    }
}
__device__ __forceinline__ void norm_pass_b(const bf16_t* src, int nrows, bf16_t* dst, const float* g, const float* mod, int sh_chunk, int lane, int wave) {
    asm volatile("" : "+v"(lane));
    const int G8 = gridDim.x >> 3;
    if ((gridDim.x & 7) == 0 && nrows == 8 * 2048) {
        const int x = blockIdx.x & 7, lw = (blockIdx.x >> 3) * NWAVES + wave, nlw = G8 * NWAVES, b = x >> 2;
        const float* mv = mod + b * 6144 + sh_chunk * 1024;
        f32x4 cg[4], cs[4];
#pragma unroll
        for (int j = 0; j < 4; ++j) { const int c = (j >> 1) * 512 + lane * 8 + (j & 1) * 4; const f32x4 gg = *(const f32x4*)(g + c), sc = *(const f32x4*)(mv + 1024 + c); cg[j] = gg * (sc + 1.0f); cs[j] = *(const f32x4*)(mv + c); }
        for (int rr = lw; rr < 2048; rr += nlw) { const int r = 2048 * x + rr;
            const bf16_t* xrow = src + (size_t)r * 1024; bf16_t* orow = dst + (size_t)r * 1024;
            f32x4 v[4]; pg8::ld8(xrow + lane * 8, v[0], v[1]); pg8::ld8(xrow + 512 + lane * 8, v[2], v[3]); float s = 0.f;
#pragma unroll
            for (int j = 0; j < 4; ++j) s += (v[j].x * v[j].x + v[j].y * v[j].y) + (v[j].z * v[j].z + v[j].w * v[j].w);
            const float rstd = rsqrtf(wave_sum(s) * (1.0f / 1024.0f) + EPS);
            pg8::st8(orow + lane * 8, v[0] * rstd * cg[0] + cs[0], v[1] * rstd * cg[1] + cs[1]);
            pg8::st8(orow + 512 + lane * 8, v[2] * rstd * cg[2] + cs[2], v[3] * rstd * cg[3] + cs[3]); }
        return;
    }
    const int gw = blockIdx.x * NWAVES + wave, NGW = gridDim.x * NWAVES;
#pragma unroll 1
    for (int b = 0; b < 2; ++b) {
        const float* mv = mod + b * 6144 + sh_chunk * 1024;
        f32x4 cg[4], cs[4];
#pragma unroll
        for (int j = 0; j < 4; ++j) { const int c = (j >> 1) * 512 + lane * 8 + (j & 1) * 4; const f32x4 gg = *(const f32x4*)(g + c), sc = *(const f32x4*)(mv + 1024 + c); cg[j] = gg * (sc + 1.0f); cs[j] = *(const f32x4*)(mv + c); }
        for (int r = b * 8192 + gw; r < (b + 1) * 8192 && r < nrows; r += NGW) {
            const bf16_t* xrow = src + (size_t)r * 1024; bf16_t* orow = dst + (size_t)r * 1024;
            f32x4 v[4]; pg8::ld8(xrow + lane * 8, v[0], v[1]); pg8::ld8(xrow + 512 + lane * 8, v[2], v[3]); float s = 0.f;
#pragma unroll
            for (int j = 0; j < 4; ++j) s += (v[j].x * v[j].x + v[j].y * v[j].y) + (v[j].z * v[j].z + v[j].w * v[j].w);
            const float rstd = rsqrtf(wave_sum(s) * (1.0f / 1024.0f) + EPS);
            pg8::st8(orow + lane * 8, v[0] * rstd * cg[0] + cs[0], v[1] * rstd * cg[1] + cs[1]);
            pg8::st8(orow + 512 + lane * 8, v[2] * rstd * cg[2] + cs[2], v[3] * rstd * cg[3] + cs[3]);
        }
    }
}

__device__ __forceinline__ float sumsq8(u32x4 c) { float s = 0.f;
#pragma unroll
    for (int i = 0; i < 4; ++i) { const float a = bflo(c[i]), b = bfhi(c[i]); s += a * a + b * b; } return s; }
__device__ __forceinline__ u32x4 scale8(u32x4 c, float r, const float* g) { const f32x4 g0 = *(const f32x4*)g, g1 = *(const f32x4*)(g + 4); u32x4 o;
    o.x = pk2(bflo(c.x) * r * g0.x, bfhi(c.x) * r * g0.y); o.y = pk2(bflo(c.y) * r * g0.z, bfhi(c.y) * r * g0.w);
    o.z = pk2(bflo(c.z) * r * g1.x, bfhi(c.z) * r * g1.y); o.w = pk2(bflo(c.w) * r * g1.z, bfhi(c.w) * r * g1.w); return o; }
__device__ __forceinline__ void conv_pass(const Args& a, int lane, int wave) {
    asm volatile("" : "+v"(lane));
    unsigned char* ws = a.ws;
    const bf16_t* P = (const bf16_t*)(ws + WS_B); bf16_t* MIX = (bf16_t*)(ws + WS_A);
    const float* cw = a.in[15];
    f32x4 w0[2], w1[2], w2[2];
#pragma unroll
    for (int i = 0; i < 2; ++i) { w0[i] = *(const f32x4*)(cw + 8 * lane + 4 * i); w1[i] = *(const f32x4*)(cw + 512 + 8 * lane + 4 * i); w2[i] = *(const f32x4*)(cw + 1024 + 8 * lane + 4 * i); }
    const int gw = blockIdx.x * NWAVES + wave, NGW = gridDim.x * NWAVES;
    for (int r = gw; r < ML; r += NGW) {
        const int t = r & (SEQ - 1);
        const bf16_t* cb = P + (size_t)r * PLD + 672 + 8 * lane;
        const u32x4 bg = *(const u32x4*)cb, cg0 = *(const u32x4*)(cb + 512), u0 = *(const u32x4*)(cb + 1024);
        u32x4 cgm = (u32x4){0u, 0u, 0u, 0u}, um = cgm, cgp = cgm, up = cgm;
        if (t > 0) { cgm = *(const u32x4*)(cb - PLD + 512); um = *(const u32x4*)(cb - PLD + 1024); }
        if (t < SEQ - 1) { cgp = *(const u32x4*)(cb + PLD + 512); up = *(const u32x4*)(cb + PLD + 1024); }
        u32x4 o;
#pragma unroll
        for (int i = 0; i < 4; ++i) {
            const float zl_m = bflo(cgm[i]) * bflo(um[i]), zh_m = bfhi(cgm[i]) * bfhi(um[i]);
            const float zl_0 = bflo(cg0[i]) * bflo(u0[i]), zh_0 = bfhi(cg0[i]) * bfhi(u0[i]);
            const float zl_p = bflo(cgp[i]) * bflo(up[i]), zh_p = bfhi(cgp[i]) * bfhi(up[i]);
            const int e = 2 * i;
            const float yl = zl_m * w0[e >> 2][e & 3] + zl_0 * w1[e >> 2][e & 3] + zl_p * w2[e >> 2][e & 3];
            const float yh = zh_m * w0[(e + 1) >> 2][(e + 1) & 3] + zh_0 * w1[(e + 1) >> 2][(e + 1) & 3] + zh_p * w2[(e + 1) >> 2][(e + 1) & 3];
            o[i] = pk2(bflo(bg[i]) * yl, bfhi(bg[i]) * yh);
        }
        *(u32x4*)(MIX + (size_t)r * 1024 + 512 + 8 * lane) = o;
    }
}

__device__ __forceinline__ void prep2_pass(const Args& a, LAS unsigned char* lds, int tid, int lane, int wave) {
    asm volatile("" : "+v"(lane), "+v"(tid));
    unsigned char* ws = a.ws;
    bf16_t* Q = (bf16_t*)(ws + WS_Q); const bf16_t* KV = (const bf16_t*)(ws + WS_KV); const bf16_t* P = (const bf16_t*)(ws + WS_B);
    LAS float* rkl = (LAS float*)(lds + 65536);
    bf16_t* Kf = (bf16_t*)(ws + WS_KF); bf16_t* Vt = (bf16_t*)(ws + WS_VT);
    const float* qgain = a.in[13]; const float* kgain = a.in[14];
    const int head = lane >> 3, sub = lane & 7;
    const float inv = __builtin_amdgcn_exp2f(-(float)sub * 1.6609640474436813f) * 0.15915494309189535f;
    float qgn[8], kgn[8], qgp[4], kgp[4];
#pragma unroll
    for (int e = 0; e < 8; ++e) { qgn[e] = qgain[8 * sub + e] * QSC; kgn[e] = kgain[8 * sub + e]; }
#pragma unroll
    for (int i = 0; i < 4; ++i) { qgp[i] = qgain[64 + sub + 8 * i] * QSC; kgp[i] = kgain[64 + sub + 8 * i]; }
    constexpr int PB = 16, RW = PB / 8;
    for (int blk = blockIdx.x; blk < MT / PB; blk += gridDim.x) {
        const int r0 = blk * PB; const bool latent = blk < ML / PB;
        const int b = latent ? (blk / (SEQ / PB)) : ((blk - ML / PB) / (256 / PB));
        const int key0 = latent ? ((blk % (SEQ / PB)) * PB) : (SEQ + ((blk - ML / PB) % (256 / PB)) * PB);
#pragma unroll
        for (int i = 0; i < PB / 8; ++i) { const int id = tid + 512 * i, row = id >> 6, cc = id & 63, h = cc >> 3, part = cc & 7;
            const u32x4 v = *(const u32x4*)(KV + (size_t)(r0 + row) * 1024 + h * 128 + 64 + part * 8);
            *(LAS u32x4*)(lds + row * 1024 + cc * 16) = v; }
        for (int i = 0; i < RW; ++i) {
            const int r = r0 + RW * wave + i, kl = RW * wave + i;
            float cr = 1.f, sr = 0.f, ccol = 1.f, scol = 0.f;
            if (latent) { const int t = r & (SEQ - 1); const float ar = (float)(t >> 6) * inv, ac = (float)(t & 63) * inv;
                cr = cos_rev(ar - floorf(ar)); sr = sin_rev(ar - floorf(ar)); ccol = cos_rev(ac - floorf(ac)); scol = sin_rev(ac - floorf(ac)); }
            const bf16_t* prow = P + (size_t)r * PLD; const bf16_t* kpe = prow + 640;
            float rq, rkv;
            { const u32x4 c1 = *(const u32x4*)(prow + lane * 8); u32x4 c2 = (u32x4){0u, 0u, 0u, 0u}; if (lane < 16) c2 = *(const u32x4*)(prow + 512 + lane * 8);
              const float ss1 = sumsq8(c1), ss2 = sumsq8(c2);
              const float sq = wave_sum(lane < 48 ? ss1 : 0.f), skv = wave_sum((lane >= 48 ? ss1 : 0.f) + ss2);
              rq = rsqrtf(sq * (1.0f / 384.0f) + EPS); rkv = rsqrtf(skv * (1.0f / 256.0f) + EPS); if (lane == 0) rkl[kl] = rkv; }
            if (latent) {
                bf16_t* qp = Q + (size_t)r * 768 + head * 96;
                const u32x4 nv = *(const u32x4*)(qp + 8 * sub);
                float pe[4];
#pragma unroll
                for (int j = 0; j < 4; ++j) pe[j] = bf1(qp[64 + sub + 8 * j]) * rq;
                float ss = sumsq8(nv) * (rq * rq) + (pe[0] * pe[0] + pe[1] * pe[1]) + (pe[2] * pe[2] + pe[3] * pe[3]);
                ss += __shfl_xor(ss, 1); ss += __shfl_xor(ss, 2); ss += __shfl_xor(ss, 4);
                const float rs0 = rsqrtf(ss * (1.0f / 96.0f) + EPS), rs = rs0 * rq;
                u32x4 o; o.x = pk2(bflo(nv.x) * rs * qgn[0], bfhi(nv.x) * rs * qgn[1]); o.y = pk2(bflo(nv.y) * rs * qgn[2], bfhi(nv.y) * rs * qgn[3]);
                o.z = pk2(bflo(nv.z) * rs * qgn[4], bfhi(nv.z) * rs * qgn[5]); o.w = pk2(bflo(nv.w) * rs * qgn[6], bfhi(nv.w) * rs * qgn[7]);
                *(u32x4*)(qp + 8 * sub) = o;
                const float p0 = pe[0] * rs0 * qgp[0], p1 = pe[1] * rs0 * qgp[1], p2 = pe[2] * rs0 * qgp[2], p3 = pe[3] * rs0 * qgp[3];
                qp[64 + sub] = (bf16_t)f2bf(p0 * cr - p1 * sr); qp[72 + sub] = (bf16_t)f2bf(p1 * cr + p0 * sr);
                qp[80 + sub] = (bf16_t)f2bf(p2 * ccol - p3 * scol); qp[88 + sub] = (bf16_t)f2bf(p3 * ccol + p2 * scol);
            }
            {
                const u32x4 nv = *(const u32x4*)(KV + (size_t)r * 1024 + head * 128 + 8 * sub);
                float pe[4];
#pragma unroll
                for (int j = 0; j < 4; ++j) pe[j] = bf1(kpe[sub + 8 * j]);
                float ss = sumsq8(nv) * (rkv * rkv) + (pe[0] * pe[0] + pe[1] * pe[1]) + (pe[2] * pe[2] + pe[3] * pe[3]);
                ss += __shfl_xor(ss, 1); ss += __shfl_xor(ss, 2); ss += __shfl_xor(ss, 4);
                const float rs0 = rsqrtf(ss * (1.0f / 96.0f) + EPS), rs = rs0 * rkv;
                bf16_t* kp = Kf + ((size_t)(b * NH + head) * NKEY + key0 + kl) * DQK;
                u32x4 o; o.x = pk2(bflo(nv.x) * rs * kgn[0], bfhi(nv.x) * rs * kgn[1]); o.y = pk2(bflo(nv.y) * rs * kgn[2], bfhi(nv.y) * rs * kgn[3]);
                o.z = pk2(bflo(nv.z) * rs * kgn[4], bfhi(nv.z) * rs * kgn[5]); o.w = pk2(bflo(nv.w) * rs * kgn[6], bfhi(nv.w) * rs * kgn[7]);
                *(u32x4*)(kp + 8 * sub) = o;
                const float p0 = pe[0] * rs0 * kgp[0], p1 = pe[1] * rs0 * kgp[1], p2 = pe[2] * rs0 * kgp[2], p3 = pe[3] * rs0 * kgp[3];
                kp[64 + sub] = (bf16_t)f2bf(p0 * cr - p1 * sr); kp[72 + sub] = (bf16_t)f2bf(p1 * cr + p0 * sr);
                kp[80 + sub] = (bf16_t)f2bf(p2 * ccol - p3 * scol); kp[88 + sub] = (bf16_t)f2bf(p3 * ccol + p2 * scol);
            }
        }
        __syncthreads();
        { const int h = tid >> 6, d = tid & 63; bf16_t* vp = Vt + ((size_t)(b * NH + h) * 64 + d) * NKEY + key0;
#pragma unroll
          for (int i = 0; i < PB / 8; ++i) { float e[8];
#pragma unroll
              for (int k = 0; k < 8; ++k) e[k] = bf1(*(const LAS unsigned short*)(lds + (8 * i + k) * 1024 + tid * 2)) * rkl[8 * i + k];
              u32x4 o; o.x = pk2(e[0], e[1]); o.y = pk2(e[2], e[3]); o.z = pk2(e[4], e[5]); o.w = pk2(e[6], e[7]);
              *(u32x4*)(vp + 8 * i) = o; } }
        __syncthreads();
    }
}

__device__ __forceinline__ float attn_rowmax(const f32x16& p0, const f32x16& p1) {
    float a = __builtin_fmaxf(__builtin_fmaxf(p0[0], p0[1]), p1[0]), b = __builtin_fmaxf(__builtin_fmaxf(p0[2], p0[3]), p1[1]);
    a = __builtin_fmaxf(__builtin_fmaxf(a, p1[2]), p1[3]);
#pragma unroll
    for (int r = 4; r < 16; r += 4) { a = __builtin_fmaxf(__builtin_fmaxf(a, p0[r]), p0[r + 1]); b = __builtin_fmaxf(__builtin_fmaxf(b, p0[r + 2]), p0[r + 3]);
        a = __builtin_fmaxf(__builtin_fmaxf(a, p1[r]), p1[r + 1]); b = __builtin_fmaxf(__builtin_fmaxf(b, p1[r + 2]), p1[r + 3]); }
    const float mx = __builtin_fmaxf(a, b);
    auto rr = __builtin_amdgcn_permlane32_swap(__float_as_uint(mx), __float_as_uint(mx), false, false);
    return __builtin_fmaxf(__uint_as_float(rr[0]), __uint_as_float(rr[1]));
}
__device__ __forceinline__ void attn_phase(const Args& a, LAS unsigned char* lds, int tid, int lane, int wid) {
    asm volatile("" : "+v"(lane), "+v"(tid));
    unsigned char* ws = a.ws;
    const bf16_t* Q = (const bf16_t*)(ws + WS_Q); const char* Kf = (const char*)(ws + WS_KF); const char* Vt = (const char*)(ws + WS_VT); bf16_t* MIX = (bf16_t*)(ws + WS_A);
    constexpr int NS = 4, KSLOT = 13312, VBASE = NS * KSLOT, VSLOT = 8192, NT = NKEY / 64;
    constexpr float THR = 8.0f;
    const int q = lane & 31, hi = lane >> 5;
    const int xcd = blockIdx.x & 7, l = blockIdx.x >> 3;
    const unsigned lds0 = (unsigned)(size_t)lds;
    unsigned koff[2];
#pragma unroll
    for (int i = 0; i < 2; ++i) { const int p = 64 * (wid + 8 * i) + lane, row = p / 13, c = p % 13, r31 = row & 31;
        const int key = (row & 32) + ((r31 & 19) | ((r31 & 4) << 1) | ((r31 & 8) >> 1)); koff[i] = (unsigned)(key * 192 + (c < 12 ? c : 11) * 16); }
    const bool k2 = wid < 5;
    unsigned voffv; { const int d = 8 * wid + (lane >> 3), cp = lane & 7, c = cp ^ ((d >> 1) & 7); voffv = (unsigned)(d * (NKEY * 2) + c * 16); }
    const unsigned kdst0 = lds0 + (unsigned)wid * 1024u, kdst1 = lds0 + (unsigned)(wid + 8) * 1024u, vdst = lds0 + VBASE + (unsigned)wid * 1024u;
    const int kro = q * 208 + hi * 16;
    int vro[4];
#pragma unroll
    for (int s = 0; s < 4; ++s) vro[s] = VBASE + q * 128 + (((2 * s + hi) ^ ((q >> 1) & 7)) * 16);
#define DMA_K(tile, slot) do { const char* kb_ = Kh + (size_t)(tile) * (64 * 192); pg8::glds16s(kb_, koff[0], kdst0 + (slot) * KSLOT); if (k2) pg8::glds16s(kb_, koff[1], kdst1 + (slot) * KSLOT); } while (0)
#define DMA_V(tile, slot) pg8::glds16s(Vh + (size_t)(tile) * 128, voffv, vdst + (slot) * VSLOT)
#define SBAR() do {} while (0)
#define EXP2(P, R) do { P[R] = __builtin_amdgcn_exp2f(P[R]); P[R + 1] = __builtin_amdgcn_exp2f(P[R + 1]); rs2 += (f32x2){P[R], P[R + 1]}; } while (0)
#define PKP(P, B) __builtin_bit_cast(bf16x8, (u32x4){cvt_pk_bf16(P[B], P[B + 1]), cvt_pk_bf16(P[B + 2], P[B + 3]), cvt_pk_bf16(P[B + 4], P[B + 5]), cvt_pk_bf16(P[B + 6], P[B + 7])})
    for (int it = 0; it < 2; ++it) {
        const int bh = 2 * xcd + it, b = bh >> 3, h = bh & 7, qb = l;
        const size_t qrow = (size_t)b * SEQ + qb * 256 + wid * 32 + q;
        const char* Kh = Kf + (size_t)bh * NKEY * 192; const char* Vh = Vt + (size_t)bh * 64 * NKEY * 2;
        DMA_K(0, 0); DMA_K(1, 1); DMA_V(0, 0); DMA_K(2, 2); DMA_V(1, 1); DMA_K(3, 3); DMA_V(2, 2);
        bf16x8 qf[6];
#pragma unroll
        for (int d0 = 0; d0 < 6; ++d0) qf[d0] = *(const bf16x8*)(Q + qrow * 768 + h * 96 + d0 * 16 + hi * 8);
        asm volatile("s_waitcnt vmcnt(0) lgkmcnt(0)\n\ts_barrier" ::: "memory");
        f32x16 pc0 = {}, pc1 = {};
#pragma unroll
        for (int d0 = 0; d0 < 6; ++d0) {
            const bf16x8 a0 = *(const LAS bf16x8*)(lds + kro + d0 * 32), a1 = *(const LAS bf16x8*)(lds + kro + 32 * 208 + d0 * 32);
            pc0 = __builtin_amdgcn_mfma_f32_32x32x16_bf16(a0, qf[d0], pc0, 0, 0, 0); pc1 = __builtin_amdgcn_mfma_f32_32x32x16_bf16(a1, qf[d0], pc1, 0, 0, 0);
        }
        float m = attn_rowmax(pc0, pc1), lsum = 0.f;
#pragma unroll
        for (int r = 0; r < 16; ++r) { pc0[r] -= m; pc1[r] -= m; }
        f32x16 o0 = {}, o1 = {};
        f32x2 rs2 = (f32x2){0.f, 0.f};
        f32x16 negm;
#pragma unroll
        for (int r = 0; r < 16; ++r) negm[r] = -m;
        asm volatile("" : "+v"(negm));
        asm volatile("s_waitcnt lgkmcnt(0)\n\ts_barrier" ::: "memory");
#define ATT_ITER(PC0, PC1, PN0, PN1, T) do { \
            { const int tk_ = ((T) + 4 < NT) ? (T) + 4 : NT - 1, tv_ = ((T) + 3 < NT) ? (T) + 3 : NT - 1; DMA_K(tk_, (T) & 3); DMA_V(tv_, ((T) + 3) & 3); } \
            const LAS unsigned char* kn = lds + (((T) + 1) & 3) * KSLOT + kro; \
            bf16x8 kfa[6], kfb[6]; \
            _Pragma("unroll") for (int d0 = 0; d0 < 3; ++d0) { kfa[2 * d0] = *(const LAS bf16x8*)(kn + d0 * 32); kfa[2 * d0 + 1] = *(const LAS bf16x8*)(kn + 32 * 208 + d0 * 32); } \
            SBAR(); \
            PN0 = __builtin_amdgcn_mfma_f32_32x32x16_bf16(kfa[0], qf[0], negm, 0, 0, 0); EXP2(PC0, 0); SBAR(); \
            _Pragma("unroll") for (int d0 = 3; d0 < 6; ++d0) { kfb[2 * (d0 - 3)] = *(const LAS bf16x8*)(kn + d0 * 32); kfb[2 * (d0 - 3) + 1] = *(const LAS bf16x8*)(kn + 32 * 208 + d0 * 32); } \
            SBAR(); \
            PN1 = __builtin_amdgcn_mfma_f32_32x32x16_bf16(kfa[1], qf[0], negm, 0, 0, 0); EXP2(PC0, 2); SBAR(); \
            PN0 = __builtin_amdgcn_mfma_f32_32x32x16_bf16(kfa[2], qf[1], PN0, 0, 0, 0); EXP2(PC0, 4); EXP2(PC0, 6); SBAR(); \
            PN1 = __builtin_amdgcn_mfma_f32_32x32x16_bf16(kfa[3], qf[1], PN1, 0, 0, 0); EXP2(PC0, 8); SBAR(); \
            PN0 = __builtin_amdgcn_mfma_f32_32x32x16_bf16(kfa[4], qf[2], PN0, 0, 0, 0); EXP2(PC0, 10); EXP2(PC0, 12); SBAR(); \
            PN1 = __builtin_amdgcn_mfma_f32_32x32x16_bf16(kfa[5], qf[2], PN1, 0, 0, 0); EXP2(PC0, 14); SBAR(); \
            const LAS unsigned char* vb = lds + ((T) & 3) * VSLOT; \
            bf16x8 va[8]; \
            _Pragma("unroll") for (int s = 0; s < 4; ++s) { va[2 * s] = *(const LAS bf16x8*)(vb + vro[s]); va[2 * s + 1] = *(const LAS bf16x8*)(vb + vro[s] + 32 * 128); } \
            SBAR(); \
            PN0 = __builtin_amdgcn_mfma_f32_32x32x16_bf16(kfb[0], qf[3], PN0, 0, 0, 0); EXP2(PC1, 0); EXP2(PC1, 2); SBAR(); \
            PN1 = __builtin_amdgcn_mfma_f32_32x32x16_bf16(kfb[1], qf[3], PN1, 0, 0, 0); EXP2(PC1, 4); SBAR(); \
            PN0 = __builtin_amdgcn_mfma_f32_32x32x16_bf16(kfb[2], qf[4], PN0, 0, 0, 0); EXP2(PC1, 6); EXP2(PC1, 8); SBAR(); \
            PN1 = __builtin_amdgcn_mfma_f32_32x32x16_bf16(kfb[3], qf[4], PN1, 0, 0, 0); EXP2(PC1, 10); SBAR(); \
            PN0 = __builtin_amdgcn_mfma_f32_32x32x16_bf16(kfb[4], qf[5], PN0, 0, 0, 0); EXP2(PC1, 12); SBAR(); \
            PN1 = __builtin_amdgcn_mfma_f32_32x32x16_bf16(kfb[5], qf[5], PN1, 0, 0, 0); EXP2(PC1, 14); SBAR(); \
            { const bf16x8 pb0 = PKP(PC0, 0); \
              o0 = __builtin_amdgcn_mfma_f32_32x32x16_bf16(va[0], pb0, o0, 0, 0, 0); o1 = __builtin_amdgcn_mfma_f32_32x32x16_bf16(va[1], pb0, o1, 0, 0, 0); \
              const bf16x8 pb1 = PKP(PC0, 8); \
              o0 = __builtin_amdgcn_mfma_f32_32x32x16_bf16(va[2], pb1, o0, 0, 0, 0); o1 = __builtin_amdgcn_mfma_f32_32x32x16_bf16(va[3], pb1, o1, 0, 0, 0); \
              const bf16x8 pb2 = PKP(PC1, 0); \
              o0 = __builtin_amdgcn_mfma_f32_32x32x16_bf16(va[4], pb2, o0, 0, 0, 0); o1 = __builtin_amdgcn_mfma_f32_32x32x16_bf16(va[5], pb2, o1, 0, 0, 0); \
              const bf16x8 pb3 = PKP(PC1, 8); \
              o0 = __builtin_amdgcn_mfma_f32_32x32x16_bf16(va[6], pb3, o0, 0, 0, 0); o1 = __builtin_amdgcn_mfma_f32_32x32x16_bf16(va[7], pb3, o1, 0, 0, 0); } \
            if (k2) asm volatile("s_waitcnt vmcnt(6) lgkmcnt(0)\n\ts_barrier" ::: "memory"); \
            else asm volatile("s_waitcnt vmcnt(4) lgkmcnt(0)\n\ts_barrier" ::: "memory"); \
        } while (0)
        f32x16 pd0, pd1;
        static_assert(NT % 2 == 0, "two tiles per loop trip");
        for (int t = 0; t < NT; t += 2) {
            ATT_ITER(pc0, pc1, pd0, pd1, t);
            ATT_ITER(pd0, pd1, pc0, pc1, t + 1);
        }
#undef ATT_ITER
        lsum += rs2.x + rs2.y;
        const float lt = lsum + __shfl_xor(lsum, 32); const float il = 1.0f / lt;
        bf16_t* op = MIX + qrow * 1024 + h * 64 + 4 * hi;
#pragma unroll
        for (int g = 0; g < 4; ++g) {
            u32x2 w0, w1; w0.x = cvt_pk_bf16(o0[4 * g] * il, o0[4 * g + 1] * il); w0.y = cvt_pk_bf16(o0[4 * g + 2] * il, o0[4 * g + 3] * il);
            w1.x = cvt_pk_bf16(o1[4 * g] * il, o1[4 * g + 1] * il); w1.y = cvt_pk_bf16(o1[4 * g + 2] * il, o1[4 * g + 3] * il);
            *(u32x2*)(op + 8 * g) = w0; *(u32x2*)(op + 32 + 8 * g) = w1;
        }
        asm volatile("s_waitcnt vmcnt(0) lgkmcnt(0)\n\ts_barrier" ::: "memory");
    }
#undef DMA_K
#undef DMA_V
#undef SBAR
#undef EXP2
#undef PKP
}

__global__ void __launch_bounds__(NTHR, 2) fwd_kernel(Args a) {
    extern __shared__ __attribute__((aligned(16))) unsigned char lds_raw[];
    LAS unsigned char* lds = (LAS unsigned char*)lds_raw;
    cg::grid_group grid = cg::this_grid();
    unsigned* barw = (unsigned*)a.ws;
    volatile LAS unsigned* bst = (volatile LAS unsigned*)(lds_raw + 131072 + 64);
    if (threadIdx.x < 2) bst[threadIdx.x] = 0u;
    __syncthreads();
    XcdBarrier xbar = xcd_barrier_post(barw, bst);
    if (a.out == nullptr) grid.sync();
#define GSYNC() do { for (int s_ = 0; s_ < PROBE_SYNC; ++s_) xcd_barrier(xbar); } while (0)
    const int tid = threadIdx.x, lane = tid & 63, wave = __builtin_amdgcn_readfirstlane(tid >> 6);
    const int G = gridDim.x, cu = blockIdx.x;
    unsigned char* ws = a.ws;
    const float* mod = (const float*)(ws + WS_MOD);
    bf16_t* XN = (bf16_t*)(ws + WS_A);
    bf16_t* XB = (bf16_t*)(ws + WS_XB);

    p0_prologue(a, lds, tid, lane, wave);
    GSYNC();
    norm_pass(a.in[0], ML, XN, a.in[6], mod, 0, -1, lane, wave);
    norm_pass(a.in[2], MC, XN + (size_t)ML * 1024, a.in[6], mod, 0, 2, lane, wave);
    GSYNC();
    { pg8::ProbStd p = pg8::make_std(XN, 1024, ws + WS_WIN, 1024, 1024); pg8::StaticOrder S; S.init(MT, NINP, G, cu);
      pg8::EpiBf16 E{(bf16_t*)(ws + WS_B), PLD, NIN}; pg8::gemm_phase<pg8::EpiBf16, pg8::ProbStd, true>(lds, p, S, E); }
    { pg8::ProbWc p{(const char*)(ws + WS_WF), (const char*)(ws + WS_D256), 256, 1024 * 2, 256 * 2, (size_t)128 * 1024 * 2, (size_t)128 * 256 * 2};
      pg8::StaticOrder S; S.init(2048, 1024, G, (cu + 32) & 255);
      pg8::EpiBf16 E{(bf16_t*)(ws + WS_WC), 1024, 1 << 30}; pg8::gemm_phase<pg8::EpiBf16, pg8::ProbWc, true>(lds, p, S, E); }
    GSYNC();
    { pg8::ProbStd p = pg8::make_std(ws + WS_B, PLD, ws + WS_WUQ, QR, QR); pg8::StaticOrder S; S.init(ML, 768, G, cu);
      pg8::EpiBf16 E{(bf16_t*)(ws + WS_Q), 768, 1 << 30}; pg8::gemm_phase<pg8::EpiBf16, pg8::ProbStd, true>(lds, p, S, E); }
    { pg8::ProbStd p = pg8::make_std(ws + WS_B + QR * 2, PLD, ws + WS_WUKV, KVR, KVR); pg8::StaticOrder S; S.init(MT, 1024, G, (cu + 64) & 255);
      pg8::EpiBf16 E{(bf16_t*)(ws + WS_KV), 1024, 1 << 30}; pg8::gemm_phase<pg8::EpiBf16, pg8::ProbStd, true>(lds, p, S, E); }
    GSYNC();
    prep2_pass(a, lds, tid, lane, wave);
    conv_pass(a, lane, wave);
    GSYNC();
    for (int p_ = 0; p_ < PROBE_ATTN; ++p_) attn_phase(a, lds, tid, lane, wave);
    GSYNC();
    { pg8::ProbStd p = pg8::make_std(ws + WS_A, 1024, ws + WS_WO, 1024, 1024); pg8::StaticOrder S; S.init(ML, 1024, G, cu);
      typedef pg8::EpiResid<float, bf16_t> EP; EP E{a.in[0], XB, mod + 2 * 1024, 6144}; pg8::gemm_phase<EP, pg8::ProbStd, true>(lds, p, S, E); }
    GSYNC();
#pragma unroll
    for (int layer = 0; layer < 2; ++layer) {
        const float* modl = mod + layer * 3 * 6144;
        if (layer == 1) {
            norm_pass_b(XB, ML, XN, a.in[6] + 1024, modl, 0, lane, wave);
            GSYNC();
            { pg8::ProbG1 p{(const char*)(ws + WS_WC), (const char*)XN, 1024, 1024 * 2, 64 * 2048, (size_t)128 * 1024 * 2, (size_t)2048};
              pg8::StaticOrder S; S.init(2048, 16384, G, cu);
              pg8::EpiG1 E{(bf16_t*)(ws + WS_Z1)}; pg8::gemm_phase<pg8::EpiG1, pg8::ProbG1, true>(lds, p, S, E); }
            GSYNC();
            { pg8::ProbStd p = pg8::make_std(ws + WS_W1D, 256, ws + WS_Z1, 256, 256); pg8::StaticOrder S; S.init(256, 131072, G, cu);
              pg8::EpiG2 E{(bf16_t*)(ws + WS_G2)}; pg8::gemm_phase<pg8::EpiG2, pg8::ProbStd, true>(lds, p, S, E); }
            GSYNC();
            { pg8::ProbG3 p{(const char*)(ws + WS_W2D), (const char*)(ws + WS_G2), 512, 512 * 2, 128 * 128 * 2, (size_t)128 * 512 * 2, (size_t)128 * 128 * 128 * 2};
              pg8::StaticOrder S; S.init(256, 65536, G, cu);
              pg8::EpiG3 E{XB, modl + 2 * 1024, 6144}; pg8::gemm_phase<pg8::EpiG3, pg8::ProbG3, true>(lds, p, S, E); }
            GSYNC();
        }
        norm_pass_b(XB, ML, XN, a.in[7] + layer * 1024, modl, 3, lane, wave);
        GSYNC();
        { pg8::ProbStd p = pg8::make_std(XN, 1024, ws + WS_W13 + layer * W13_BYTES, 1024, 1024); pg8::StaticOrder S; S.init(ML, 2 * DFF, G, cu);
          pg8::EpiSwiglu E{(bf16_t*)(ws + WS_H)}; for (int p_ = 0; p_ < PROBE_FFNUP; ++p_) pg8::gemm_phase<pg8::EpiSwiglu, pg8::ProbStd, true>(lds, p, S, E); }
        GSYNC();
        { pg8::ProbStd p = pg8::make_std(ws + WS_H, DFF, ws + WS_W2 + layer * W2_BYTES, DFF, DFF); pg8::StaticOrder S; S.init(ML, 1024, G, cu);
          if (layer == 0) { typedef pg8::EpiResid<bf16_t, bf16_t> EP; EP E{XB, XB, modl + 5 * 1024, 6144}; pg8::gemm_phase<EP, pg8::ProbStd, true>(lds, p, S, E); }
          else { typedef pg8::EpiResid<bf16_t, float> EP; EP E{XB, a.out, modl + 5 * 1024, 6144}; pg8::gemm_phase<EP, pg8::ProbStd, true>(lds, p, S, E); } }
        if (layer == 0) GSYNC();
    }
}

extern "C" void kernel_launch(void* const* d_in, const int* in_sizes, int n_in, void* d_out, int out_size, void* d_ws, size_t ws_size, hipStream_t stream) {
    static int grid = 0;
    if (grid == 0) {
        if (n_in != 21 || out_size != ML * DM || ws_size < WS_END) { fprintf(stderr, "kernel_launch: unexpected problem (n_in %d out %d ws %zu)\n", n_in, out_size, ws_size); grid = -1; return; }
        int dev = 0, cus = 0, per_cu = 0;
        (void)hipGetDevice(&dev);
        (void)hipDeviceGetAttribute(&cus, hipDeviceAttributeMultiprocessorCount, dev);
        (void)hipFuncSetAttribute((const void*)fwd_kernel, hipFuncAttributeMaxDynamicSharedMemorySize, LDS_BYTES);
        (void)hipOccupancyMaxActiveBlocksPerMultiprocessor(&per_cu, (const void*)fwd_kernel, NTHR, LDS_BYTES);
        (void)hipGetLastError();
        grid = 256;
        if (cus < 256 || per_cu < 1) fprintf(stderr, "kernel_launch: cus %d per_cu %d\n", cus, per_cu);
    }
    if (grid < 0) return;
    Args a{};
    for (int i = 0; i < 21; ++i) a.in[i] = (const float*)d_in[i];
    a.out = (float*)d_out; a.ws = (unsigned char*)d_ws;
    (void)hipMemsetAsync(d_ws, 0, 16384, stream);
    void* args[] = {&a};
    hipError_t e = hipLaunchCooperativeKernel((const void*)fwd_kernel, dim3(grid), dim3(NTHR), args, LDS_BYTES, stream);
    if (e != hipSuccess) fprintf(stderr, "cooperative launch failed: %s\n", hipGetErrorString(e));
}
```

```cpp
#include <hip/hip_runtime.h>
#include <hip/hip_cooperative_groups.h>
#include <cstdio>
#include <cstdint>
namespace cg = cooperative_groups;
#ifndef PROBE_SYNC
#define PROBE_SYNC 1
#endif
#ifndef PROBE_ATTN
#define PROBE_ATTN 1
#endif
#ifndef PROBE_FFNUP
#define PROBE_FFNUP 1
#endif

#define LAS __attribute__((address_space(3)))
typedef unsigned short bf16_t;
typedef short bf16x8 __attribute__((ext_vector_type(8)));
typedef short s16x4 __attribute__((ext_vector_type(4)));
typedef float f32x4 __attribute__((ext_vector_type(4)));
typedef float f32x16 __attribute__((ext_vector_type(16)));
typedef unsigned u32x4 __attribute__((ext_vector_type(4)));
typedef unsigned u32x2 __attribute__((ext_vector_type(2)));
typedef float f32x2 __attribute__((ext_vector_type(2)));

constexpr int DM = 1024, SEQ = 8192, ML = 16384, MC = 512, MT = ML + MC;
constexpr int NINP = 2304, NIN = 2208, QR = 384, KVR = 256, NH = 8, DQK = 96, DFF = 2816, NKEY = 8448;
constexpr float EPS = 1e-6f;
constexpr float QSC = 0.10206207261596575f * 1.4426950408889634f;

constexpr size_t MiB = 1u << 20;
constexpr size_t WS_MOD = 1 * MiB;
constexpr size_t WS_WIN = 2 * MiB;
constexpr size_t WS_WUQ = WS_WIN + (size_t)NINP * 1024 * 2;
constexpr size_t WS_WUKV = WS_WUQ + (size_t)768 * 384 * 2;
constexpr size_t WS_WO = WS_WUKV + (size_t)1024 * 256 * 2;
constexpr size_t WS_WF = WS_WO + 2 * MiB;
constexpr size_t WS_WC = WS_WF + 2 * MiB;
constexpr size_t WS_D256 = WS_WC + 4 * MiB;
constexpr size_t WS_W1D = WS_D256 + 262144;
constexpr size_t WS_W2D = WS_W1D + 131072;
constexpr size_t WS_W13 = WS_W2D + 262144;
constexpr size_t W13_BYTES = (size_t)2 * DFF * 1024 * 2;
constexpr size_t WS_W2 = WS_W13 + 2 * W13_BYTES;
constexpr size_t W2_BYTES = (size_t)1024 * DFF * 2;
constexpr size_t WS_WEND = WS_W2 + 2 * W2_BYTES;
static_assert(WS_WEND <= 52 * MiB, "weights");
constexpr size_t WS_A = 52 * MiB;
constexpr int PLD = 2208;
constexpr size_t WS_B = 85 * MiB;
constexpr size_t WS_Q = 157 * MiB;
constexpr size_t WS_KV = 181 * MiB;
constexpr size_t WS_KF = 214 * MiB;
constexpr size_t WS_VT = 239 * MiB;
constexpr size_t WS_H = WS_B;
constexpr size_t WS_Z1 = WS_B;
constexpr size_t WS_G2 = WS_B + 64 * MiB;
constexpr size_t WS_XB = 218 * MiB;
constexpr size_t WS_END = 256 * MiB;

__device__ __forceinline__ unsigned f2bf(float f) { unsigned u = __builtin_bit_cast(unsigned, f); return (u + 0x7fffu + ((u >> 16) & 1u)) >> 16; }
__device__ __forceinline__ unsigned pk2(float lo, float hi) { return f2bf(lo) | (f2bf(hi) << 16); }
__device__ __forceinline__ float bflo(unsigned w) { return __builtin_bit_cast(float, w << 16); }
__device__ __forceinline__ float bfhi(unsigned w) { return __builtin_bit_cast(float, w & 0xffff0000u); }
__device__ __forceinline__ float bf1(bf16_t h) { return __builtin_bit_cast(float, (unsigned)h << 16); }
__device__ __forceinline__ unsigned cvt_pk_bf16(float lo, float hi) { unsigned r; asm volatile("v_cvt_pk_bf16_f32 %0, %1, %2" : "=v"(r) : "v"(lo), "v"(hi)); return r; }
__device__ __forceinline__ float wave_sum(float v) {
#pragma unroll
    for (int o = 1; o < 64; o <<= 1) v += __shfl_xor(v, o);
    return v;
}
__device__ __forceinline__ float sin_rev(float r) { return __builtin_amdgcn_sinf(r); }
__device__ __forceinline__ float cos_rev(float r) { return __builtin_amdgcn_cosf(r); }
__device__ __forceinline__ float silu_f(float x) { return x * __builtin_amdgcn_rcpf(1.0f + __builtin_amdgcn_exp2f(-1.4426950408889634f * x)); }
#define LDS_WAIT() asm volatile("s_waitcnt lgkmcnt(0)" ::: "memory")

namespace pg8 {
constexpr int BM = 256, BK = 64, HALF = 128, HTB = HALF * BK * 2, STAGE_BYTES = 8 * HTB, NXCD = 8, WGM = 2;
__host__ __device__ __forceinline__ int lds_byte(int r, int c) { const int st = (r >> 4) * 2 + (c >> 5), rr = r & 15, cc = c & 31, ob = rr * 64 + cc * 2; return st * 1024 + (ob ^ (((ob >> 9) & 1) << 5)); }
__host__ __device__ __forceinline__ void stage_rc(int b, int& R, int& C) { const int st = b / 1024, sb = b % 1024, swz = sb ^ (((sb >> 9) & 1) << 5); R = (st >> 1) * 16 + swz / 64; C = (st & 1) * 32 + (swz % 64) / 2; }
__host__ __device__ __forceinline__ int perm32(int rho) { const int n = rho >> 4, i = rho & 15; return 8 * (i >> 2) + 4 * n + (i & 3); }

__device__ __forceinline__ void glds16s(const char* sbase, unsigned voff, unsigned lds_dst) { unsigned keep;
    asm volatile("s_mov_b32 %0, m0\n\ts_mov_b32 m0, %3\n\ts_nop 0\n\tglobal_load_lds_dwordx4 %1, %2\n\ts_mov_b32 m0, %0" : "=&s"(keep) : "v"(voff), "s"(sbase), "s"(lds_dst) : "memory"); }
struct Unit { int pm, pn; };
struct StaticOrder {
    int nM, nN, nwg, G, c;
    __device__ void init(int M, int N, int G_, int c_) { nM = M / BM; nN = N / BM; nwg = nM * nN; G = G_; c = c_; }
    __device__ bool next(int i, Unit& u) const {
        const long L = (long)i * G + c; if (L >= nwg) return false;
        int wgid = (int)L; { const int q = nwg / NXCD, r = nwg % NXCD, xcd = wgid % NXCD, off = wgid / NXCD; wgid = (xcd < r ? xcd * (q + 1) : r * (q + 1) + (xcd - r) * q) + off; }
        const int nig = WGM * nN, gid = wgid / nig, fm = gid * WGM, gsz = (nM - fm) < WGM ? (nM - fm) : WGM;
        u.pm = fm + ((wgid % nig) % gsz); u.pn = (wgid % nig) / gsz; return true;
    }
};
struct ProbStd {
    const char* A; const char* B; int K; unsigned rsA, rsB; size_t hsA, hsB, tsA, tsB;
    __device__ __forceinline__ const char* a_base(const Unit& u) const { return A + (size_t)u.pm * tsA; }
    __device__ __forceinline__ const char* b_base(const Unit& u) const { return B + (size_t)u.pn * tsB; }
};
__device__ __forceinline__ ProbStd make_std(const void* A, int lda, const void* B, int ldb, int K) {
    ProbStd p; p.A = (const char*)A; p.B = (const char*)B; p.K = K; p.rsA = lda * 2; p.rsB = ldb * 2;
    p.hsA = (size_t)128 * lda * 2; p.hsB = (size_t)128 * ldb * 2; p.tsA = 2 * p.hsA; p.tsB = 2 * p.hsB; return p;
}

template <class Epi, class Prob, bool ALIGN_EPI>
__device__ __forceinline__ void gemm_phase(LAS unsigned char* lds, const Prob& P, const StaticOrder& S, const Epi& E) {
    int tid = threadIdx.x; asm volatile("" : "+v"(tid));
    const int wid = __builtin_amdgcn_readfirstlane(tid >> 6), lane = tid & 63, wr = wid >> 2, wc = wid & 3, fr = lane & 15, fq = lane >> 4;
    const int nt = P.K / BK;
    unsigned voffA[2], voffB[2];
#pragma unroll
    for (int i = 0; i < 2; ++i) { int R, C; stage_rc(tid * 16 + i * 8192, R, C); const int Rb = (R & ~31) + perm32(R & 31);
        voffA[i] = (unsigned)R * P.rsA + (unsigned)C * 2u; voffB[i] = (unsigned)Rb * P.rsB + (unsigned)C * 2u; }
    const size_t kstep = (size_t)(BK * 2);
    const size_t hstepA = P.hsA, hstepB = P.hsB;
    const unsigned ldsw = (unsigned)wid * 1024u;
    const unsigned lds0 = (unsigned)(size_t)lds;
    const int aoff = lds_byte(wr * 64 + fr, fq * 8), boff = lds_byte(wc * 32 + fr, fq * 8);
#define PG8_SA(b, h) (((b) * 2 + (h)) * HTB)
#define PG8_SB(b, h) ((4 + (b) * 2 + (h)) * HTB)
#define PG8_STAGE(bufoff, gbase, voff) do { _Pragma("unroll") for (int _i = 0; _i < 2; ++_i) \
        glds16s((gbase), (voff)[_i], lds0 + (unsigned)(bufoff) + ldsw + _i * 8192u); } while (0)
#define PG8_LDA(dst, b, h) do { _Pragma("unroll") for (int m = 0; m < 4; ++m) _Pragma("unroll") for (int k = 0; k < 2; ++k) dst[m][k] = *(const LAS bf16x8*)(lds + PG8_SA(b, h) + aoff + m * 2048 + k * 1024); } while (0)
#define PG8_LDB(dst, b, h) do { _Pragma("unroll") for (int n = 0; n < 2; ++n) _Pragma("unroll") for (int k = 0; k < 2; ++k) dst[n][k] = *(const LAS bf16x8*)(lds + PG8_SB(b, h) + boff + n * 2048 + k * 1024); } while (0)
#define PG8_MMA(ai, bj, At, Bt) do { __builtin_amdgcn_s_setprio(1); _Pragma("unroll") for (int m = 0; m < 4; ++m) _Pragma("unroll") for (int n = 0; n < 2; ++n) _Pragma("unroll") for (int k = 0; k < 2; ++k) \
        acc[ai][bj][m][n] = __builtin_amdgcn_mfma_f32_16x16x32_bf16(Bt[n][k], At[m][k], acc[ai][bj][m][n], 0, 0, 0); __builtin_amdgcn_s_setprio(0); } while (0)
#define PG8_WAIT_V(n) asm volatile("s_waitcnt vmcnt(" #n ")" ::: "memory")
#define PG8_WAIT_L(n) asm volatile("s_waitcnt lgkmcnt(" #n ")" ::: "memory")
#define PG8_BAR __builtin_amdgcn_s_barrier()
#define PG8_SCHED __builtin_amdgcn_sched_barrier(0)
    Unit cur, nxt; int ui = 0;
    if (!S.next(0, cur)) return;
    f32x4 acc[2][2][4][2];
#pragma unroll
    for (int a = 0; a < 2; ++a)
#pragma unroll
        for (int b = 0; b < 2; ++b)
#pragma unroll
            for (int m = 0; m < 4; ++m)
#pragma unroll
                for (int n = 0; n < 2; ++n) acc[a][b][m][n] = (f32x4){0.f, 0.f, 0.f, 0.f};
    bf16x8 At[4][2], B0[2][2], B1[2][2];
    const char* cA = P.a_base(cur); const char* cB = P.b_base(cur);
    PG8_STAGE(PG8_SB(0, 0), cB, voffB); PG8_STAGE(PG8_SB(0, 1), cB + hstepB, voffB); PG8_STAGE(PG8_SA(0, 0), cA, voffA); PG8_STAGE(PG8_SA(0, 1), cA + hstepA, voffA);
    if (wr == 1) PG8_BAR;
    PG8_WAIT_V(2); PG8_BAR;
    PG8_STAGE(PG8_SB(1, 0), cB + kstep, voffB); PG8_STAGE(PG8_SA(1, 0), cA + kstep, voffA); PG8_STAGE(PG8_SB(1, 1), cB + hstepB + kstep, voffB);
    PG8_WAIT_V(6); PG8_BAR;
    for (;;) {
        const bool has_next = S.next(ui + 1, nxt);
        const char* nA = has_next ? P.a_base(nxt) : cA; const char* nB = has_next ? P.b_base(nxt) : cB;
        for (int t = 0; t < nt; t += 2) {
            const bool last = (t == nt - 2);
            const char* a1 = cA + (size_t)(t + 1) * kstep;
            const char* a2 = last ? nA : cA + (size_t)(t + 2) * kstep; const char* b2 = last ? nB : cB + (size_t)(t + 2) * kstep;
            const char* a3 = a2 + kstep; const char* b3 = b2 + kstep;
            PG8_LDB(B0, 0, 0); PG8_LDB(B1, 0, 1); PG8_SCHED; PG8_LDA(At, 0, 0); PG8_STAGE(PG8_SA(1, 1), a1 + hstepA, voffA);
            PG8_WAIT_V(8); PG8_WAIT_L(0); PG8_BAR; PG8_MMA(0, 0, At, B0); PG8_MMA(0, 1, At, B1); PG8_BAR; PG8_SCHED;
            PG8_LDA(At, 0, 1); PG8_STAGE(PG8_SB(0, 0), b2, voffB); PG8_STAGE(PG8_SB(0, 1), b2 + hstepB, voffB); PG8_STAGE(PG8_SA(0, 0), a2, voffA);
            PG8_WAIT_V(8); PG8_WAIT_L(0); PG8_BAR; PG8_MMA(1, 0, At, B0); PG8_MMA(1, 1, At, B1); PG8_BAR; PG8_SCHED;
            PG8_LDB(B0, 1, 0); PG8_LDB(B1, 1, 1); PG8_SCHED; PG8_LDA(At, 1, 0); PG8_STAGE(PG8_SA(0, 1), a2 + hstepA, voffA);
            PG8_WAIT_V(8); PG8_WAIT_L(0); PG8_BAR; PG8_MMA(0, 0, At, B0); PG8_MMA(0, 1, At, B1); PG8_BAR; PG8_SCHED;
            PG8_LDA(At, 1, 1); PG8_STAGE(PG8_SB(1, 0), b3, voffB); PG8_STAGE(PG8_SB(1, 1), b3 + hstepB, voffB); PG8_STAGE(PG8_SA(1, 0), a3, voffA);
            PG8_WAIT_V(8); PG8_WAIT_L(0); PG8_BAR; PG8_MMA(1, 0, At, B0); PG8_MMA(1, 1, At, B1); PG8_BAR; PG8_SCHED;
        }
        if constexpr (ALIGN_EPI) { if (wr == 0) PG8_BAR; }
        { int fr_ = fr, fq_ = fq; asm volatile("" : "+v"(fr_), "+v"(fq_)); E(acc, cur, wr, wc, fr_, fq_); }
        if (!has_next) break;
#pragma unroll
        for (int a = 0; a < 2; ++a)
#pragma unroll
            for (int b = 0; b < 2; ++b)
#pragma unroll
                for (int m = 0; m < 4; ++m)
#pragma unroll
                    for (int n = 0; n < 2; ++n) acc[a][b][m][n] = (f32x4){0.f, 0.f, 0.f, 0.f};
        cur = nxt; cA = nA; cB = nB; ++ui;
        if constexpr (ALIGN_EPI) { if (wr == 1) PG8_BAR; }
    }
    PG8_WAIT_V(0);
    if constexpr (!ALIGN_EPI) { if (wr == 0) PG8_BAR; }
    PG8_BAR;
#undef PG8_SA
#undef PG8_SB
#undef PG8_STAGE
#undef PG8_LDA
#undef PG8_LDB
#undef PG8_MMA
#undef PG8_WAIT_V
#undef PG8_WAIT_L
#undef PG8_BAR
#undef PG8_SCHED
}

typedef f32x4 Acc[2][2][4][2];
struct EpiBf16 {
    bf16_t* O; int ldc; int ncols;
    __device__ __forceinline__ void operator()(const Acc& acc, const Unit& u, int wr, int wc, int fr, int fq) const {
        const int row0 = u.pm * BM + wr * 64 + fr, col0 = u.pn * BM + wc * 32 + 8 * fq;
#pragma unroll
        for (int ai = 0; ai < 2; ++ai)
#pragma unroll
            for (int m = 0; m < 4; ++m) { bf16_t* rowp = O + (size_t)(row0 + ai * HALF + m * 16) * ldc + col0;
#pragma unroll
                for (int bj = 0; bj < 2; ++bj) { const f32x4 v0 = acc[ai][bj][m][0], v1 = acc[ai][bj][m][1];
                    u32x4 w; w.x = cvt_pk_bf16(v0[0], v0[1]); w.y = cvt_pk_bf16(v0[2], v0[3]); w.z = cvt_pk_bf16(v1[0], v1[1]); w.w = cvt_pk_bf16(v1[2], v1[3]);
                    if (col0 + bj * HALF < ncols) *(u32x4*)(rowp + bj * HALF) = w; } }
    }
};
__device__ __forceinline__ void ld8(const float* p, f32x4& a, f32x4& b) { a = __builtin_nontemporal_load((const f32x4*)p); b = __builtin_nontemporal_load((const f32x4*)(p + 4)); }
__device__ __forceinline__ void ld8(const bf16_t* p, f32x4& a, f32x4& b) { const u32x4 w = __builtin_nontemporal_load((const u32x4*)p); a = (f32x4){bflo(w.x), bfhi(w.x), bflo(w.y), bfhi(w.y)}; b = (f32x4){bflo(w.z), bfhi(w.z), bflo(w.w), bfhi(w.w)}; }
__device__ __forceinline__ void st8(float* p, const f32x4& a, const f32x4& b) { *(f32x4*)p = a; *(f32x4*)(p + 4) = b; }
__device__ __forceinline__ void st8(bf16_t* p, const f32x4& a, const f32x4& b) { u32x4 w; w.x = cvt_pk_bf16(a[0], a[1]); w.y = cvt_pk_bf16(a[2], a[3]); w.z = cvt_pk_bf16(b[0], b[1]); w.w = cvt_pk_bf16(b[2], b[3]); *(u32x4*)p = w; }
template <class TR, class TO> struct EpiResid {
    const TR* res; TO* out; const float* gate0; int gstride;
    __device__ __forceinline__ void operator()(const Acc& acc, const Unit& u, int wr, int wc, int fr, int fq) const {
        const int row0 = u.pm * BM + wr * 64 + fr, col0 = u.pn * BM + wc * 32 + 8 * fq;
        const float* gp = gate0 + (size_t)(u.pm >> 5) * gstride + col0;
        f32x4 g[2][2];
#pragma unroll
        for (int bj = 0; bj < 2; ++bj)
#pragma unroll
            for (int n = 0; n < 2; ++n) g[bj][n] = *(const f32x4*)(gp + bj * HALF + 4 * n);
#pragma unroll
        for (int ai = 0; ai < 2; ++ai)
#pragma unroll
            for (int m = 0; m < 4; ++m) { const size_t off = (size_t)(row0 + ai * HALF + m * 16) * 1024 + col0;
#pragma unroll
                for (int bj = 0; bj < 2; ++bj) { f32x4 r0, r1; ld8(res + off + bj * HALF, r0, r1);
                    st8(out + off + bj * HALF, r0 + g[bj][0] * acc[ai][bj][m][0], r1 + g[bj][1] * acc[ai][bj][m][1]); } }
    }
};
struct EpiSwiglu {
    bf16_t* H;
    __device__ __forceinline__ void operator()(const Acc& acc, const Unit& u, int wr, int wc, int fr, int fq) const {
        const int row0 = u.pm * BM + wr * 64 + fr, col0 = u.pn * HALF + wc * 32 + 8 * fq;
#pragma unroll
        for (int ai = 0; ai < 2; ++ai)
#pragma unroll
            for (int m = 0; m < 4; ++m) { bf16_t* rowp = H + (size_t)(row0 + ai * HALF + m * 16) * DFF + col0;
                f32x4 h0, h1;
                { const f32x4 x0 = acc[ai][0][m][0], x1 = acc[ai][0][m][1]; const f32x4 t0 = x0 * (-1.4426950408889634f), t1 = x1 * (-1.4426950408889634f);
                  f32x4 e0, e1;
#pragma unroll
                  for (int j = 0; j < 4; ++j) { e0[j] = __builtin_amdgcn_exp2f(t0[j]); e1[j] = __builtin_amdgcn_exp2f(t1[j]); }
                  const f32x4 d0 = e0 + 1.0f, d1 = e1 + 1.0f; f32x4 r0, r1;
#pragma unroll
                  for (int j = 0; j < 4; ++j) { r0[j] = __builtin_amdgcn_rcpf(d0[j]); r1[j] = __builtin_amdgcn_rcpf(d1[j]); }
                  h0 = (x0 * acc[ai][1][m][0]) * r0; h1 = (x1 * acc[ai][1][m][1]) * r1; }
                u32x4 w; w.x = cvt_pk_bf16(h0[0], h0[1]); w.y = cvt_pk_bf16(h0[2], h0[3]); w.z = cvt_pk_bf16(h1[0], h1[1]); w.w = cvt_pk_bf16(h1[2], h1[3]);
                *(u32x4*)rowp = w; }
    }
};
struct EpiG1 {
    bf16_t* Z1;
    __device__ __forceinline__ void operator()(const Acc& acc, const Unit& u, int wr, int wc, int fr, int fq) const {
        const unsigned b = u.pn >> 5, q = u.pn & 31, ns0 = wc * 32 + 8 * fq;
        const unsigned j0 = u.pm * BM + wr * 64 + fr;
        const unsigned cs = j0 >> 10;
        bf16_t* base = Z1 + ((size_t)(b * 1024u) * 64u * 256u + (size_t)(2u * q) * 256u + cs * 128u + ns0);
#pragma unroll
        for (int ai = 0; ai < 2; ++ai)
#pragma unroll
            for (int m = 0; m < 4; ++m) { const unsigned ch = (j0 + ai * HALF + m * 16) & 1023u; bf16_t* rp = base + (size_t)ch * (64u * 256u);
#pragma unroll
                for (int bj = 0; bj < 2; ++bj) { const f32x4 v0 = acc[ai][bj][m][0], v1 = acc[ai][bj][m][1];
                    u32x4 w; w.x = cvt_pk_bf16(v0[0], v0[1]); w.y = cvt_pk_bf16(v0[2], v0[3]); w.z = cvt_pk_bf16(v1[0], v1[1]); w.w = cvt_pk_bf16(v1[2], v1[3]);
                    *(u32x4*)(rp + bj * 256) = w; }
                asm volatile("" ::: "memory"); }
    }
};
struct EpiG2 {
    bf16_t* G2;
    __device__ __forceinline__ void operator()(const Acc& acc, const Unit& u, int wr, int wc, int fr, int fq) const {
        const unsigned rho00 = u.pn * BM + wc * 32 + 8 * fq;
#pragma unroll
        for (int m = 0; m < 4; ++m) { const unsigned ka = wr * 64 + m * 16 + fr; const float kaf = (float)ka * (1.0f / 8192.0f);
#pragma unroll
            for (int bj = 0; bj < 2; ++bj) { const unsigned rho0 = rho00 + bj * HALF, bc = rho0 >> 6, nf0 = rho0 & 63u;
                bf16_t* dp = G2 + ((size_t)(bc * 128u + ka) * 128u + nf0);
                f32x4 o_r[2], o_i[2];
#pragma unroll
                for (int n = 0; n < 2; ++n) { const f32x4 gr = acc[0][bj][m][n], gi = acc[1][bj][m][n];
#pragma unroll
                    for (int j = 0; j < 4; ++j) { const float rev = (float)(nf0 + 4 * n + j) * kaf; const float c = cos_rev(rev), s = sin_rev(rev);
                        o_r[n][j] = gr[j] * c + gi[j] * s; o_i[n][j] = gi[j] * c - gr[j] * s; } }
                st8(dp, o_r[0], o_r[1]); st8(dp + 64, o_i[0], o_i[1]);
                asm volatile("" ::: "memory"); } }
    }
};
struct EpiG3 {
    bf16_t* out; const float* gate0; int gstride;
    __device__ __forceinline__ void operator()(const Acc& acc, const Unit& u, int wr, int wc, int fr, int fq) const {
        const int chblk = u.pn & 3, kag = (u.pn >> 2) & 31, b = u.pn >> 7, ch0 = chblk * 256 + wc * 32 + 8 * fq;
        const float* gp = gate0 + (size_t)b * gstride + ch0;
        f32x4 g[2][2];
#pragma unroll
        for (int bj = 0; bj < 2; ++bj)
#pragma unroll
            for (int n = 0; n < 2; ++n) g[bj][n] = *(const f32x4*)(gp + bj * HALF + 4 * n);
#pragma unroll
        for (int ai = 0; ai < 2; ++ai)
#pragma unroll
            for (int m = 0; m < 4; ++m) { const int r = ai * HALF + wr * 64 + m * 16 + fr, s = r >> 6, kb = r & 63;
                const size_t off = ((size_t)b * 8192 + 4 * kag + s + 128 * kb) * 1024 + ch0;
#pragma unroll
                for (int bj = 0; bj < 2; ++bj) { f32x4 r0, r1; ld8(out + off + bj * HALF, r0, r1);
                    st8(out + off + bj * HALF, r0 + g[bj][0] * acc[ai][bj][m][0], r1 + g[bj][1] * acc[ai][bj][m][1]); } }
    }
};
struct ProbWc {
    const char* WfT; const char* D; int K; unsigned rsA, rsB; size_t hsA, hsB;
    __device__ __forceinline__ const char* a_base(const Unit& u) const { return WfT + ((size_t)(u.pm & 3) * 256 * 1024 + (size_t)u.pn * 256) * 2; }
    __device__ __forceinline__ const char* b_base(const Unit& u) const { return D + (size_t)(u.pm >> 2) * 256 * 256 * 2; }
};
struct ProbG1 {
    const char* WcT; const char* XN; int K; unsigned rsA, rsB; size_t hsA, hsB;
    __device__ __forceinline__ const char* a_base(const Unit& u) const { return WcT + (size_t)u.pm * 256 * 1024 * 2; }
    __device__ __forceinline__ const char* b_base(const Unit& u) const { return XN + ((size_t)(u.pn >> 5) * 8192 + 2 * (u.pn & 31)) * 2048; }
};
struct ProbG3 {
    const char* W2d; const char* G2; int K; unsigned rsA, rsB; size_t hsA, hsB;
    __device__ __forceinline__ const char* a_base(const Unit&) const { return W2d; }
    __device__ __forceinline__ const char* b_base(const Unit& u) const { const int chblk = u.pn & 3, kag = (u.pn >> 2) & 31, b = u.pn >> 7;
        return G2 + (((size_t)(b * 1024 + chblk * 256) * 128 + 4 * kag) * 128) * 2; }
};
}

#define RLX_AGENT __ATOMIC_RELAXED, __HIP_MEMORY_SCOPE_AGENT
#define XB_TMO      128
#define XB_XCNT(j)  (256  + 64 * (j))
#define XB_XSUB(j)  (1280 + 64 * (j))
#define XB_XGEN(j)  (2304 + 64 * (j))
#define XB_TOP      3328
#define XB_TOPGEN   3392
#define XCD_BAR_WORDS 3456
#define XB_SPIN_CAP (1u << 18)

__device__ __forceinline__ unsigned xb_ld(unsigned* p)              { return __hip_atomic_load(p, __ATOMIC_RELAXED, __HIP_MEMORY_SCOPE_AGENT); }
__device__ __forceinline__ unsigned xb_add(unsigned* p, unsigned v) { return __hip_atomic_fetch_add(p, v, __ATOMIC_RELAXED, __HIP_MEMORY_SCOPE_AGENT); }
__device__ __forceinline__ unsigned xb_xcc_id() { return (unsigned)__builtin_amdgcn_s_getreg((3 << 11) | 20) & 0xFu; }
#define XB_SPIN(cond, bar) do { unsigned _sp = 0; while (cond) { __builtin_amdgcn_s_sleep(1); \
    if ((++_sp & 255u) == 0u) { if (xb_ld(&(bar)[XB_TMO])) break; if (_sp > XB_SPIN_CAP) { atomicAdd(&(bar)[XB_TMO], 1u); break; } } } } while (0)

struct XcdBarrier {
    unsigned* bar; unsigned x;
    volatile LAS unsigned* st;
};

__device__ __forceinline__ XcdBarrier xcd_barrier_post(unsigned* bar, volatile LAS unsigned* st) {
    XcdBarrier b; b.bar = bar; b.x = xb_xcc_id(); b.st = st;
    if (threadIdx.x == 0) (void)xb_add(&bar[XB_XCNT(b.x)], 1u);
    return b;
}
__device__ __forceinline__ void xcd_barrier_complete(unsigned* bar, unsigned x, unsigned& nloc, unsigned& nx) {
    const unsigned G = gridDim.x * gridDim.y * gridDim.z;
    unsigned sum, cnt, mine, sp = 0u;
    for (;;) {
        sum = 0u; cnt = 0u; mine = 0u;
#pragma unroll
        for (unsigned j = 0; j < 16; ++j) { const unsigned c = xb_ld(&bar[XB_XCNT(j)]); sum += c; cnt += (c > 0u) ? 1u : 0u; mine = (j == x) ? c : mine; }
        if (sum == G) break;
        __builtin_amdgcn_s_sleep(1);
        if ((++sp & 255u) == 0u) { if (xb_ld(&bar[XB_TMO])) break; if (sp > XB_SPIN_CAP) { atomicAdd(&bar[XB_TMO], 1u); break; } }
    }
    nloc = mine > 0u ? mine : 1u; nx = cnt > 0u ? cnt : 1u;
}

__device__ __forceinline__ void xcd_barrier(const XcdBarrier& b) {
    asm volatile("s_waitcnt vmcnt(0)" ::: "memory");
    __syncthreads();
    if (threadIdx.x == 0) {
        unsigned* bar = b.bar;
        __builtin_amdgcn_s_waitcnt(0);
        unsigned nloc = b.st[0], nx = b.st[1];
        if (nloc == 0u) { xcd_barrier_complete(bar, b.x, nloc, nx); b.st[0] = nloc; b.st[1] = nx; }
        const unsigned old = xb_add(&bar[XB_XSUB(b.x)], 1u);
        const unsigned gen = old / nloc;
        if (old + 1u == (gen + 1u) * nloc) {
            __builtin_amdgcn_fence(__ATOMIC_RELEASE, "agent");
            asm volatile("s_waitcnt vmcnt(0)" ::: "memory");
            const unsigned og = xb_add(&bar[XB_TOP], 1u);
            const unsigned tg = og / nx;
            if (og + 1u == (tg + 1u) * nx) xb_add(&bar[XB_TOPGEN], 1u);
            else XB_SPIN(xb_ld(&bar[XB_TOPGEN]) == tg, bar);
            __builtin_amdgcn_fence(__ATOMIC_ACQUIRE, "agent");
            xb_add(&bar[XB_XGEN(b.x)], 1u);
            asm volatile("s_waitcnt vmcnt(0)" ::: "memory");
        } else {
            XB_SPIN(xb_ld(&bar[XB_XGEN(b.x)]) == gen, bar);
            __builtin_amdgcn_fence(__ATOMIC_ACQUIRE, "agent");
            asm volatile("s_waitcnt vmcnt(0)" ::: "memory");
        }
    }
    __syncthreads();
}
struct Args {
    const float* in[21]; float* out; unsigned char* ws;
};
constexpr int NWAVES = 8, NTHR = 512;
constexpr int LDS_BYTES = 147456;

__device__ __forceinline__ void ada_item(const Args& a, int item, LAS unsigned char* lds, int tid, int lane, int wave) {
    const int layer = item / 96, n0 = (item % 96) * 64;
    LAS float* sil = (LAS float*)lds; LAS float* red = sil + 3072;
    const float* c = a.in[1]; const float* cc = a.in[3];
    for (int i = tid; i < 3072; i += NTHR) { const int v = i >> 10, k = i & 1023; const float cv = (v < 2) ? c[v * 1024 + k] : cc[k]; sil[i] = cv / (1.0f + __expf(-cv)); }
    __syncthreads();
    const float* W = a.in[4] + (size_t)layer * 1024 * 6144 + n0 + lane;
    float a0 = 0.f, a1 = 0.f, a2 = 0.f; const int k0 = wave * 128;
#pragma unroll 8
    for (int kk = 0; kk < 128; ++kk) { const int k = k0 + kk; const float w = __builtin_nontemporal_load(W + (size_t)k * 6144); a0 += sil[k] * w; a1 += sil[1024 + k] * w; a2 += sil[2048 + k] * w; }
    red[(wave * 3 + 0) * 64 + lane] = a0; red[(wave * 3 + 1) * 64 + lane] = a1; red[(wave * 3 + 2) * 64 + lane] = a2;
    __syncthreads();
    if (tid < 192) { const int v = tid >> 6, l = tid & 63; float s = a.in[5][layer * 6144 + n0 + l];
#pragma unroll
        for (int w = 0; w < 8; ++w) s += red[(w * 3 + v) * 64 + l];
        ((float*)(a.ws + WS_MOD))[(layer * 3 + v) * 6144 + n0 + l] = s; }
    __syncthreads();
}
__device__ __forceinline__ void transpose_item(const float* W, int N, bf16_t* WT, int ldk, int k0, int n0, int drow0, LAS float* scr, int lane, const float* kscale = nullptr) {
#pragma unroll 8
    for (int i = 0; i < 32; ++i) { const int kk = 2 * i + (lane >> 5); float w = __builtin_nontemporal_load(W + (size_t)(k0 + kk) * N + n0 + (lane & 31)); if (kscale) w *= kscale[k0 + kk]; scr[kk * 33 + (lane & 31)] = w; }
    LDS_WAIT(); asm volatile("" ::: "memory");
    const int c = lane & 7;
#pragma unroll
    for (int j = 0; j < 4; ++j) { const int n = (lane >> 3) + 8 * j; const LAS float* s = scr + (8 * c) * 33 + n;
        u32x4 o; o.x = pk2(s[0 * 33], s[1 * 33]); o.y = pk2(s[2 * 33], s[3 * 33]); o.z = pk2(s[4 * 33], s[5 * 33]); o.w = pk2(s[6 * 33], s[7 * 33]);
        *(u32x4*)(WT + (size_t)(drow0 + n) * ldk + k0 + 8 * c) = o; }
    LDS_WAIT(); asm volatile("" ::: "memory");
}
__device__ __forceinline__ void p0_prologue(const Args& a, LAS unsigned char* lds, int tid, int lane, int wave) {
    asm volatile("" : "+v"(lane), "+v"(tid));
    unsigned char* ws = a.ws;
    if (blockIdx.x < 192) ada_item(a, blockIdx.x, lds, tid, lane, wave);
    LAS float* scr = (LAS float*)(lds + wave * 16384);
    const int gw = blockIdx.x * NWAVES + wave, NGW = gridDim.x * NWAVES;
    constexpr int I_IN = 16 * 69, I_UQ = 6 * 24, I_UKV = 4 * 32, I_O = 512, I_F = 512, I_13 = 16 * 88, I_2 = 44 * 32;
    constexpr int NITEMS = I_IN + I_UQ + I_UKV + I_O + I_F + 2 * (2 * I_13 + I_2);
    for (int it = gw; it < NITEMS; it += NGW) {
        int r = it;
        if (r < I_IN) { const int kb = r / 69, nb = r % 69; transpose_item(a.in[8], NIN, (bf16_t*)(ws + WS_WIN), 1024, 64 * kb, 32 * nb, 32 * nb, scr, lane); continue; } r -= I_IN;
        if (r < I_UQ) { const int kb = r / 24, nb = r % 24; transpose_item(a.in[11], 768, (bf16_t*)(ws + WS_WUQ), 384, 64 * kb, 32 * nb, 32 * nb, scr, lane, a.in[9]); continue; } r -= I_UQ;
        if (r < I_UKV) { const int kb = r / 32, nb = r % 32; transpose_item(a.in[12], 1024, (bf16_t*)(ws + WS_WUKV), 256, 64 * kb, 32 * nb, 32 * nb, scr, lane, a.in[10]); continue; } r -= I_UKV;
        if (r < I_O) { const int kb = r / 32, nb = r % 32; transpose_item(a.in[16], 1024, (bf16_t*)(ws + WS_WO), 1024, 64 * kb, 32 * nb, 32 * nb, scr, lane); continue; } r -= I_O;
        if (r < I_F) { const int kb = r / 32, nb = r % 32; transpose_item(a.in[17], 1024, (bf16_t*)(ws + WS_WF), 1024, 64 * kb, 32 * nb, 32 * nb, scr, lane); continue; } r -= I_F;
        const int layer = r / (2 * I_13 + I_2); r -= layer * (2 * I_13 + I_2);
        if (r < 2 * I_13) { const int s = r / I_13; r -= s * I_13; const int kb = r / 88, nb = r % 88, n0 = 32 * nb;
            transpose_item(a.in[s ? 19 : 18] + (size_t)layer * 1024 * DFF, DFF, (bf16_t*)(ws + WS_W13 + layer * W13_BYTES), 1024, 64 * kb, n0, 256 * (n0 >> 7) + 128 * s + (n0 & 127), scr, lane); continue; }
        r -= 2 * I_13;
        { const int kb = r / 32, nb = r % 32; transpose_item(a.in[20] + (size_t)layer * DFF * 1024, 1024, (bf16_t*)(ws + WS_W2 + layer * W2_BYTES), DFF, 64 * kb, 32 * nb, 32 * nb, scr, lane); }
    }
    const int gt = blockIdx.x * NTHR + tid, NGT = gridDim.x * NTHR;
    { unsigned* z = (unsigned*)(ws + WS_WIN + (size_t)NIN * 1024 * 2); for (int i = gt; i < 96 * 1024 / 2; i += NGT) z[i] = 0u; }
    { bf16_t* d = (bf16_t*)(ws + WS_D256);
      for (int i = gt; i < 131072; i += NGT) { const int cs = i >> 16, c = (i >> 8) & 255, cp = i & 255; const float rev = (float)((c * cp) & 255) * (1.0f / 256.0f);
          const float v = cs ? -sin_rev(rev) : cos_rev(rev); d[i] = (bf16_t)f2bf(v * 0.0625f); } }
    { bf16_t* d = (bf16_t*)(ws + WS_W1D);
      for (int i = gt; i < 65536; i += NGT) { const int row = i >> 8, col = i & 255, ro = row >> 7, ka = row & 127, ri = col >> 7, n = col & 127; const float rev = (float)((n * ka) & 127) * (1.0f / 128.0f);
          const float c = cos_rev(rev), s = sin_rev(rev); const float v = (ro == 0) ? (ri == 0 ? c : s) : (ri == 0 ? -s : c); d[i] = (bf16_t)f2bf(v * 0.08838834764831845f); } }
    { bf16_t* d = (bf16_t*)(ws + WS_W2D);
      for (int i = gt; i < 256 * 512; i += NGT) { const int row = i >> 9, col = i & 511, s = row >> 6, kb = row & 63, sp = col >> 7, ri = (col >> 6) & 1, n2 = col & 63; float v = 0.f;
          if (s == sp) { const float rev = (float)((n2 * kb) & 63) * (1.0f / 64.0f); v = (ri == 0 ? cos_rev(rev) : sin_rev(rev)) * 0.125f; }
          d[i] = (bf16_t)f2bf(v); } }
}

__device__ __forceinline__ void norm_pass(const float* src, int nrows, bf16_t* dst, const float* g, const float* mod, int sh_chunk, int vfixed, int lane, int wave) {
    asm volatile("" : "+v"(lane));
    const int gw = blockIdx.x * NWAVES + wave, NGW = gridDim.x * NWAVES;
    const int nb = vfixed >= 0 ? 1 : 2;
#pragma unroll 1
    for (int b = 0; b < nb; ++b) {
        const int v = vfixed >= 0 ? vfixed : b; const float* mv = mod + v * 6144 + sh_chunk * 1024;
        f32x4 cg[4], cs[4];
#pragma unroll
        for (int j = 0; j < 4; ++j) { const int c = (j >> 1) * 512 + lane * 8 + (j & 1) * 4; const f32x4 gg = *(const f32x4*)(g + c), sc = *(const f32x4*)(mv + 1024 + c); cg[j] = gg * (sc + 1.0f); cs[j] = *(const f32x4*)(mv + c); }
        const int rlo = vfixed >= 0 ? 0 : b * 8192, rhi = vfixed >= 0 ? nrows : (b + 1) * 8192;
        for (int r = rlo + gw; r < rhi && r < nrows; r += NGW) {
            const float* xrow = src + (size_t)r * 1024; bf16_t* orow = dst + (size_t)r * 1024;
            f32x4 x[4]; pg8::ld8(xrow + lane * 8, x[0], x[1]); pg8::ld8(xrow + 512 + lane * 8, x[2], x[3]); float s = 0.f;
#pragma unroll
            for (int j = 0; j < 4; ++j) s += (x[j].x * x[j].x + x[j].y * x[j].y) + (x[j].z * x[j].z + x[j].w * x[j].w);
            const float rstd = rsqrtf(wave_sum(s) * (1.0f / 1024.0f) + EPS);
            pg8::st8(orow + lane * 8, x[0] * rstd * cg[0] + cs[0], x[1] * rstd * cg[1] + cs[1]);
            pg8::st8(orow + 512 + lane * 8, x[2] * rstd * cg[2] + cs[2], x[3] * rstd * cg[3] + cs[3]);
        }
    }
}
__device__ __forceinline__ void norm_pass_b(const bf16_t* src, int nrows, bf16_t* dst, const float* g, const float* mod, int sh_chunk, int lane, int wave) {
    asm volatile("" : "+v"(lane));
    const int G8 = gridDim.x >> 3;
    if ((gridDim.x & 7) == 0 && nrows == 8 * 2048) {
        const int x = blockIdx.x & 7, lw = (blockIdx.x >> 3) * NWAVES + wave, nlw = G8 * NWAVES, b = x >> 2;
        const float* mv = mod + b * 6144 + sh_chunk * 1024;
        f32x4 cg[4], cs[4];
#pragma unroll
        for (int j = 0; j < 4; ++j) { const int c = (j >> 1) * 512 + lane * 8 + (j & 1) * 4; const f32x4 gg = *(const f32x4*)(g + c), sc = *(const f32x4*)(mv + 1024 + c); cg[j] = gg * (sc + 1.0f); cs[j] = *(const f32x4*)(mv + c); }
        for (int rr = lw; rr < 2048; rr += nlw) { const int r = 2048 * x + rr;
            const bf16_t* xrow = src + (size_t)r * 1024; bf16_t* orow = dst + (size_t)r * 1024;
            f32x4 v[4]; pg8::ld8(xrow + lane * 8, v[0], v[1]); pg8::ld8(xrow + 512 + lane * 8, v[2], v[3]); float s = 0.f;
#pragma unroll
            for (int j = 0; j < 4; ++j) s += (v[j].x * v[j].x + v[j].y * v[j].y) + (v[j].z * v[j].z + v[j].w * v[j].w);
            const float rstd = rsqrtf(wave_sum(s) * (1.0f / 1024.0f) + EPS);
            pg8::st8(orow + lane * 8, v[0] * rstd * cg[0] + cs[0], v[1] * rstd * cg[1] + cs[1]);
            pg8::st8(orow + 512 + lane * 8, v[2] * rstd * cg[2] + cs[2], v[3] * rstd * cg[3] + cs[3]); }
        return;
    }
    const int gw = blockIdx.x * NWAVES + wave, NGW = gridDim.x * NWAVES;
#pragma unroll 1
    for (int b = 0; b < 2; ++b) {
        const float* mv = mod + b * 6144 + sh_chunk * 1024;
        f32x4 cg[4], cs[4];
#pragma unroll
        for (int j = 0; j < 4; ++j) { const int c = (j >> 1) * 512 + lane * 8 + (j & 1) * 4; const f32x4 gg = *(const f32x4*)(g + c), sc = *(const f32x4*)(mv + 1024 + c); cg[j] = gg * (sc + 1.0f); cs[j] = *(const f32x4*)(mv + c); }
        for (int r = b * 8192 + gw; r < (b + 1) * 8192 && r < nrows; r += NGW) {
            const bf16_t* xrow = src + (size_t)r * 1024; bf16_t* orow = dst + (size_t)r * 1024;
            f32x4 v[4]; pg8::ld8(xrow + lane * 8, v[0], v[1]); pg8::ld8(xrow + 512 + lane * 8, v[2], v[3]); float s = 0.f;
#pragma unroll
            for (int j = 0; j < 4; ++j) s += (v[j].x * v[j].x + v[j].y * v[j].y) + (v[j].z * v[j].z + v[j].w * v[j].w);
            const float rstd = rsqrtf(wave_sum(s) * (1.0f / 1024.0f) + EPS);
            pg8::st8(orow + lane * 8, v[0] * rstd * cg[0] + cs[0], v[1] * rstd * cg[1] + cs[1]);
            pg8::st8(orow + 512 + lane * 8, v[2] * rstd * cg[2] + cs[2], v[3] * rstd * cg[3] + cs[3]);
        }
    }
}

__device__ __forceinline__ float sumsq8(u32x4 c) { float s = 0.f;
#pragma unroll
    for (int i = 0; i < 4; ++i) { const float a = bflo(c[i]), b = bfhi(c[i]); s += a * a + b * b; } return s; }
__device__ __forceinline__ u32x4 scale8(u32x4 c, float r, const float* g) { const f32x4 g0 = *(const f32x4*)g, g1 = *(const f32x4*)(g + 4); u32x4 o;
    o.x = pk2(bflo(c.x) * r * g0.x, bfhi(c.x) * r * g0.y); o.y = pk2(bflo(c.y) * r * g0.z, bfhi(c.y) * r * g0.w);
    o.z = pk2(bflo(c.z) * r * g1.x, bfhi(c.z) * r * g1.y); o.w = pk2(bflo(c.w) * r * g1.z, bfhi(c.w) * r * g1.w); return o; }
__device__ __forceinline__ void conv_pass(const Args& a, int lane, int wave) {
    asm volatile("" : "+v"(lane));
    unsigned char* ws = a.ws;
    const bf16_t* P = (const bf16_t*)(ws + WS_B); bf16_t* MIX = (bf16_t*)(ws + WS_A);
    const float* cw = a.in[15];
    f32x4 w0[2], w1[2], w2[2];
#pragma unroll
    for (int i = 0; i < 2; ++i) { w0[i] = *(const f32x4*)(cw + 8 * lane + 4 * i); w1[i] = *(const f32x4*)(cw + 512 + 8 * lane + 4 * i); w2[i] = *(const f32x4*)(cw + 1024 + 8 * lane + 4 * i); }
    const int gw = blockIdx.x * NWAVES + wave, NGW = gridDim.x * NWAVES;
    for (int r = gw; r < ML; r += NGW) {
        const int t = r & (SEQ - 1);
        const bf16_t* cb = P + (size_t)r * PLD + 672 + 8 * lane;
        const u32x4 bg = *(const u32x4*)cb, cg0 = *(const u32x4*)(cb + 512), u0 = *(const u32x4*)(cb + 1024);
        u32x4 cgm = (u32x4){0u, 0u, 0u, 0u}, um = cgm, cgp = cgm, up = cgm;
        if (t > 0) { cgm = *(const u32x4*)(cb - PLD + 512); um = *(const u32x4*)(cb - PLD + 1024); }
        if (t < SEQ - 1) { cgp = *(const u32x4*)(cb + PLD + 512); up = *(const u32x4*)(cb + PLD + 1024); }
        u32x4 o;
#pragma unroll
        for (int i = 0; i < 4; ++i) {
            const float zl_m = bflo(cgm[i]) * bflo(um[i]), zh_m = bfhi(cgm[i]) * bfhi(um[i]);
            const float zl_0 = bflo(cg0[i]) * bflo(u0[i]), zh_0 = bfhi(cg0[i]) * bfhi(u0[i]);
            const float zl_p = bflo(cgp[i]) * bflo(up[i]), zh_p = bfhi(cgp[i]) * bfhi(up[i]);
            const int e = 2 * i;
            const float yl = zl_m * w0[e >> 2][e & 3] + zl_0 * w1[e >> 2][e & 3] + zl_p * w2[e >> 2][e & 3];
            const float yh = zh_m * w0[(e + 1) >> 2][(e + 1) & 3] + zh_0 * w1[(e + 1) >> 2][(e + 1) & 3] + zh_p * w2[(e + 1) >> 2][(e + 1) & 3];
            o[i] = pk2(bflo(bg[i]) * yl, bfhi(bg[i]) * yh);
        }
        *(u32x4*)(MIX + (size_t)r * 1024 + 512 + 8 * lane) = o;
    }
}

__device__ __forceinline__ void prep2_pass(const Args& a, LAS unsigned char* lds, int tid, int lane, int wave) {
    asm volatile("" : "+v"(lane), "+v"(tid));
    unsigned char* ws = a.ws;
    bf16_t* Q = (bf16_t*)(ws + WS_Q); const bf16_t* KV = (const bf16_t*)(ws + WS_KV); const bf16_t* P = (const bf16_t*)(ws + WS_B);
    LAS float* rkl = (LAS float*)(lds + 65536);
    bf16_t* Kf = (bf16_t*)(ws + WS_KF); bf16_t* Vt = (bf16_t*)(ws + WS_VT);
    const float* qgain = a.in[13]; const float* kgain = a.in[14];
    const int head = lane >> 3, sub = lane & 7;
    const float inv = __builtin_amdgcn_exp2f(-(float)sub * 1.6609640474436813f) * 0.15915494309189535f;
    float qgn[8], kgn[8], qgp[4], kgp[4];
#pragma unroll
    for (int e = 0; e < 8; ++e) { qgn[e] = qgain[8 * sub + e] * QSC; kgn[e] = kgain[8 * sub + e]; }
#pragma unroll
    for (int i = 0; i < 4; ++i) { qgp[i] = qgain[64 + sub + 8 * i] * QSC; kgp[i] = kgain[64 + sub + 8 * i]; }
    constexpr int PB = 16, RW = PB / 8;
    for (int blk = blockIdx.x; blk < MT / PB; blk += gridDim.x) {
        const int r0 = blk * PB; const bool latent = blk < ML / PB;
        const int b = latent ? (blk / (SEQ / PB)) : ((blk - ML / PB) / (256 / PB));
        const int key0 = latent ? ((blk % (SEQ / PB)) * PB) : (SEQ + ((blk - ML / PB) % (256 / PB)) * PB);
#pragma unroll
        for (int i = 0; i < PB / 8; ++i) { const int id = tid + 512 * i, row = id >> 6, cc = id & 63, h = cc >> 3, part = cc & 7;
            const u32x4 v = *(const u32x4*)(KV + (size_t)(r0 + row) * 1024 + h * 128 + 64 + part * 8);
            *(LAS u32x4*)(lds + row * 1024 + cc * 16) = v; }
        for (int i = 0; i < RW; ++i) {
            const int r = r0 + RW * wave + i, kl = RW * wave + i;
            float cr = 1.f, sr = 0.f, ccol = 1.f, scol = 0.f;
            if (latent) { const int t = r & (SEQ - 1); const float ar = (float)(t >> 6) * inv, ac = (float)(t & 63) * inv;
                cr = cos_rev(ar - floorf(ar)); sr = sin_rev(ar - floorf(ar)); ccol = cos_rev(ac - floorf(ac)); scol = sin_rev(ac - floorf(ac)); }
            const bf16_t* prow = P + (size_t)r * PLD; const bf16_t* kpe = prow + 640;
            float rq, rkv;
            { const u32x4 c1 = *(const u32x4*)(prow + lane * 8); u32x4 c2 = (u32x4){0u, 0u, 0u, 0u}; if (lane < 16) c2 = *(const u32x4*)(prow + 512 + lane * 8);
              const float ss1 = sumsq8(c1), ss2 = sumsq8(c2);
              const float sq = wave_sum(lane < 48 ? ss1 : 0.f), skv = wave_sum((lane >= 48 ? ss1 : 0.f) + ss2);
              rq = rsqrtf(sq * (1.0f / 384.0f) + EPS); rkv = rsqrtf(skv * (1.0f / 256.0f) + EPS); if (lane == 0) rkl[kl] = rkv; }
            if (latent) {
                bf16_t* qp = Q + (size_t)r * 768 + head * 96;
                const u32x4 nv = *(const u32x4*)(qp + 8 * sub);
                float pe[4];
#pragma unroll
                for (int j = 0; j < 4; ++j) pe[j] = bf1(qp[64 + sub + 8 * j]) * rq;
                float ss = sumsq8(nv) * (rq * rq) + (pe[0] * pe[0] + pe[1] * pe[1]) + (pe[2] * pe[2] + pe[3] * pe[3]);
                ss += __shfl_xor(ss, 1); ss += __shfl_xor(ss, 2); ss += __shfl_xor(ss, 4);
                const float rs0 = rsqrtf(ss * (1.0f / 96.0f) + EPS), rs = rs0 * rq;
                u32x4 o; o.x = pk2(bflo(nv.x) * rs * qgn[0], bfhi(nv.x) * rs * qgn[1]); o.y = pk2(bflo(nv.y) * rs * qgn[2], bfhi(nv.y) * rs * qgn[3]);
                o.z = pk2(bflo(nv.z) * rs * qgn[4], bfhi(nv.z) * rs * qgn[5]); o.w = pk2(bflo(nv.w) * rs * qgn[6], bfhi(nv.w) * rs * qgn[7]);
                *(u32x4*)(qp + 8 * sub) = o;
                const float p0 = pe[0] * rs0 * qgp[0], p1 = pe[1] * rs0 * qgp[1], p2 = pe[2] * rs0 * qgp[2], p3 = pe[3] * rs0 * qgp[3];
                qp[64 + sub] = (bf16_t)f2bf(p0 * cr - p1 * sr); qp[72 + sub] = (bf16_t)f2bf(p1 * cr + p0 * sr);
                qp[80 + sub] = (bf16_t)f2bf(p2 * ccol - p3 * scol); qp[88 + sub] = (bf16_t)f2bf(p3 * ccol + p2 * scol);
            }
            {
                const u32x4 nv = *(const u32x4*)(KV + (size_t)r * 1024 + head * 128 + 8 * sub);
                float pe[4];
#pragma unroll
                for (int j = 0; j < 4; ++j) pe[j] = bf1(kpe[sub + 8 * j]);
                float ss = sumsq8(nv) * (rkv * rkv) + (pe[0] * pe[0] + pe[1] * pe[1]) + (pe[2] * pe[2] + pe[3] * pe[3]);
                ss += __shfl_xor(ss, 1); ss += __shfl_xor(ss, 2); ss += __shfl_xor(ss, 4);
                const float rs0 = rsqrtf(ss * (1.0f / 96.0f) + EPS), rs = rs0 * rkv;
                bf16_t* kp = Kf + ((size_t)(b * NH + head) * NKEY + key0 + kl) * DQK;
                u32x4 o; o.x = pk2(bflo(nv.x) * rs * kgn[0], bfhi(nv.x) * rs * kgn[1]); o.y = pk2(bflo(nv.y) * rs * kgn[2], bfhi(nv.y) * rs * kgn[3]);
                o.z = pk2(bflo(nv.z) * rs * kgn[4], bfhi(nv.z) * rs * kgn[5]); o.w = pk2(bflo(nv.w) * rs * kgn[6], bfhi(nv.w) * rs * kgn[7]);
                *(u32x4*)(kp + 8 * sub) = o;
                const float p0 = pe[0] * rs0 * kgp[0], p1 = pe[1] * rs0 * kgp[1], p2 = pe[2] * rs0 * kgp[2], p3 = pe[3] * rs0 * kgp[3];
                kp[64 + sub] = (bf16_t)f2bf(p0 * cr - p1 * sr); kp[72 + sub] = (bf16_t)f2bf(p1 * cr + p0 * sr);
                kp[80 + sub] = (bf16_t)f2bf(p2 * ccol - p3 * scol); kp[88 + sub] = (bf16_t)f2bf(p3 * ccol + p2 * scol);
            }
        }
        __syncthreads();
        { const int h = tid >> 6, d = tid & 63; bf16_t* vp = Vt + ((size_t)(b * NH + h) * 64 + d) * NKEY + key0;
#pragma unroll
          for (int i = 0; i < PB / 8; ++i) { float e[8];
#pragma unroll
              for (int k = 0; k < 8; ++k) e[k] = bf1(*(const LAS unsigned short*)(lds + (8 * i + k) * 1024 + tid * 2)) * rkl[8 * i + k];
              u32x4 o; o.x = pk2(e[0], e[1]); o.y = pk2(e[2], e[3]); o.z = pk2(e[4], e[5]); o.w = pk2(e[6], e[7]);
              *(u32x4*)(vp + 8 * i) = o; } }
        __syncthreads();
    }
}

__device__ __forceinline__ float attn_rowmax(const f32x16& p0, const f32x16& p1) {
    float a = __builtin_fmaxf(__builtin_fmaxf(p0[0], p0[1]), p1[0]), b = __builtin_fmaxf(__builtin_fmaxf(p0[2], p0[3]), p1[1]);
    a = __builtin_fmaxf(__builtin_fmaxf(a, p1[2]), p1[3]);
#pragma unroll
    for (int r = 4; r < 16; r += 4) { a = __builtin_fmaxf(__builtin_fmaxf(a, p0[r]), p0[r + 1]); b = __builtin_fmaxf(__builtin_fmaxf(b, p0[r + 2]), p0[r + 3]);
        a = __builtin_fmaxf(__builtin_fmaxf(a, p1[r]), p1[r + 1]); b = __builtin_fmaxf(__builtin_fmaxf(b, p1[r + 2]), p1[r + 3]); }
    const float mx = __builtin_fmaxf(a, b);
    auto rr = __builtin_amdgcn_permlane32_swap(__float_as_uint(mx), __float_as_uint(mx), false, false);
    return __builtin_fmaxf(__uint_as_float(rr[0]), __uint_as_float(rr[1]));
}
__device__ __forceinline__ void attn_phase(const Args& a, LAS unsigned char* lds, int tid, int lane, int wid) {
    asm volatile("" : "+v"(lane), "+v"(tid));
    unsigned char* ws = a.ws;
    const bf16_t* Q = (const bf16_t*)(ws + WS_Q); const char* Kf = (const char*)(ws + WS_KF); const char* Vt = (const char*)(ws + WS_VT); bf16_t* MIX = (bf16_t*)(ws + WS_A);
    constexpr int NS = 4, KSLOT = 13312, VBASE = NS * KSLOT, VSLOT = 8192, NT = NKEY / 64;
    constexpr float THR = 8.0f;
    const int q = lane & 31, hi = lane >> 5;
    const int xcd = blockIdx.x & 7, l = blockIdx.x >> 3;
    const unsigned lds0 = (unsigned)(size_t)lds;
    unsigned koff[2];
#pragma unroll
    for (int i = 0; i < 2; ++i) { const int p = 64 * (wid + 8 * i) + lane, row = p / 13, c = p % 13, r31 = row & 31;
        const int key = (row & 32) + ((r31 & 19) | ((r31 & 4) << 1) | ((r31 & 8) >> 1)); koff[i] = (unsigned)(key * 192 + (c < 12 ? c : 11) * 16); }
    const bool k2 = wid < 5;
    unsigned voffv; { const int d = 8 * wid + (lane >> 3), cp = lane & 7, c = cp ^ ((d >> 1) & 7); voffv = (unsigned)(d * (NKEY * 2) + c * 16); }
    const unsigned kdst0 = lds0 + (unsigned)wid * 1024u, kdst1 = lds0 + (unsigned)(wid + 8) * 1024u, vdst = lds0 + VBASE + (unsigned)wid * 1024u;
    const int kro = q * 208 + hi * 16;
    int vro[4];
#pragma unroll
    for (int s = 0; s < 4; ++s) vro[s] = VBASE + q * 128 + (((2 * s + hi) ^ ((q >> 1) & 7)) * 16);
#define DMA_K(tile, slot) do { const char* kb_ = Kh + (size_t)(tile) * (64 * 192); pg8::glds16s(kb_, koff[0], kdst0 + (slot) * KSLOT); if (k2) pg8::glds16s(kb_, koff[1], kdst1 + (slot) * KSLOT); } while (0)
#define DMA_V(tile, slot) pg8::glds16s(Vh + (size_t)(tile) * 128, voffv, vdst + (slot) * VSLOT)
#define SBAR() do {} while (0)
#define EXP2(P, R) do { P[R] = __builtin_amdgcn_exp2f(P[R]); P[R + 1] = __builtin_amdgcn_exp2f(P[R + 1]); rs2 += (f32x2){P[R], P[R + 1]}; } while (0)
#define PKP(P, B) __builtin_bit_cast(bf16x8, (u32x4){cvt_pk_bf16(P[B], P[B + 1]), cvt_pk_bf16(P[B + 2], P[B + 3]), cvt_pk_bf16(P[B + 4], P[B + 5]), cvt_pk_bf16(P[B + 6], P[B + 7])})
    for (int it = 0; it < 2; ++it) {
        const int bh = 2 * xcd + it, b = bh >> 3, h = bh & 7, qb = l;
        const size_t qrow = (size_t)b * SEQ + qb * 256 + wid * 32 + q;
        const char* Kh = Kf + (size_t)bh * NKEY * 192; const char* Vh = Vt + (size_t)bh * 64 * NKEY * 2;
        DMA_K(0, 0); DMA_K(1, 1); DMA_V(0, 0); DMA_K(2, 2); DMA_V(1, 1); DMA_K(3, 3); DMA_V(2, 2);
        bf16x8 qf[6];
#pragma unroll
        for (int d0 = 0; d0 < 6; ++d0) qf[d0] = *(const bf16x8*)(Q + qrow * 768 + h * 96 + d0 * 16 + hi * 8);
        asm volatile("s_waitcnt vmcnt(0) lgkmcnt(0)\n\ts_barrier" ::: "memory");
        f32x16 pc0 = {}, pc1 = {};
#pragma unroll
        for (int d0 = 0; d0 < 6; ++d0) {
            const bf16x8 a0 = *(const LAS bf16x8*)(lds + kro + d0 * 32), a1 = *(const LAS bf16x8*)(lds + kro + 32 * 208 + d0 * 32);
            pc0 = __builtin_amdgcn_mfma_f32_32x32x16_bf16(a0, qf[d0], pc0, 0, 0, 0); pc1 = __builtin_amdgcn_mfma_f32_32x32x16_bf16(a1, qf[d0], pc1, 0, 0, 0);
        }
        float m = attn_rowmax(pc0, pc1), lsum = 0.f;
#pragma unroll
        for (int r = 0; r < 16; ++r) { pc0[r] -= m; pc1[r] -= m; }
        f32x16 o0 = {}, o1 = {};
        f32x2 rs2 = (f32x2){0.f, 0.f};
        f32x16 negm;
#pragma unroll
        for (int r = 0; r < 16; ++r) negm[r] = -m;
        asm volatile("" : "+v"(negm));
        asm volatile("s_waitcnt lgkmcnt(0)\n\ts_barrier" ::: "memory");
#define ATT_ITER(PC0, PC1, PN0, PN1, T) do { \
            { const int tk_ = ((T) + 4 < NT) ? (T) + 4 : NT - 1, tv_ = ((T) + 3 < NT) ? (T) + 3 : NT - 1; DMA_K(tk_, (T) & 3); DMA_V(tv_, ((T) + 3) & 3); } \
            const LAS unsigned char* kn = lds + (((T) + 1) & 3) * KSLOT + kro; \
            bf16x8 kfa[6], kfb[6]; \
            _Pragma("unroll") for (int d0 = 0; d0 < 3; ++d0) { kfa[2 * d0] = *(const LAS bf16x8*)(kn + d0 * 32); kfa[2 * d0 + 1] = *(const LAS bf16x8*)(kn + 32 * 208 + d0 * 32); } \
            SBAR(); \
            PN0 = __builtin_amdgcn_mfma_f32_32x32x16_bf16(kfa[0], qf[0], negm, 0, 0, 0); EXP2(PC0, 0); SBAR(); \
            _Pragma("unroll") for (int d0 = 3; d0 < 6; ++d0) { kfb[2 * (d0 - 3)] = *(const LAS bf16x8*)(kn + d0 * 32); kfb[2 * (d0 - 3) + 1] = *(const LAS bf16x8*)(kn + 32 * 208 + d0 * 32); } \
            SBAR(); \
            PN1 = __builtin_amdgcn_mfma_f32_32x32x16_bf16(kfa[1], qf[0], negm, 0, 0, 0); EXP2(PC0, 2); SBAR(); \
            PN0 = __builtin_amdgcn_mfma_f32_32x32x16_bf16(kfa[2], qf[1], PN0, 0, 0, 0); EXP2(PC0, 4); EXP2(PC0, 6); SBAR(); \
            PN1 = __builtin_amdgcn_mfma_f32_32x32x16_bf16(kfa[3], qf[1], PN1, 0, 0, 0); EXP2(PC0, 8); SBAR(); \
            PN0 = __builtin_amdgcn_mfma_f32_32x32x16_bf16(kfa[4], qf[2], PN0, 0, 0, 0); EXP2(PC0, 10); EXP2(PC0, 12); SBAR(); \
            PN1 = __builtin_amdgcn_mfma_f32_32x32x16_bf16(kfa[5], qf[2], PN1, 0, 0, 0); EXP2(PC0, 14); SBAR(); \
            const LAS unsigned char* vb = lds + ((T) & 3) * VSLOT; \
            bf16x8 va[8]; \
            _Pragma("unroll") for (int s = 0; s < 4; ++s) { va[2 * s] = *(const LAS bf16x8*)(vb + vro[s]); va[2 * s + 1] = *(const LAS bf16x8*)(vb + vro[s] + 32 * 128); } \
            SBAR(); \
            PN0 = __builtin_amdgcn_mfma_f32_32x32x16_bf16(kfb[0], qf[3], PN0, 0, 0, 0); EXP2(PC1, 0); EXP2(PC1, 2); SBAR(); \
            PN1 = __builtin_amdgcn_mfma_f32_32x32x16_bf16(kfb[1], qf[3], PN1, 0, 0, 0); EXP2(PC1, 4); SBAR(); \
            PN0 = __builtin_amdgcn_mfma_f32_32x32x16_bf16(kfb[2], qf[4], PN0, 0, 0, 0); EXP2(PC1, 6); EXP2(PC1, 8); SBAR(); \
            PN1 = __builtin_amdgcn_mfma_f32_32x32x16_bf16(kfb[3], qf[4], PN1, 0, 0, 0); EXP2(PC1, 10); SBAR(); \
            PN0 = __builtin_amdgcn_mfma_f32_32x32x16_bf16(kfb[4], qf[5], PN0, 0, 0, 0); EXP2(PC1, 12); SBAR(); \
            PN1 = __builtin_amdgcn_mfma_f32_32x32x16_bf16(kfb[5], qf[5], PN1, 0, 0, 0); EXP2(PC1, 14); SBAR(); \
            { const bf16x8 pb0 = PKP(PC0, 0); \
              o0 = __builtin_amdgcn_mfma_f32_32x32x16_bf16(va[0], pb0, o0, 0, 0, 0); o1 = __builtin_amdgcn_mfma_f32_32x32x16_bf16(va[1], pb0, o1, 0, 0, 0); \
              const bf16x8 pb1 = PKP(PC0, 8); \
              o0 = __builtin_amdgcn_mfma_f32_32x32x16_bf16(va[2], pb1, o0, 0, 0, 0); o1 = __builtin_amdgcn_mfma_f32_32x32x16_bf16(va[3], pb1, o1, 0, 0, 0); \
              const bf16x8 pb2 = PKP(PC1, 0); \
              o0 = __builtin_amdgcn_mfma_f32_32x32x16_bf16(va[4], pb2, o0, 0, 0, 0); o1 = __builtin_amdgcn_mfma_f32_32x32x16_bf16(va[5], pb2, o1, 0, 0, 0); \
              const bf16x8 pb3 = PKP(PC1, 8); \
              o0 = __builtin_amdgcn_mfma_f32_32x32x16_bf16(va[6], pb3, o0, 0, 0, 0); o1 = __builtin_amdgcn_mfma_f32_32x32x16_bf16(va[7], pb3, o1, 0, 0, 0); } \
            if (k2) asm volatile("s_waitcnt vmcnt(6) lgkmcnt(0)\n\ts_barrier" ::: "memory"); \
            else asm volatile("s_waitcnt vmcnt(4) lgkmcnt(0)\n\ts_barrier" ::: "memory"); \
        } while (0)
        f32x16 pd0, pd1;
        static_assert(NT % 2 == 0, "two tiles per loop trip");
        for (int t = 0; t < NT; t += 2) {
            ATT_ITER(pc0, pc1, pd0, pd1, t);
            ATT_ITER(pd0, pd1, pc0, pc1, t + 1);
        }
#undef ATT_ITER
        lsum += rs2.x + rs2.y;
        const float lt = lsum + __shfl_xor(lsum, 32); const float il = 1.0f / lt;
        bf16_t* op = MIX + qrow * 1024 + h * 64 + 4 * hi;
#pragma unroll
        for (int g = 0; g < 4; ++g) {
            u32x2 w0, w1; w0.x = cvt_pk_bf16(o0[4 * g] * il, o0[4 * g + 1] * il); w0.y = cvt_pk_bf16(o0[4 * g + 2] * il, o0[4 * g + 3] * il);
            w1.x = cvt_pk_bf16(o1[4 * g] * il, o1[4 * g + 1] * il); w1.y = cvt_pk_bf16(o1[4 * g + 2] * il, o1[4 * g + 3] * il);
            *(u32x2*)(op + 8 * g) = w0; *(u32x2*)(op + 32 + 8 * g) = w1;
        }
        asm volatile("s_waitcnt vmcnt(0) lgkmcnt(0)\n\ts_barrier" ::: "memory");
    }
#undef DMA_K
#undef DMA_V
#undef SBAR
#undef EXP2
#undef PKP
}

__global__ void __launch_bounds__(NTHR, 2) fwd_kernel(Args a) {
    extern __shared__ __attribute__((aligned(16))) unsigned char lds_raw[];
    LAS unsigned char* lds = (LAS unsigned char*)lds_raw;
    cg::grid_group grid = cg::this_grid();
    unsigned* barw = (unsigned*)a.ws;
    volatile LAS unsigned* bst = (volatile LAS unsigned*)(lds_raw + 131072 + 64);
    if (threadIdx.x < 2) bst[threadIdx.x] = 0u;
    __syncthreads();
    XcdBarrier xbar = xcd_barrier_post(barw, bst);
    if (a.out == nullptr) grid.sync();
#define GSYNC() do { for (int s_ = 0; s_ < PROBE_SYNC; ++s_) xcd_barrier(xbar); } while (0)
    const int tid = threadIdx.x, lane = tid & 63, wave = __builtin_amdgcn_readfirstlane(tid >> 6);
    const int G = gridDim.x, cu = blockIdx.x;
    unsigned char* ws = a.ws;
    const float* mod = (const float*)(ws + WS_MOD);
    bf16_t* XN = (bf16_t*)(ws + WS_A);
    bf16_t* XB = (bf16_t*)(ws + WS_XB);

    p0_prologue(a, lds, tid, lane, wave);
    GSYNC();
    norm_pass(a.in[0], ML, XN, a.in[6], mod, 0, -1, lane, wave);
    norm_pass(a.in[2], MC, XN + (size_t)ML * 1024, a.in[6], mod, 0, 2, lane, wave);
    GSYNC();
    { pg8::ProbStd p = pg8::make_std(XN, 1024, ws + WS_WIN, 1024, 1024); pg8::StaticOrder S; S.init(MT, NINP, G, cu);
      pg8::EpiBf16 E{(bf16_t*)(ws + WS_B), PLD, NIN}; pg8::gemm_phase<pg8::EpiBf16, pg8::ProbStd, true>(lds, p, S, E); }
    { pg8::ProbWc p{(const char*)(ws + WS_WF), (const char*)(ws + WS_D256), 256, 1024 * 2, 256 * 2, (size_t)128 * 1024 * 2, (size_t)128 * 256 * 2};
      pg8::StaticOrder S; S.init(2048, 1024, G, (cu + 32) & 255);
      pg8::EpiBf16 E{(bf16_t*)(ws + WS_WC), 1024, 1 << 30}; pg8::gemm_phase<pg8::EpiBf16, pg8::ProbWc, true>(lds, p, S, E); }
    GSYNC();
    { pg8::ProbStd p = pg8::make_std(ws + WS_B, PLD, ws + WS_WUQ, QR, QR); pg8::StaticOrder S; S.init(ML, 768, G, cu);
      pg8::EpiBf16 E{(bf16_t*)(ws + WS_Q), 768, 1 << 30}; pg8::gemm_phase<pg8::EpiBf16, pg8::ProbStd, true>(lds, p, S, E); }
    { pg8::ProbStd p = pg8::make_std(ws + WS_B + QR * 2, PLD, ws + WS_WUKV, KVR, KVR); pg8::StaticOrder S; S.init(MT, 1024, G, (cu + 64) & 255);
      pg8::EpiBf16 E{(bf16_t*)(ws + WS_KV), 1024, 1 << 30}; pg8::gemm_phase<pg8::EpiBf16, pg8::ProbStd, true>(lds, p, S, E); }
    GSYNC();
    prep2_pass(a, lds, tid, lane, wave);
    conv_pass(a, lane, wave);
    GSYNC();
    for (int p_ = 0; p_ < PROBE_ATTN; ++p_) attn_phase(a, lds, tid, lane, wave);
    GSYNC();
    { pg8::ProbStd p = pg8::make_std(ws + WS_A, 1024, ws + WS_WO, 1024, 1024); pg8::StaticOrder S; S.init(ML, 1024, G, cu);
      typedef pg8::EpiResid<float, bf16_t> EP; EP E{a.in[0], XB, mod + 2 * 1024, 6144}; pg8::gemm_phase<EP, pg8::ProbStd, true>(lds, p, S, E); }
    GSYNC();
#pragma unroll
    for (int layer = 0; layer < 2; ++layer) {
        const float* modl = mod + layer * 3 * 6144;
        if (layer == 1) {
            norm_pass_b(XB, ML, XN, a.in[6] + 1024, modl, 0, lane, wave);
            GSYNC();
            { pg8::ProbG1 p{(const char*)(ws + WS_WC), (const char*)XN, 1024, 1024 * 2, 64 * 2048, (size_t)128 * 1024 * 2, (size_t)2048};
              pg8::StaticOrder S; S.init(2048, 16384, G, cu);
              pg8::EpiG1 E{(bf16_t*)(ws + WS_Z1)}; pg8::gemm_phase<pg8::EpiG1, pg8::ProbG1, true>(lds, p, S, E); }
            GSYNC();
            { pg8::ProbStd p = pg8::make_std(ws + WS_W1D, 256, ws + WS_Z1, 256, 256); pg8::StaticOrder S; S.init(256, 131072, G, cu);
              pg8::EpiG2 E{(bf16_t*)(ws + WS_G2)}; pg8::gemm_phase<pg8::EpiG2, pg8::ProbStd, true>(lds, p, S, E); }
            GSYNC();
            { pg8::ProbG3 p{(const char*)(ws + WS_W2D), (const char*)(ws + WS_G2), 512, 512 * 2, 128 * 128 * 2, (size_t)128 * 512 * 2, (size_t)128 * 128 * 128 * 2};
              pg8::StaticOrder S; S.init(256, 65536, G, cu);
              pg8::EpiG3 E{XB, modl + 2 * 1024, 6144}; pg8::gemm_phase<pg8::EpiG3, pg8::ProbG3, true>(lds, p, S, E); }
            GSYNC();
        }
        norm_pass_b(XB, ML, XN, a.in[7] + layer * 1024, modl, 3, lane, wave);
        GSYNC();
        { pg8::ProbStd p = pg8::make_std(XN, 1024, ws + WS_W13 + layer * W13_BYTES, 1024, 1024); pg8::StaticOrder S; S.init(ML, 2 * DFF, G, cu);
          pg8::EpiSwiglu E{(bf16_t*)(ws + WS_H)}; for (int p_ = 0; p_ < PROBE_FFNUP; ++p_) pg8::gemm_phase<pg8::EpiSwiglu, pg8::ProbStd, true>(lds, p, S, E); }
        GSYNC();
        { pg8::ProbStd p = pg8::make_std(ws + WS_H, DFF, ws + WS_W2 + layer * W2_BYTES, DFF, DFF); pg8::StaticOrder S; S.init(ML, 1024, G, cu);
          if (layer == 0) { typedef pg8::EpiResid<bf16_t, bf16_t> EP; EP E{XB, XB, modl + 5 * 1024, 6144}; pg8::gemm_phase<EP, pg8::ProbStd, true>(lds, p, S, E); }
          else { typedef pg8::EpiResid<bf16_t, float> EP; EP E{XB, a.out, modl + 5 * 1024, 6144}; pg8::gemm_phase<EP, pg8::ProbStd, true>(lds, p, S, E); } }
        if (layer == 0) GSYNC();
    }
}

extern "C" void kernel_launch(void* const* d_in, const int* in_sizes, int n_in, void* d_out, int out_size, void* d_ws, size_t ws_size, hipStream_t stream) {
    static int grid = 0;
    if (grid == 0) {
        if (n_in != 21 || out_size != ML * DM || ws_size < WS_END) { fprintf(stderr, "kernel_launch: unexpected problem (n_in %d out %d ws %zu)\n", n_in, out_size, ws_size); grid = -1; return; }
        int dev = 0, cus = 0, per_cu = 0;
        (void)hipGetDevice(&dev);
        (void)hipDeviceGetAttribute(&cus, hipDeviceAttributeMultiprocessorCount, dev);
        (void)hipFuncSetAttribute((const void*)fwd_kernel, hipFuncAttributeMaxDynamicSharedMemorySize, LDS_BYTES);
        (void)hipOccupancyMaxActiveBlocksPerMultiprocessor(&per_cu, (const void*)fwd_kernel, NTHR, LDS_BYTES);
        (void)hipGetLastError();
        grid = 256;
        if (cus < 256 || per_cu < 1) fprintf(stderr, "kernel_launch: cus %d per_cu %d\n", cus, per_cu);
    }
    if (grid < 0) return;
    Args a{};
    for (int i = 0; i < 21; ++i) a.in[i] = (const float*)d_in[i];
    a.out = (float*)d_out; a.ws = (unsigned char*)d_ws;
    (void)hipMemsetAsync(d_ws, 0, 16384, stream);
    void* args[] = {&a};
    hipError_t e = hipLaunchCooperativeKernel((const void*)fwd_kernel, dim3(grid), dim3(NTHR), args, LDS_BYTES, stream);
    if (e != hipSuccess) fprintf(stderr, "cooperative launch failed: %s\n", hipGetErrorString(e));
}
```
